# Optimizing an MI355X kernel written in HIP

```python
import math
import jax
import jax.numpy as jnp
from jax import lax
import numpy as np

D_MODEL = 2048
BATCH = 4
SEQ = 2048
DEPTH = 1
DEC_BATCH = 128
DEC_SEQ = 8
PAST_LEN = 2048
PAGE_SIZE = 128

A_HEADS = 8
A_KV_GROUPS = 2
A_HPG = A_HEADS // A_KV_GROUPS
A_HEAD_DIM = D_MODEL // 16
A_WIDTH = A_HEADS * A_HEAD_DIM
A_KV_WIDTH = A_KV_GROUPS * A_HEAD_DIM
CMP_BLOCK = 32
CMP_STRIDE = 16
SLC_BLOCK = 64
N_SELECT = 16
WINDOW = 512
QUERY_BLOCK = 128
B_HEADS = 8
B_KEY_DIM = D_MODEL // 16
B_VAL_DIM = D_MODEL // 16
B_WIDTH = B_HEADS * B_VAL_DIM
HGRN_CHUNK = 64
MIX_WIDTH = A_WIDTH + B_WIDTH
REL_BUCKETS = 32
REL_MAX_DIST = 128
EPS = 1e-6
IN_SPLITS = (A_WIDTH, 6 * A_KV_WIDTH, 3 * A_HEADS, A_WIDTH, B_HEADS * B_KEY_DIM, B_HEADS * B_KEY_DIM, B_WIDTH, B_WIDTH)

kernel_name = 'nsa_hgrn2_parallel_heads_decode_step'


def _rms_norm(x, g):
    xf = x.astype(jnp.float32)
    y = xf * lax.rsqrt(jnp.mean(xf * xf, axis=-1, keepdims=True) + EPS)
    return (y * g.astype(jnp.float32)).astype(x.dtype)


def _masked_softmax(logits, mask):
    z = jnp.where(mask, logits.astype(jnp.float32), -jnp.inf)
    m = jnp.max(z, axis=-1, keepdims=True)
    m = jnp.where(jnp.isfinite(m), m, 0.0)
    e = jnp.where(mask, jnp.exp(z - m), 0.0)
    s = jnp.sum(e, axis=-1, keepdims=True)
    return e / jnp.where(s > 0, s, 1.0)


def _rel_bucket(dist):
    n = jnp.maximum(dist, 0)
    exact = REL_BUCKETS // 2
    scale = (REL_BUCKETS - exact) / math.log(REL_MAX_DIST / exact)
    large = exact + (jnp.log(jnp.maximum(n, exact).astype(jnp.float32) / exact) * scale).astype(jnp.int32)
    return jnp.where(n < exact, n, jnp.minimum(large, REL_BUCKETS - 1))


def _cmp_to_slc(n_cmp, n_slc):
    c0 = jnp.arange(n_cmp)[:, None] * CMP_STRIDE
    s0 = jnp.arange(n_slc)[None, :] * SLC_BLOCK
    ov = jnp.minimum(c0 + CMP_BLOCK, s0 + SLC_BLOCK) - jnp.maximum(c0, s0)
    return jnp.maximum(ov, 0).astype(jnp.float32) / CMP_STRIDE


def _nsa_sparse_seq(q, kv_cmp, kv_slc, qpos, w_cmp_k, w_cmp_v, pe_k, pe_v, g_k_cmp, rel_bias):
    t, g, hpg, dh = q.shape
    length = kv_cmp.shape[0]
    bias_g = rel_bias.reshape(REL_BUCKETS, g, hpg)
    n_cmp = (length - CMP_BLOCK) // CMP_STRIDE + 1
    starts = jnp.arange(n_cmp) * CMP_STRIDE
    blk = kv_cmp[starts[:, None] + jnp.arange(CMP_BLOCK)[None, :]]
    k_c = jnp.einsum('clgd,lde->cge', blk[:, :, 0] + pe_k[:, None, :], w_cmp_k.reshape(CMP_BLOCK, dh, dh))
    v_c = jnp.einsum('clgd,lde->cge', blk[:, :, 1] + pe_v[:, None, :], w_cmp_v.reshape(CMP_BLOCK, dh, dh))
    k_c = _rms_norm(k_c, g_k_cmp)
    dist_c = qpos[:, None] - (starts + CMP_BLOCK - 1)[None, :]
    bias_c = jnp.transpose(bias_g[_rel_bucket(dist_c)], (0, 2, 3, 1))
    logit_c = jnp.einsum('tghd,cgd->tghc', q, k_c).astype(jnp.float32) + bias_c
    p_c = _masked_softmax(logit_c, (dist_c >= 0)[:, None, None, :])
    o_c = jnp.einsum('tghc,cgd->tghd', p_c.astype(v_c.dtype), v_c)
    n_slc = -(-length // SLC_BLOCK)
    score = jnp.einsum('tghc,cj->tgj', p_c, _cmp_to_slc(n_cmp, n_slc))
    blk_id = jnp.arange(n_slc)[None, :]
    cur = (qpos // SLC_BLOCK)[:, None]
    valid = (blk_id * SLC_BLOCK <= qpos[:, None])[:, None, :]
    forced = ((blk_id == 0) | (blk_id == cur) | (blk_id == cur - 1))[:, None, :]
    score = jnp.where(valid, jnp.where(forced, jnp.inf, score), -jnp.inf)
    n_sel = min(N_SELECT, n_slc)
    _, sel = lax.top_k(score, n_sel)
    sel_ok = jnp.take_along_axis(jnp.broadcast_to(valid, score.shape), sel, axis=-1)
    pad = n_slc * SLC_BLOCK - length
    kv_b = jnp.pad(kv_slc, ((0, pad), (0, 0), (0, 0), (0, 0))).reshape(n_slc, SLC_BLOCK, 2, g, dh)
    k_blk = jnp.transpose(kv_b[:, :, 0], (2, 0, 1, 3))
    v_blk = jnp.transpose(kv_b[:, :, 1], (2, 0, 1, 3))
    g_idx = jnp.arange(g)[None, :, None]
    offs = jnp.arange(SLC_BLOCK)
    qb = math.gcd(t, QUERY_BLOCK)
    nb = t // qb

    def sel_block(args):
        q_blk, sel_blk, ok_blk, pos_blk = args
        k_g = k_blk[g_idx, sel_blk]
        v_g = v_blk[g_idx, sel_blk]
        dist = pos_blk[:, None, None, None] - (sel_blk[..., None] * SLC_BLOCK + offs)
        mask = ((dist >= 0) & ok_blk[..., None]).reshape(qb, g, 1, n_sel * SLC_BLOCK)
        bias = jnp.moveaxis(bias_g[_rel_bucket(dist), g_idx[..., None]], -1, 2)
        logit = jnp.einsum('qghd,qgnkd->qghnk', q_blk, k_g).astype(jnp.float32) + bias
        p = _masked_softmax(logit.reshape(qb, g, hpg, n_sel * SLC_BLOCK), mask)
        return jnp.einsum('qghm,qgmd->qghd', p.astype(v_g.dtype), v_g.reshape(qb, g, n_sel * SLC_BLOCK, dh))

    o_s = lax.map(sel_block, (q.reshape(nb, qb, g, hpg, dh), sel.reshape(nb, qb, g, n_sel),
                              sel_ok.reshape(nb, qb, g, n_sel), qpos.reshape(nb, qb)))
    return o_c, o_s.reshape(t, g, hpg, dh)


def _window_attn(q, kv, qpos, kpos, rel_bias):
    g, hpg = q.shape[3], q.shape[4]
    dist = qpos[:, :, None] - kpos[:, None, :]
    mask = (dist >= 0) & (dist <= WINDOW) & (kpos[:, None, :] >= 0)
    bias = jnp.transpose(rel_bias.reshape(REL_BUCKETS, g, hpg)[_rel_bucket(dist)], (0, 3, 4, 1, 2))
    logit = jnp.einsum('nbqghd,nbkgd->nbghqk', q, kv[:, :, :, 0]).astype(jnp.float32) + bias[None]
    p = _masked_softmax(logit, mask[None, :, None, None])
    return jnp.einsum('nbghqk,nbkgd->nbqghd', p.astype(kv.dtype), kv[:, :, :, 1])


def _prompt_window(q, kv_win, rel_bias):
    n, t = q.shape[0], q.shape[1]
    qb = math.gcd(t, QUERY_BLOCK)
    nb = t // qb
    kv_pad = jnp.pad(kv_win, ((0, 0), (WINDOW, 0), (0, 0), (0, 0), (0, 0)))
    idx = (jnp.arange(nb) * qb)[:, None] + jnp.arange(WINDOW + qb)[None, :]
    o = _window_attn(q.reshape((n, nb, qb) + q.shape[2:]), kv_pad[:, idx],
                     jnp.arange(t).reshape(nb, qb), idx - WINDOW, rel_bias)
    return o.reshape(q.shape), kv_win[:, -min(WINDOW, t):]


def _sample_window(q, kv_win, buf, past_len, rel_bias):
    kv_all = jnp.concatenate([buf, kv_win], axis=1)
    wb, t = buf.shape[1], q.shape[1]
    qpos = (past_len + jnp.arange(t))[None]
    kpos = (past_len - wb + jnp.arange(wb + t))[None]
    o = _window_attn(q[:, None], kv_all[:, None], qpos, kpos, rel_bias)[:, 0]
    return o, kv_all[:, -min(WINDOW, wb + t):]


def _hgrn2(q, k, v, log_f, s0):
    n, t, h, dk = q.shape
    dv = v.shape[-1]
    c = math.gcd(t, HGRN_CHUNK)
    nc = t // c

    def chunks(a):
        return jnp.moveaxis(a.astype(jnp.float32).reshape((n, nc, c) + a.shape[2:]), 1, 0)

    tri = jnp.tril(jnp.ones((c, c), bool))[None, :, :, None, None]

    def step(s, xs):
        qc, kc, vc, lf = xs
        b = jnp.cumsum(lf, axis=1)
        decay = jnp.exp(jnp.where(tri, b[:, :, None] - b[:, None, :], -jnp.inf))
        att = jnp.einsum('nthk,ntshk,nshk->nths', qc, decay, kc)
        o = jnp.einsum('nths,nshv->nthv', att, vc) + jnp.einsum('nthk,nhkv->nthv', qc * jnp.exp(b), s)
        b_last = b[:, -1]
        s = jnp.exp(b_last)[..., None] * s + jnp.einsum('nshk,nshv->nhkv', kc * jnp.exp(b_last[:, None] - b), vc)
        return s, o

    s, o = lax.scan(step, s0.astype(jnp.float32), (chunks(q), chunks(k), chunks(v), chunks(log_f)))
    return jnp.moveaxis(o, 0, 1).reshape(n, t, h, dv), s


def _project(x, g_norm, w_in, g_q, g_k_slc, g_k_win, lb):
    n, t, _ = x.shape
    g, hpg, dh = A_KV_GROUPS, A_HPG, A_HEAD_DIM
    h = _rms_norm(x, g_norm)
    cuts = np.cumsum(IN_SPLITS)[:-1].tolist()
    q_a, kv_raw, gate, z_a, q_b, f_b, i_b, z_b = jnp.split(h @ w_in, cuts, axis=-1)
    q_a = _rms_norm(q_a.reshape(n, t, g, hpg, dh), g_q) * (dh ** -0.5)
    kv_raw = kv_raw.reshape(n, t, 3, 2, g, dh)
    kv_cmp = kv_raw[:, :, 0]
    kv_slc = jnp.stack([_rms_norm(kv_raw[:, :, 1, 0], g_k_slc), kv_raw[:, :, 1, 1]], axis=2)
    kv_win = jnp.stack([_rms_norm(kv_raw[:, :, 2, 0], g_k_win), kv_raw[:, :, 2, 1]], axis=2)
    gate = jax.nn.sigmoid(gate.astype(jnp.float32)).reshape(n, t, 3, g, hpg)
    f = lb + (1.0 - lb) * jax.nn.sigmoid(f_b.astype(jnp.float32))
    shp = (n, t, B_HEADS, B_KEY_DIM)
    return (q_a, kv_cmp, kv_slc, kv_win, gate, z_a, q_b.reshape(shp), (1.0 - f).reshape(shp),
            i_b.reshape(n, t, B_HEADS, B_VAL_DIM), jnp.log(f).reshape(shp), z_b)


def _combine(x, gate, o_c, o_s, o_w, z_a, o_h, z_b, g_o, w_out):
    n, t, _ = x.shape
    gt = gate[..., None]
    o_a = (gt[:, :, 0] * o_c + gt[:, :, 1] * o_s + gt[:, :, 2] * o_w).reshape(n, t, A_WIDTH).astype(x.dtype) * jax.nn.silu(z_a)
    o_b = _rms_norm(o_h, g_o).reshape(n, t, B_WIDTH).astype(x.dtype) * jax.nn.silu(z_b)
    return x + jnp.concatenate([o_a, o_b], axis=-1) @ w_out


def setup_inputs(seed: int = 0) -> dict:
    key = jax.random.key(seed)
    k = jax.random.split(key, 22)
    n_pages = PAST_LEN // PAGE_SIZE
    n_used = DEC_BATCH * n_pages
    n_pool = n_used + (n_used + 3) // 4
    wb = min(WINDOW, PAST_LEN)
    g, dh = A_KV_GROUPS, A_HEAD_DIM
    n_in = sum(IN_SPLITS)

    def nrm(kk, shape, s=1.0):
        return s * jax.random.normal(kk, shape, jnp.float32)

    page_table = jax.random.permutation(k[6], n_pool)[:n_used].reshape(DEC_BATCH, n_pages).astype(jnp.int32)
    return {
        'x_prompt': nrm(k[0], (BATCH, SEQ, D_MODEL)),
        'x_sample': nrm(k[1], (DEC_BATCH, DEC_SEQ, D_MODEL)),
        'cache_kv_cmp': nrm(k[2], (DEPTH, n_pool, PAGE_SIZE, 2, g, dh)),
        'cache_kv_slc': nrm(k[3], (DEPTH, n_pool, PAGE_SIZE, 2, g, dh)),
        'cache_kv_win': nrm(k[4], (DEPTH, DEC_BATCH, wb, 2, g, dh)),
        'state_hgrn': nrm(k[5], (DEPTH, DEC_BATCH, B_HEADS, B_KEY_DIM, B_VAL_DIM), 0.5),
        'page_table': page_table,
        'g_norm': 1.0 + nrm(k[7], (DEPTH, D_MODEL), 0.02),
        'w_in': nrm(k[8], (DEPTH, D_MODEL, n_in), D_MODEL ** -0.5),
        'w_out': nrm(k[9], (DEPTH, MIX_WIDTH, D_MODEL), MIX_WIDTH ** -0.5),
        'g_q': 1.0 + nrm(k[10], (DEPTH, dh), 0.02),
        'g_k_slc': 1.0 + nrm(k[11], (DEPTH, dh), 0.02),
        'g_k_win': 1.0 + nrm(k[12], (DEPTH, dh), 0.02),
        'g_k_cmp': 1.0 + nrm(k[13], (DEPTH, dh), 0.02),
        'w_cmp_k': nrm(k[14], (DEPTH, CMP_BLOCK * dh, dh), (CMP_BLOCK * dh) ** -0.5),
        'w_cmp_v': nrm(k[15], (DEPTH, CMP_BLOCK * dh, dh), (CMP_BLOCK * dh) ** -0.5),
        'pe_cmp_k': nrm(k[16], (DEPTH, CMP_BLOCK, dh), 0.1),
        'pe_cmp_v': nrm(k[17], (DEPTH, CMP_BLOCK, dh), 0.1),
        'rel_bias': nrm(k[18], (REL_BUCKETS, A_HEADS), 0.5),
        'lb_logits': nrm(k[19], (DEPTH + 1, B_HEADS * B_KEY_DIM)),
        'g_o_hgrn': 1.0 + nrm(k[20], (DEPTH, B_VAL_DIM), 0.02),
    }


def reference(x_prompt, x_sample, cache_kv_cmp, cache_kv_slc, cache_kv_win, state_hgrn, page_table,
              g_norm, w_in, w_out, g_q, g_k_slc, g_k_win, g_k_cmp, w_cmp_k, w_cmp_v, pe_cmp_k, pe_cmp_v,
              rel_bias, lb_logits, g_o_hgrn):
    lower_bounds = jnp.cumsum(jax.nn.softmax(lb_logits.astype(jnp.float32), axis=0), axis=0)
    past_len = page_table.shape[1] * cache_kv_cmp.shape[2]
    xp, xs = x_prompt, x_sample
    p_cmp, p_slc, p_win, p_st = [], [], [], []
    s_cmp, s_slc, s_win, s_st = [], [], [], []
    for l in range(DEPTH):
        sparse_w = (w_cmp_k[l], w_cmp_v[l], pe_cmp_k[l], pe_cmp_v[l], g_k_cmp[l], rel_bias)
        proj_w = (g_norm[l], w_in[l], g_q[l], g_k_slc[l], g_k_win[l], lower_bounds[l])
        qa, kvc, kvs, kvw, gate, za, qh, kh, vh, lfh, zh = _project(xp, *proj_w)
        qpos_p = jnp.arange(xp.shape[1])
        o_c, o_s = lax.map(lambda a: _nsa_sparse_seq(a[0], a[1], a[2], qpos_p, *sparse_w), (qa, kvc, kvs))
        o_w, win_p = _prompt_window(qa, kvw, rel_bias)
        s0 = jnp.zeros((xp.shape[0], B_HEADS, B_KEY_DIM, B_VAL_DIM), jnp.float32)
        o_h, st_p = _hgrn2(qh, kh, vh, lfh, s0)
        xp_new = _combine(xp, gate, o_c, o_s, o_w, za, o_h, zh, g_o_hgrn[l], w_out[l])
        p_cmp.append(kvc)
        p_slc.append(kvs)
        p_win.append(win_p)
        p_st.append(st_p.astype(xp.dtype))
        qa, kvc, kvs, kvw, gate, za, qh, kh, vh, lfh, zh = _project(xs, *proj_w)
        qpos_s = past_len + jnp.arange(xs.shape[1])
        pool_c, pool_s = cache_kv_cmp[l], cache_kv_slc[l]

        def sample_seq(a, pool_c=pool_c, pool_s=pool_s, qpos_s=qpos_s, sparse_w=sparse_w):
            q_s, kvc_new, kvs_new, pages = a
            rows = (-1,) + kvc_new.shape[1:]
            kvc_all = jnp.concatenate([pool_c[pages].reshape(rows), kvc_new], axis=0)
            kvs_all = jnp.concatenate([pool_s[pages].reshape(rows), kvs_new], axis=0)
            return _nsa_sparse_seq(q_s, kvc_all, kvs_all, qpos_s, *sparse_w)

        o_c, o_s = lax.map(sample_seq, (qa, kvc, kvs, page_table))
        o_w, win_s = _sample_window(qa, kvw, cache_kv_win[l], past_len, rel_bias)
        o_h, st_s = _hgrn2(qh, kh, vh, lfh, state_hgrn[l])
        xs_new = _combine(xs, gate, o_c, o_s, o_w, za, o_h, zh, g_o_hgrn[l], w_out[l])
        s_cmp.append(kvc)
        s_slc.append(kvs)
        s_win.append(win_s)
        s_st.append(st_s.astype(state_hgrn.dtype))
        xp, xs = xp_new, xs_new
    return (xp, xs, jnp.stack(p_cmp), jnp.stack(p_slc), jnp.stack(p_win), jnp.stack(p_st),
            jnp.stack(s_cmp), jnp.stack(s_slc), jnp.stack(s_win), jnp.stack(s_st))
```

```cpp
#include <hip/hip_runtime.h>
#include <stdint.h>

namespace {

constexpr int D = 2048;
constexpr int MP = 4 * 2048;
constexpr int MS = 128 * 8;
constexpr int M = MP + MS;
constexpr int NIN = 7704;
constexpr int C_QA = 0, C_KV = 1024, C_GATE = 2560, C_ZA = 2584, C_QB = 3608, C_FB = 4632,
              C_IB = 5656, C_ZB = 6680;
constexpr int NCMP = 127;
constexpr int NSEQ = 132;
constexpr float EPS = 1e-6f;

constexpr size_t O_YP = 0;
constexpr size_t O_YS = O_YP + 16777216;
constexpr size_t O_CMP_P = O_YS + 2097152;
constexpr size_t O_SLC_P = O_CMP_P + 4194304;
constexpr size_t O_WIN_P = O_SLC_P + 4194304;
constexpr size_t O_ST_P = O_WIN_P + 1048576;
constexpr size_t O_CMP_S = O_ST_P + 524288;
constexpr size_t O_SLC_S = O_CMP_S + 524288;
constexpr size_t O_WIN_S = O_SLC_S + 524288;
constexpr size_t O_ST_S = O_WIN_S + 33554432;

struct Params {
    const float *x_prompt, *x_sample, *cache_cmp, *cache_slc, *cache_win, *state;
    const int* page_table;
    const float *g_norm, *w_in, *w_out, *g_q, *g_k_slc, *g_k_win, *g_k_cmp, *w_cmp_k, *w_cmp_v,
        *pe_k, *pe_v, *rel_bias, *lb_logits, *g_o;
    float* out;
    float *H, *P, *KC, *VC, *OC, *OS, *OW, *OH, *MIX;
    unsigned long long* SEL;
};

__device__ __forceinline__ const float* xrow(const Params& p, int m) {
    return m < MP ? p.x_prompt + (size_t)m * D : p.x_sample + (size_t)(m - MP) * D;
}

__device__ __forceinline__ int rel_bucket(int dist) {
    int n = dist < 0 ? 0 : dist;
    if (n < 16) return n;
    int b = 16;
    b += (n >= 19) + (n >= 21) + (n >= 24) + (n >= 27) + (n >= 31) + (n >= 35) + (n >= 40) +
         (n >= 46) + (n >= 52) + (n >= 59) + (n >= 67) + (n >= 77) + (n >= 87) + (n >= 99) +
         (n >= 113);
    return b;
}

__device__ __forceinline__ float wave_sum(float v) {
#pragma unroll
    for (int o = 32; o >= 1; o >>= 1) v += __shfl_xor(v, o, 64);
    return v;
}
__device__ __forceinline__ float wave_max(float v) {
#pragma unroll
    for (int o = 32; o >= 1; o >>= 1) v = fmaxf(v, __shfl_xor(v, o, 64));
    return v;
}
__device__ __forceinline__ float half_sum(float v) {
#pragma unroll
    for (int o = 16; o >= 1; o >>= 1) v += __shfl_xor(v, o, 64);
    return v;
}
__device__ __forceinline__ float sigmoidf_(float x) { return 1.0f / (1.0f + expf(-x)); }
__device__ __forceinline__ float siluf_(float x) { return x / (1.0f + expf(-x)); }

__device__ __forceinline__ void tok_info(int m, int& n, int& qpos) {
    if (m < MP) { n = m >> 11; qpos = m & 2047; }
    else { int j = m - MP; n = 4 + (j >> 3); qpos = 2048 + (j & 7); }
}

template <class FA, class FB, class FC>
__device__ __forceinline__ void gemm128(int m0, int n0, int Mtot, int Ntot, int K, FA fa, FB fb,
                                        FC fc, float* lds) {
    float* As = lds;
    float* Bs = lds + 16 * 132;
    const int tid = threadIdx.x, tx = tid & 15, ty = tid >> 4;
    float acc[8][8];
#pragma unroll
    for (int i = 0; i < 8; ++i)
#pragma unroll
        for (int j = 0; j < 8; ++j) acc[i][j] = 0.f;
    for (int k0 = 0; k0 < K; k0 += 16) {
#pragma unroll
        for (int i = 0; i < 8; ++i) {
            int e = tid + 256 * i;
            int r = e >> 4, kk = e & 15;
            int m = m0 + r;
            As[kk * 132 + r] = (m < Mtot) ? fa(m, k0 + kk) : 0.f;
        }
#pragma unroll
        for (int i = 0; i < 8; ++i) {
            int e = tid + 256 * i;
            int kk = e >> 7, c = e & 127;
            int n = n0 + c;
            Bs[kk * 132 + c] = (n < Ntot) ? fb(k0 + kk, n) : 0.f;
        }
        __syncthreads();
#pragma unroll
        for (int kk = 0; kk < 16; ++kk) {
            float a[8], b[8];
            const float4 a0 = *(const float4*)&As[kk * 132 + ty * 8];
            const float4 a1 = *(const float4*)&As[kk * 132 + ty * 8 + 4];
            const float4 b0 = *(const float4*)&Bs[kk * 132 + tx * 8];
            const float4 b1 = *(const float4*)&Bs[kk * 132 + tx * 8 + 4];
            a[0] = a0.x; a[1] = a0.y; a[2] = a0.z; a[3] = a0.w;
            a[4] = a1.x; a[5] = a1.y; a[6] = a1.z; a[7] = a1.w;
            b[0] = b0.x; b[1] = b0.y; b[2] = b0.z; b[3] = b0.w;
            b[4] = b1.x; b[5] = b1.y; b[6] = b1.z; b[7] = b1.w;
#pragma unroll
            for (int i = 0; i < 8; ++i)
#pragma unroll
                for (int j = 0; j < 8; ++j) acc[i][j] = fmaf(a[i], b[j], acc[i][j]);
        }
        __syncthreads();
    }
#pragma unroll
    for (int i = 0; i < 8; ++i) {
        int m = m0 + ty * 8 + i;
        if (m < Mtot) {
#pragma unroll
            for (int j = 0; j < 8; ++j) {
                int n = n0 + tx * 8 + j;
                if (n < Ntot) fc(m, n, acc[i][j]);
            }
        }
    }
}

__device__ void ph_rmsnorm(const Params& p, int bid, int nb, float* lds) {
    const int tid = threadIdx.x;
    for (int m = bid; m < M; m += nb) {
        const float4* x = (const float4*)xrow(p, m);
        float4 v0 = x[tid], v1 = x[tid + 256];
        float ss = v0.x * v0.x + v0.y * v0.y + v0.z * v0.z + v0.w * v0.w + v1.x * v1.x +
                   v1.y * v1.y + v1.z * v1.z + v1.w * v1.w;
        ss = wave_sum(ss);
        __syncthreads();
        if ((tid & 63) == 0) lds[tid >> 6] = ss;
        __syncthreads();
        float tot = lds[0] + lds[1] + lds[2] + lds[3];
        float r = rsqrtf(tot * (1.0f / D) + EPS);
        const float4* g = (const float4*)p.g_norm;
        float4 g0 = g[tid], g1 = g[tid + 256];
        float4* h = (float4*)(p.H + (size_t)m * D);
        h[tid] = make_float4(v0.x * r * g0.x, v0.y * r * g0.y, v0.z * r * g0.z, v0.w * r * g0.w);
        h[tid + 256] =
            make_float4(v1.x * r * g1.x, v1.y * r * g1.y, v1.z * r * g1.z, v1.w * r * g1.w);
    }
}

__device__ void ph_gemm_in(const Params& p, int bid, int nb, float* lds) {
    constexpr int TM = M / 128, TN = (NIN + 127) / 128;
    for (int t = bid; t < TM * TN; t += nb) {
        int tm = t / TN, tn = t % TN;
        gemm128(
            tm * 128, tn * 128, M, NIN, D,
            [&](int m, int k) { return p.H[(size_t)m * D + k]; },
            [&](int k, int n) { return p.w_in[(size_t)k * NIN + n]; },
            [&](int m, int n, float v) { p.P[(size_t)m * NIN + n] = v; }, lds);
    }
}

__device__ void ph_post(const Params& p, int bid, int nb, float* lds) {
    const int tid = threadIdx.x;
    const int hd = tid >> 5, l4 = (tid & 31) * 4;
    for (int m = bid; m < M; m += nb) {
        float* row = p.P + (size_t)m * NIN;
        {
            float4 v = *(float4*)&row[C_QA + hd * 128 + l4];
            float ss = half_sum(v.x * v.x + v.y * v.y + v.z * v.z + v.w * v.w);
            float r = rsqrtf(ss * (1.0f / 128) + EPS) * 0.08838834764831845f;
            float4 g = *(const float4*)&p.g_q[l4];
            *(float4*)&row[C_QA + hd * 128 + l4] =
                make_float4(v.x * r * g.x, v.y * r * g.y, v.z * r * g.z, v.w * r * g.w);
        }
        for (int pass = 0; pass < 2; ++pass) {
            int ch = pass * 8 + hd;
            if (ch < 12) {
                int br = ch >> 2, kv = (ch >> 1) & 1;
                float4 v = *(float4*)&row[C_KV + ch * 128 + l4];
                float ss = half_sum(v.x * v.x + v.y * v.y + v.z * v.z + v.w * v.w);
                if (br >= 1 && kv == 0) {
                    float r = rsqrtf(ss * (1.0f / 128) + EPS);
                    const float* gp = (br == 1) ? p.g_k_slc : p.g_k_win;
                    float4 g = *(const float4*)&gp[l4];
                    v = make_float4(v.x * r * g.x, v.y * r * g.y, v.z * r * g.z, v.w * r * g.w);
                    *(float4*)&row[C_KV + ch * 128 + l4] = v;
                }
                int sub = (ch & 3) * 128 + l4;
                if (m < MP) {
                    if (br == 0) *(float4*)&p.out[O_CMP_P + (size_t)m * 512 + sub] = v;
                    else if (br == 1) *(float4*)&p.out[O_SLC_P + (size_t)m * 512 + sub] = v;
                    else {
                        int b = m >> 11, t = m & 2047;
                        if (t >= 1536)
                            *(float4*)&p.out[O_WIN_P + ((size_t)b * 512 + (t - 1536)) * 512 + sub] = v;
                    }
                } else {
                    int j = m - MP;
                    if (br == 0) *(float4*)&p.out[O_CMP_S + (size_t)j * 512 + sub] = v;
                    else if (br == 1) *(float4*)&p.out[O_SLC_S + (size_t)j * 512 + sub] = v;
                    else {
                        int s = j >> 3, i = j & 7;
                        *(float4*)&p.out[O_WIN_S + ((size_t)s * 512 + 504 + i) * 512 + sub] = v;
                    }
                }
            }
        }
        if (tid < 24) row[C_GATE + tid] = sigmoidf_(row[C_GATE + tid]);
        {
            int c = tid * 4;
#pragma unroll
            for (int e = 0; e < 4; ++e) {
                float l0 = p.lb_logits[c + e], l1 = p.lb_logits[1024 + c + e];
                float lb = 1.0f / (1.0f + expf(l1 - l0));
                float fb = row[C_FB + c + e];
                row[C_FB + c + e] = lb + (1.0f - lb) * sigmoidf_(fb);
            }
        }
    }
    (void)lds;
}

__device__ void ph_wincopy(const Params& p, int bid, int nb) {
    const size_t total4 = (size_t)128 * 504 * 128;
    for (size_t i = (size_t)bid * 256 + threadIdx.x; i < total4; i += (size_t)nb * 256) {
        size_t s = i / (504 * 128), rem = i % (504 * 128);
        const float4* src = (const float4*)(p.cache_win + (s * 512 + 8) * 512);
        float4* dst = (float4*)(p.out + O_WIN_S + s * 512 * 512);
        dst[rem] = src[rem];
    }
}

__device__ void ph_cmp_gemm(const Params& p, int bid, int nb, float* lds) {
    for (int u = bid; u < NSEQ * 4; u += nb) {
        const int n = u >> 2, g = (u >> 1) & 1, kvsel = u & 1;
        const float* W = kvsel ? p.w_cmp_v : p.w_cmp_k;
        const float* pe = kvsel ? p.pe_v : p.pe_k;
        float* dst = kvsel ? p.VC : p.KC;
        auto fb = [&](int k, int e) { return W[(size_t)k * 128 + e]; };
        auto fc = [&](int c, int e, float v) { dst[(((size_t)n * NCMP + c) * 2 + g) * 128 + e] = v; };
        if (n < 4) {
            gemm128(
                0, 0, NCMP, 128, 4096,
                [&](int c, int k) {
                    int l = k >> 7, d = k & 127;
                    int r = 16 * c + l;
                    return p.P[((size_t)n * 2048 + r) * NIN + C_KV + kvsel * 256 + g * 128 + d] +
                           pe[k];
                },
                fb, fc, lds);
        } else {
            const int s = n - 4;
            gemm128(
                0, 0, NCMP, 128, 4096,
                [&](int c, int k) {
                    int l = k >> 7, d = k & 127;
                    int r = 16 * c + l;
                    int page = p.page_table[s * 16 + (r >> 7)];
                    return p.cache_cmp[((((size_t)page * 128 + (r & 127)) * 2 + kvsel) * 2 + g) * 128 + d] +
                           pe[k];
                },
                fb, fc, lds);
        }
    }
}

__device__ void ph_kc_norm(const Params& p, int bid, int nb) {
    const int lane = threadIdx.x & 63, w = threadIdx.x >> 6;
    const int rows = NSEQ * NCMP * 2;
    for (int r = bid * 4 + w; r < rows; r += nb * 4) {
        float* k = p.KC + (size_t)r * 128;
        float a = k[lane], b = k[lane + 64];
        float ss = wave_sum(a * a + b * b);
        float rr = rsqrtf(ss * (1.0f / 128) + EPS);
        k[lane] = a * rr * p.g_k_cmp[lane];
        k[lane + 64] = b * rr * p.g_k_cmp[lane + 64];
    }
}

__device__ void ph_cmp_attn(const Params& p, int bid, int nb, float* lds) {
    float* qs = lds;
    float* ps = lds + 512;
    float* bt = lds + 1024;
    float* sc = lds + 1536;
    const int tid = threadIdx.x, lane = tid & 63, h = tid >> 6;
    for (int it = bid; it < M * 2; it += nb) {
        const int m = it >> 1, g = it & 1;
        int n, qpos;
        tok_info(m, n, qpos);
        const int head = g * 4 + h;
        __syncthreads();
        qs[h * 128 + lane] = p.P[(size_t)m * NIN + C_QA + head * 128 + lane];
        qs[h * 128 + lane + 64] = p.P[(size_t)m * NIN + C_QA + head * 128 + lane + 64];
        bt[h * 128 + lane] = p.rel_bias[rel_bucket(lane) * 8 + head];
        bt[h * 128 + lane + 64] = p.rel_bias[rel_bucket(lane + 64) * 8 + head];
        __syncthreads();
        const int ncv = qpos >= 31 ? min(NCMP, (qpos - 31) / 16 + 1) : 0;
        float s[2];
#pragma unroll
        for (int r = 0; r < 2; ++r) {
            int c = lane + 64 * r;
            if (c < ncv) {
                const float4* kp = (const float4*)(p.KC + (((size_t)n * NCMP + c) * 2 + g) * 128);
                const float4* qp = (const float4*)(qs + h * 128);
                float a = 0.f;
#pragma unroll 8
                for (int d = 0; d < 32; ++d) {
                    float4 kk = kp[d], qq = qp[d];
                    a += kk.x * qq.x + kk.y * qq.y + kk.z * qq.z + kk.w * qq.w;
                }
                int dist = qpos - (16 * c + 31);
                s[r] = a + bt[h * 128 + min(dist, 127)];
            } else s[r] = -INFINITY;
        }
        float mx = wave_max(fmaxf(s[0], s[1]));
        float e0 = (lane < ncv) ? expf(s[0] - mx) : 0.f;
        float e1 = (lane + 64 < ncv) ? expf(s[1] - mx) : 0.f;
        float sum = wave_sum(e0 + e1);
        float inv = sum > 0.f ? 1.0f / sum : 0.f;
        ps[h * 128 + lane] = e0 * inv;
        ps[h * 128 + lane + 64] = e1 * inv;
        __syncthreads();
        float o0 = 0.f, o1 = 0.f;
        for (int c = 0; c < ncv; ++c) {
            const float* vp = p.VC + (((size_t)n * NCMP + c) * 2 + g) * 128;
            float pc = ps[h * 128 + c];
            o0 += pc * vp[lane];
            o1 += pc * vp[lane + 64];
        }
        p.OC[(size_t)m * 1024 + head * 128 + lane] = o0;
        p.OC[(size_t)m * 1024 + head * 128 + lane + 64] = o1;
        const int nslc = (m < MP) ? 32 : 33;
        const int cur = qpos >> 6;
        if (h == 0) {
            float key = -INFINITY;
            bool valid = false;
            if (lane < nslc) {
                int j = lane;
                float scv = 0.f;
#pragma unroll
                for (int dc = -1; dc <= 3; ++dc) {
                    int c = 4 * j + dc;
                    if (c >= 0 && c < NCMP) {
                        float w = (dc == -1 || dc == 3) ? 1.f : 2.f;
                        scv += w * (ps[c] + ps[128 + c] + ps[256 + c] + ps[384 + c]);
                    }
                }
                valid = (j <= cur);
                bool forced = (j == 0) || (j == cur) || (j == cur - 1);
                key = valid ? (forced ? INFINITY : scv) : -INFINITY;
            }
            sc[lane] = key;
        }
        __syncthreads();
        if (h == 0) {
            bool sel = false;
            if (lane < nslc) {
                float key = sc[lane];
                int rank = 0;
                for (int j2 = 0; j2 < nslc; ++j2) {
                    float k2 = sc[j2];
                    rank += (k2 > key) || (k2 == key && j2 < lane);
                }
                sel = (rank < 16) && (lane <= cur);
            }
            unsigned long long mask = __ballot(sel);
            if (lane == 0) p.SEL[it] = mask;
        }
    }
}

__device__ __forceinline__ const float* slc_row(const Params& p, int n, int r, int kv, int g) {
    if (n < 4) return p.P + ((size_t)n * 2048 + r) * NIN + C_KV + 512 + kv * 256 + g * 128;
    const int s = n - 4;
    if (r >= 2048) return p.P + ((size_t)MP + s * 8 + (r - 2048)) * NIN + C_KV + 512 + kv * 256 + g * 128;
    const int page = p.page_table[s * 16 + (r >> 7)];
    return p.cache_slc + ((((size_t)page * 128 + (r & 127)) * 2 + kv) * 2 + g) * 128;
}

__device__ __forceinline__ const float* win_row(const Params& p, int n, int j, int kv, int g) {
    if (n < 4) return p.P + ((size_t)n * 2048 + j) * NIN + C_KV + 1024 + kv * 256 + g * 128;
    const int s = n - 4;
    if (j >= 512) return p.P + ((size_t)MP + s * 8 + (j - 512)) * NIN + C_KV + 1024 + kv * 256 + g * 128;
    return p.cache_win + ((((size_t)s * 512 + j) * 2 + kv) * 2 + g) * 128;
}

struct AttnState {
    float m, l, a0, a1;
};

template <class VROW>
__device__ __forceinline__ void attn_step(AttnState& st, const float* qh, const float* kp, bool valid,
                                          float bias, VROW vrow, int lane) {
    float s = -INFINITY;
    if (valid) {
        const float4* k4 = (const float4*)kp;
        const float4* q4 = (const float4*)qh;
        float a = 0.f;
#pragma unroll 8
        for (int d = 0; d < 32; ++d) {
            float4 kk = k4[d], qq = q4[d];
            a += kk.x * qq.x + kk.y * qq.y + kk.z * qq.z + kk.w * qq.w;
        }
        s = a + bias;
    }
    float bm = wave_max(s);
    if (bm == -INFINITY) return;
    float mn = fmaxf(st.m, bm);
    float scale = (st.m == -INFINITY) ? 0.f : expf(st.m - mn);
    float pe = valid ? expf(s - mn) : 0.f;
    st.l = st.l * scale + wave_sum(pe);
    st.a0 *= scale;
    st.a1 *= scale;
    unsigned long long vm = __ballot(valid);
    for (int k = 0; k < 64; ++k) {
        if ((vm >> k) & 1ull) {
            float pk = __shfl(pe, k, 64);
            const float* vp = vrow(k);
            st.a0 += pk * vp[lane];
            st.a1 += pk * vp[lane + 64];
        }
    }
    st.m = mn;
}

__device__ void ph_slc_attn(const Params& p, int bid, int nb, float* lds) {
    float* qs = lds;
    float* bt = lds + 512;
    const int tid = threadIdx.x, lane = tid & 63, h = tid >> 6;
    for (int it = bid; it < M * 2; it += nb) {
        const int m = it >> 1, g = it & 1;
        int n, qpos;
        tok_info(m, n, qpos);
        const int head = g * 4 + h;
        __syncthreads();
        qs[h * 128 + lane] = p.P[(size_t)m * NIN + C_QA + head * 128 + lane];
        qs[h * 128 + lane + 64] = p.P[(size_t)m * NIN + C_QA + head * 128 + lane + 64];
        bt[h * 128 + lane] = p.rel_bias[rel_bucket(lane) * 8 + head];
        bt[h * 128 + lane + 64] = p.rel_bias[rel_bucket(lane + 64) * 8 + head];
        __syncthreads();
        unsigned long long mask = p.SEL[it];
        AttnState st{-INFINITY, 0.f, 0.f, 0.f};
        for (int j = 0; j < 33; ++j) {
            if (!((mask >> j) & 1ull)) continue;
            const int r = 64 * j + lane;
            const bool valid = r <= qpos;
            const float* kp = valid ? slc_row(p, n, r, 0, g) : nullptr;
            const float bias = valid ? bt[h * 128 + min(qpos - r, 127)] : 0.f;
            attn_step(st, qs + h * 128, kp, valid, bias,
                      [&](int k) { return slc_row(p, n, 64 * j + k, 1, g); }, lane);
        }
        float inv = st.l > 0.f ? 1.0f / st.l : 0.f;
        p.OS[(size_t)m * 1024 + head * 128 + lane] = st.a0 * inv;
        p.OS[(size_t)m * 1024 + head * 128 + lane + 64] = st.a1 * inv;
    }
}

__device__ void ph_win_attn(const Params& p, int bid, int nb, float* lds) {
    float* qs = lds;
    float* bt = lds + 512;
    const int tid = threadIdx.x, lane = tid & 63, h = tid >> 6;
    for (int it = bid; it < M * 2; it += nb) {
        const int m = it >> 1, g = it & 1;
        int n, qpos;
        tok_info(m, n, qpos);
        const int head = g * 4 + h;
        __syncthreads();
        qs[h * 128 + lane] = p.P[(size_t)m * NIN + C_QA + head * 128 + lane];
        qs[h * 128 + lane + 64] = p.P[(size_t)m * NIN + C_QA + head * 128 + lane + 64];
        bt[h * 128 + lane] = p.rel_bias[rel_bucket(lane) * 8 + head];
        bt[h * 128 + lane + 64] = p.rel_bias[rel_bucket(lane + 64) * 8 + head];
        __syncthreads();
        int j0, j1, jq;
        if (n < 4) { jq = qpos; j1 = qpos; j0 = max(0, qpos - 512); }
        else { int i = qpos - 2048; jq = 512 + i; j1 = 512 + i; j0 = i; }
        AttnState st{-INFINITY, 0.f, 0.f, 0.f};
        for (int jb = j0; jb <= j1; jb += 64) {
            const int j = jb + lane;
            const bool valid = j <= j1;
            const float* kp = valid ? win_row(p, n, j, 0, g) : nullptr;
            const float bias = valid ? bt[h * 128 + min(jq - j, 127)] : 0.f;
            attn_step(st, qs + h * 128, kp, valid, bias,
                      [&](int k) { return win_row(p, n, jb + k, 1, g); }, lane);
        }
        float inv = st.l > 0.f ? 1.0f / st.l : 0.f;
        p.OW[(size_t)m * 1024 + head * 128 + lane] = st.a0 * inv;
        p.OW[(size_t)m * 1024 + head * 128 + lane + 64] = st.a1 * inv;
    }
}

__device__ void ph_hgrn(const Params& p, int bid, int nb, float* lds) {
    const int tid = threadIdx.x, v = tid & 127, kh = tid >> 7;
    float* sq = lds;
    float* sf = lds + 2048;
    float* si = lds + 4096;
    float* so = lds + 6144;
    for (int it = bid; it < 32 + 1024; it += nb) {
        int h, T;
        size_t mbase;
        const float* s0 = nullptr;
        float* sout;
        if (it < 32) {
            int n = it >> 3; h = it & 7; T = 2048; mbase = (size_t)n * 2048;
            sout = p.out + O_ST_P + (size_t)it * 16384;
        } else {
            int j = it - 32; h = j & 7; T = 8; mbase = (size_t)MP + (size_t)(j >> 3) * 8;
            s0 = p.state + (size_t)j * 16384;
            sout = p.out + O_ST_S + (size_t)j * 16384;
        }
        float S[64];
#pragma unroll
        for (int k = 0; k < 64; ++k) S[k] = s0 ? s0[(size_t)(kh * 64 + k) * 128 + v] : 0.f;
        for (int t0 = 0; t0 < T; t0 += 16) {
            const int nt = min(16, T - t0);
            __syncthreads();
            for (int e = tid; e < nt * 128; e += 256) {
                int tt = e >> 7, d = e & 127;
                const float* row = p.P + (mbase + t0 + tt) * NIN;
                sq[e] = row[C_QB + h * 128 + d];
                sf[e] = row[C_FB + h * 128 + d];
                si[e] = row[C_IB + h * 128 + d];
            }
            __syncthreads();
            for (int tt = 0; tt < nt; ++tt) {
                const float iv = si[tt * 128 + v];
                float o = 0.f;
#pragma unroll
                for (int k = 0; k < 64; ++k) {
                    float f = sf[tt * 128 + kh * 64 + k];
                    float q = sq[tt * 128 + kh * 64 + k];
                    S[k] = f * S[k] + (1.0f - f) * iv;
                    o += q * S[k];
                }
                so[kh * 128 + v] = o;
                __syncthreads();
                if (kh == 0) p.OH[(mbase + t0 + tt) * 1024 + h * 128 + v] = so[v] + so[128 + v];
                __syncthreads();
            }
        }
#pragma unroll
        for (int k = 0; k < 64; ++k) sout[(size_t)(kh * 64 + k) * 128 + v] = S[k];
    }
}

__device__ void ph_combine(const Params& p, int bid, int nb) {
    const int tid = threadIdx.x;
    const int hd = tid >> 5, l4 = (tid & 31) * 4;
    for (int m = bid; m < M; m += nb) {
        const float* row = p.P + (size_t)m * NIN;
        const int c = hd * 128 + l4;
        float gc = row[C_GATE + hd], gs = row[C_GATE + 8 + hd], gw = row[C_GATE + 16 + hd];
        float4 oc = *(const float4*)&p.OC[(size_t)m * 1024 + c];
        float4 os = *(const float4*)&p.OS[(size_t)m * 1024 + c];
        float4 ow = *(const float4*)&p.OW[(size_t)m * 1024 + c];
        float4 za = *(const float4*)&row[C_ZA + c];
        float4 r;
        r.x = (gc * oc.x + gs * os.x + gw * ow.x) * siluf_(za.x);
        r.y = (gc * oc.y + gs * os.y + gw * ow.y) * siluf_(za.y);
        r.z = (gc * oc.z + gs * os.z + gw * ow.z) * siluf_(za.z);
        r.w = (gc * oc.w + gs * os.w + gw * ow.w) * siluf_(za.w);
        *(float4*)&p.MIX[(size_t)m * 2048 + c] = r;
        float4 oh = *(const float4*)&p.OH[(size_t)m * 1024 + c];
        float ss = half_sum(oh.x * oh.x + oh.y * oh.y + oh.z * oh.z + oh.w * oh.w);
        float rr = rsqrtf(ss * (1.0f / 128) + EPS);
        float4 go = *(const float4*)&p.g_o[l4];
        float4 zb = *(const float4*)&row[C_ZB + c];
        float4 q;
        q.x = oh.x * rr * go.x * siluf_(zb.x);
        q.y = oh.y * rr * go.y * siluf_(zb.y);
        q.z = oh.z * rr * go.z * siluf_(zb.z);
        q.w = oh.w * rr * go.w * siluf_(zb.w);
        *(float4*)&p.MIX[(size_t)m * 2048 + 1024 + c] = q;
    }
}

__device__ void ph_gemm_out(const Params& p, int bid, int nb, float* lds) {
    constexpr int TM = M / 128, TN = D / 128;
    for (int t = bid; t < TM * TN; t += nb) {
        int tm = t / TN, tn = t % TN;
        gemm128(
            tm * 128, tn * 128, M, D, 2048,
            [&](int m, int k) { return p.MIX[(size_t)m * 2048 + k]; },
            [&](int k, int n) { return p.w_out[(size_t)k * D + n]; },
            [&](int m, int n, float v) {
                float x = xrow(p, m)[n];
                if (m < MP) p.out[O_YP + (size_t)m * D + n] = x + v;
                else p.out[O_YS + (size_t)(m - MP) * D + n] = x + v;
            },
            lds);
    }
}

__global__ void __launch_bounds__(256) k_rmsnorm(Params p) {
    __shared__ float lds[16];
    ph_rmsnorm(p, blockIdx.x, gridDim.x, lds);
}
__global__ void __launch_bounds__(256) k_gemm_in(Params p) {
    __shared__ float lds[2 * 16 * 132];
    ph_gemm_in(p, blockIdx.x, gridDim.x, lds);
}
__global__ void __launch_bounds__(256) k_post(Params p) {
    ph_post(p, blockIdx.x, gridDim.x, nullptr);
    ph_wincopy(p, blockIdx.x, gridDim.x);
}
__global__ void __launch_bounds__(256) k_cmp_gemm(Params p) {
    __shared__ float lds[2 * 16 * 132];
    ph_cmp_gemm(p, blockIdx.x, gridDim.x, lds);
}
__global__ void __launch_bounds__(256) k_kc_norm(Params p) { ph_kc_norm(p, blockIdx.x, gridDim.x); }
__global__ void __launch_bounds__(256) k_cmp_attn(Params p) {
    __shared__ float lds[1600];
    ph_cmp_attn(p, blockIdx.x, gridDim.x, lds);
}
__global__ void __launch_bounds__(256) k_slc_attn(Params p) {
    __shared__ float lds[1024];
    ph_slc_attn(p, blockIdx.x, gridDim.x, lds);
}
__global__ void __launch_bounds__(256) k_win_attn(Params p) {
    __shared__ float lds[1024];
    ph_win_attn(p, blockIdx.x, gridDim.x, lds);
}
__global__ void __launch_bounds__(256) k_hgrn(Params p) {
    __shared__ float lds[6144 + 256];
    ph_hgrn(p, blockIdx.x, gridDim.x, lds);
}
__global__ void __launch_bounds__(256) k_combine(Params p) { ph_combine(p, blockIdx.x, gridDim.x); }
__global__ void __launch_bounds__(256) k_gemm_out(Params p) {
    __shared__ float lds[2 * 16 * 132];
    ph_gemm_out(p, blockIdx.x, gridDim.x, lds);
}

}

extern "C" void kernel_launch(void* const* d_in, const int* in_sizes, int n_in, void* d_out,
                              int out_size, void* d_ws, size_t ws_size, hipStream_t stream) {
    (void)in_sizes; (void)n_in; (void)out_size; (void)ws_size;
    Params p{};
    p.x_prompt = (const float*)d_in[0];
    p.x_sample = (const float*)d_in[1];
    p.cache_cmp = (const float*)d_in[2];
    p.cache_slc = (const float*)d_in[3];
    p.cache_win = (const float*)d_in[4];
    p.state = (const float*)d_in[5];
    p.page_table = (const int*)d_in[6];
    p.g_norm = (const float*)d_in[7];
    p.w_in = (const float*)d_in[8];
    p.w_out = (const float*)d_in[9];
    p.g_q = (const float*)d_in[10];
    p.g_k_slc = (const float*)d_in[11];
    p.g_k_win = (const float*)d_in[12];
    p.g_k_cmp = (const float*)d_in[13];
    p.w_cmp_k = (const float*)d_in[14];
    p.w_cmp_v = (const float*)d_in[15];
    p.pe_k = (const float*)d_in[16];
    p.pe_v = (const float*)d_in[17];
    p.rel_bias = (const float*)d_in[18];
    p.lb_logits = (const float*)d_in[19];
    p.g_o = (const float*)d_in[20];
    p.out = (float*)d_out;
    float* ws = (float*)d_ws;
    size_t off = 0;
    auto take = [&](size_t nfloats) { float* r = ws + off; off += (nfloats + 63) & ~(size_t)63; return r; };
    p.H = take((size_t)M * D);
    p.P = take((size_t)M * NIN);
    p.KC = take((size_t)NSEQ * NCMP * 256);
    p.VC = take((size_t)NSEQ * NCMP * 256);
    p.OC = take((size_t)M * 1024);
    p.OS = take((size_t)M * 1024);
    p.OW = take((size_t)M * 1024);
    p.OH = take((size_t)M * 1024);
    p.MIX = take((size_t)M * 2048);
    p.SEL = (unsigned long long*)take((size_t)M * 2 * 2);

    k_rmsnorm<<<2048, 256, 0, stream>>>(p);
    k_gemm_in<<<72 * 61, 256, 0, stream>>>(p);
    k_post<<<2048, 256, 0, stream>>>(p);
    k_cmp_gemm<<<NSEQ * 4, 256, 0, stream>>>(p);
    k_kc_norm<<<1024, 256, 0, stream>>>(p);
    k_cmp_attn<<<4096, 256, 0, stream>>>(p);
    k_slc_attn<<<4096, 256, 0, stream>>>(p);
    k_win_attn<<<4096, 256, 0, stream>>>(p);
    k_hgrn<<<32 + 1024, 256, 0, stream>>>(p);
    k_combine<<<2048, 256, 0, stream>>>(p);
    k_gemm_out<<<72 * 16, 256, 0, stream>>>(p);
}
```

```cpp
#include <hip/hip_runtime.h>
#include <stdint.h>
#include <stdio.h>

#define XB_TMO      128
#define XB_XCNT(j)  (256  + 64 * (j))
#define XB_XSUB(j)  (1280 + 64 * (j))
#define XB_XGEN(j)  (2304 + 64 * (j))
#define XB_TOP      3328
#define XB_TOPGEN   3392
#define XCD_BAR_WORDS 3456
#define XB_SPIN_CAP (1u << 18)
#define LAS __attribute__((address_space(3)))

__device__ __forceinline__ unsigned xb_ld(unsigned* p)              { return __hip_atomic_load(p, __ATOMIC_RELAXED, __HIP_MEMORY_SCOPE_AGENT); }
__device__ __forceinline__ unsigned xb_add(unsigned* p, unsigned v) { return __hip_atomic_fetch_add(p, v, __ATOMIC_RELAXED, __HIP_MEMORY_SCOPE_AGENT); }
__device__ __forceinline__ unsigned xb_xcc_id() { return (unsigned)__builtin_amdgcn_s_getreg((3 << 11) | 20) & 0xFu; }
#define XB_SPIN(cond, bar) do { unsigned _sp = 0; while (cond) { __builtin_amdgcn_s_sleep(1); \
    if ((++_sp & 255u) == 0u) { if (xb_ld(&(bar)[XB_TMO])) break; if (_sp > XB_SPIN_CAP) { atomicAdd(&(bar)[XB_TMO], 1u); break; } } } } while (0)

struct XcdBarrier {
    unsigned* bar; unsigned x;
    volatile LAS unsigned* st;
};

__device__ __forceinline__ XcdBarrier xcd_barrier_post(unsigned* bar, volatile LAS unsigned* st) {
    XcdBarrier b; b.bar = bar; b.x = xb_xcc_id(); b.st = st;
    if (threadIdx.x == 0) (void)xb_add(&bar[XB_XCNT(b.x)], 1u);
    return b;
}
__device__ __forceinline__ void xcd_barrier_complete(unsigned* bar, unsigned x, unsigned& nloc, unsigned& nx) {
    const unsigned G = gridDim.x * gridDim.y * gridDim.z;
    unsigned sum, cnt, mine, sp = 0u;
    for (;;) {
        sum = 0u; cnt = 0u; mine = 0u;
#pragma unroll
        for (unsigned j = 0; j < 16; ++j) { const unsigned c = xb_ld(&bar[XB_XCNT(j)]); sum += c; cnt += (c > 0u) ? 1u : 0u; mine = (j == x) ? c : mine; }
        if (sum == G) break;
        __builtin_amdgcn_s_sleep(1);
        if ((++sp & 255u) == 0u) { if (xb_ld(&bar[XB_TMO])) break; if (sp > XB_SPIN_CAP) { atomicAdd(&bar[XB_TMO], 1u); break; } }
    }
    nloc = mine > 0u ? mine : 1u; nx = cnt > 0u ? cnt : 1u;
}
__device__ __forceinline__ void xcd_barrier(const XcdBarrier& b) {
    asm volatile("s_waitcnt vmcnt(0)" ::: "memory");
    __syncthreads();
    if (threadIdx.x == 0) {
        unsigned* bar = b.bar;
        __builtin_amdgcn_s_waitcnt(0);
        unsigned nloc = b.st[0], nx = b.st[1];
        if (nloc == 0u) { xcd_barrier_complete(bar, b.x, nloc, nx); b.st[0] = nloc; b.st[1] = nx; }
        const unsigned old = xb_add(&bar[XB_XSUB(b.x)], 1u);
        const unsigned gen = old / nloc;
        if (old + 1u == (gen + 1u) * nloc) {
            __builtin_amdgcn_fence(__ATOMIC_RELEASE, "agent");
            asm volatile("s_waitcnt vmcnt(0)" ::: "memory");
            const unsigned og = xb_add(&bar[XB_TOP], 1u);
            const unsigned tg = og / nx;
            if (og + 1u == (tg + 1u) * nx) xb_add(&bar[XB_TOPGEN], 1u);
            else XB_SPIN(xb_ld(&bar[XB_TOPGEN]) == tg, bar);
            __builtin_amdgcn_fence(__ATOMIC_ACQUIRE, "agent");
            xb_add(&bar[XB_XGEN(b.x)], 1u);
            asm volatile("s_waitcnt vmcnt(0)" ::: "memory");
        } else {
            XB_SPIN(xb_ld(&bar[XB_XGEN(b.x)]) == gen, bar);
            __builtin_amdgcn_fence(__ATOMIC_ACQUIRE, "agent");
            asm volatile("s_waitcnt vmcnt(0)" ::: "memory");
        }
    }
    __syncthreads();
}


namespace pg8 {
#define PG8_LAS __attribute__((address_space(3)))
typedef unsigned short bf16_t;
typedef short bf16x8 __attribute__((ext_vector_type(8)));
typedef float f32x4 __attribute__((ext_vector_type(4)));
typedef unsigned u32x4 __attribute__((ext_vector_type(4)));
constexpr int BM = 256, BK = 64, HALF = 128, HTB = HALF * BK * 2, STAGE_BYTES = 8 * HTB, NXCD = 8, WGM = 8;

__host__ __device__ __forceinline__ int lds_byte(int r, int c) { const int st = (r >> 4) * 2 + (c >> 5), rr = r & 15, cc = c & 31, ob = rr * 64 + cc * 2; return st * 1024 + (ob ^ (((ob >> 9) & 1) << 5)); }
__host__ __device__ __forceinline__ void stage_rc(int b, int& R, int& C) { const int st = b / 1024, sb = b % 1024, swz = sb ^ (((sb >> 9) & 1) << 5); R = (st >> 1) * 16 + swz / 64; C = (st & 1) * 32 + (swz % 64) / 2; }
__host__ __device__ __forceinline__ int perm32(int rho) { const int n = rho >> 4, i = rho & 15; return 8 * (i >> 2) + 4 * n + (i & 3); }

struct Unit { int pm, pn; };
struct Gemm { const bf16_t* A; const bf16_t* Bt; int M, N, K; };

struct StaticOrder {
    int nM, nN, nwg, G, c;
    __host__ __device__ void init(int M, int N, int G_, int c_) { nM = M / BM; nN = N / BM; nwg = nM * nN; G = G_; c = c_; }
    __host__ __device__ bool next(int i, Unit& u) const {
        const long L = (long)i * G + c; if (L >= nwg) return false;
        int wgid = (int)L; { const int q = nwg / NXCD, r = nwg % NXCD, xcd = wgid % NXCD, off = wgid / NXCD; wgid = (xcd < r ? xcd * (q + 1) : r * (q + 1) + (xcd - r) * q) + off; }
        const int nig = WGM * nN, gid = wgid / nig, fm = gid * WGM, gsz = (nM - fm) < WGM ? (nM - fm) : WGM;
        u.pm = fm + ((wgid % nig) % gsz); u.pn = (wgid % nig) / gsz; return true;
    }
    __device__ __forceinline__ void a_ready(const Unit&) const {}
    __device__ __forceinline__ void done(const Unit&) const {}
};

__device__ __forceinline__ unsigned cvt_pk_bf16(float lo, float hi) { unsigned r; asm volatile("v_cvt_pk_bf16_f32 %0, %1, %2" : "=v"(r) : "v"(lo), "v"(hi)); return r; }

struct EpiF32 {
    static constexpr bool PERM = false, AFTER_DRAIN = false;
    float* C; int ldc;
    __device__ __forceinline__ void operator()(const f32x4 (&acc)[2][2][4][2], const Unit& u, int wr, int wc, int fr, int fq) const {
        const int row0 = u.pm * BM + wr * 64 + fr, col0 = u.pn * BM + wc * 32 + 4 * fq;
#pragma unroll
        for (int ai = 0; ai < 2; ++ai)
#pragma unroll
            for (int m = 0; m < 4; ++m) { float* rowp = C + (size_t)(row0 + ai * HALF + m * 16) * ldc + col0;
#pragma unroll
                for (int bj = 0; bj < 2; ++bj)
#pragma unroll
                    for (int n = 0; n < 2; ++n) *(f32x4*)(rowp + bj * HALF + n * 16) = acc[ai][bj][m][n]; }
    }
};
struct EpiMix {
    static constexpr bool PERM = true, AFTER_DRAIN = false;
    float* F; bf16_t* H; int ldh;
    __device__ __forceinline__ void operator()(const f32x4 (&acc)[2][2][4][2], const Unit& u, int wr, int wc, int fr, int fq) const {
        const int row0 = u.pm * BM + wr * 64 + fr;
        if (u.pn < 12) {
            const int col0 = u.pn * BM + wc * 32 + 8 * fq;
#pragma unroll
            for (int ai = 0; ai < 2; ++ai)
#pragma unroll
                for (int m = 0; m < 4; ++m) { float* rowp = F + (size_t)(row0 + ai * HALF + m * 16) * 3072 + col0;
#pragma unroll
                    for (int bj = 0; bj < 2; ++bj) { *(f32x4*)(rowp + bj * HALF) = acc[ai][bj][m][0]; *(f32x4*)(rowp + bj * HALF + 4) = acc[ai][bj][m][1]; } }
        } else {
            const int col0 = (u.pn - 12) * BM + wc * 32 + 8 * fq;
#pragma unroll
            for (int ai = 0; ai < 2; ++ai)
#pragma unroll
                for (int m = 0; m < 4; ++m) { bf16_t* rowp = H + (size_t)(row0 + ai * HALF + m * 16) * ldh + col0;
#pragma unroll
                    for (int bj = 0; bj < 2; ++bj) { const f32x4 v0 = acc[ai][bj][m][0], v1 = acc[ai][bj][m][1];
                        u32x4 w; w.x = cvt_pk_bf16(v0[0], v0[1]); w.y = cvt_pk_bf16(v0[2], v0[3]); w.z = cvt_pk_bf16(v1[0], v1[1]); w.w = cvt_pk_bf16(v1[2], v1[3]);
                        *(u32x4*)(rowp + bj * HALF) = w; } }
        }
    }
};
#define PG8_RES_LD(q, dst, XROW) { const int ai_ = (q) >> 2, m_ = (q) & 3; const int r_ = row0 + ai_ * HALF + m_ * 16; const float* xr_ = (XROW) + col0; \
        dst[0] = *(const f32x4*)(xr_); dst[1] = *(const f32x4*)(xr_ + 16); dst[2] = *(const f32x4*)(xr_ + HALF); dst[3] = *(const f32x4*)(xr_ + HALF + 16); }
#define PG8_RES_ST(q, src) { const int ai_ = (q) >> 2, m_ = (q) & 3; const int r_ = row0 + ai_ * HALF + m_ * 16; float* rowp_ = C + (size_t)r_ * 2048 + col0; \
        *(f32x4*)(rowp_) = acc[ai_][0][m_][0] + src[0]; *(f32x4*)(rowp_ + 16) = acc[ai_][0][m_][1] + src[1]; \
        *(f32x4*)(rowp_ + HALF) = acc[ai_][1][m_][0] + src[2]; *(f32x4*)(rowp_ + HALF + 16) = acc[ai_][1][m_][1] + src[3]; }
#define PG8_RES_BODY(XROWF) \
        f32x4 xa0[4], xa1[4], xb0[4], xb1[4]; \
        PG8_RES_LD(0, xa0, XROWF(r_)) PG8_RES_LD(1, xa1, XROWF(r_)) PG8_RES_LD(2, xb0, XROWF(r_)) PG8_RES_LD(3, xb1, XROWF(r_)) \
        PG8_RES_ST(0, xa0) PG8_RES_ST(1, xa1) \
        PG8_RES_LD(4, xa0, XROWF(r_)) PG8_RES_LD(5, xa1, XROWF(r_)) \
        PG8_RES_ST(2, xb0) PG8_RES_ST(3, xb1) \
        PG8_RES_LD(6, xb0, XROWF(r_)) PG8_RES_LD(7, xb1, XROWF(r_)) \
        PG8_RES_ST(4, xa0) PG8_RES_ST(5, xa1) PG8_RES_ST(6, xb0) PG8_RES_ST(7, xb1)
struct EpiResF32 {
    static constexpr bool PERM = false, AFTER_DRAIN = false;
    float* C; const float* xp; const float* xs;
    __device__ __forceinline__ void operator()(const f32x4 (&acc)[2][2][4][2], const Unit& u, int wr, int wc, int fr, int fq) const {
        const int row0 = u.pm * BM + wr * 64 + fr, col0 = u.pn * BM + wc * 32 + 4 * fq;
#define PG8_XROW_A(r) ((r) < 8192 ? xp + (size_t)(r) * 2048 : xs + (size_t)((r) - 8192) * 2048)
        PG8_RES_BODY(PG8_XROW_A)
#undef PG8_XROW_A
    }
};

struct EpiResF32S {
    static constexpr bool PERM = false, AFTER_DRAIN = false;
    float* C; const float* x;
    __device__ __forceinline__ void operator()(const f32x4 (&acc)[2][2][4][2], const Unit& u, int wr, int wc, int fr, int fq) const {
        const int row0 = u.pm * BM + wr * 64 + fr, col0 = u.pn * BM + wc * 32 + 4 * fq;
#define PG8_XROW_S(r) (x + (size_t)(r) * 2048)
        PG8_RES_BODY(PG8_XROW_S)
#undef PG8_XROW_S
    }
};
#undef PG8_RES_BODY
#undef PG8_RES_ST
#undef PG8_RES_LD

template <class Epi, class Sched>
__device__ __forceinline__ void gemm_phase(PG8_LAS unsigned char* lds, const Gemm g, const Sched& S, const Epi& E) {
    const int tid = threadIdx.x, wid = __builtin_amdgcn_readfirstlane(tid >> 6), lane = tid & 63, wr = wid >> 2, wc = wid & 3, fr = lane & 15, fq = lane >> 4;
    const int K = g.K, nt = K / BK;
    unsigned voffA[2], voffB[2];
#pragma unroll
    for (int i = 0; i < 2; ++i) { int R, C; stage_rc(tid * 16 + i * 8192, R, C); const int Rb = Epi::PERM ? ((R & ~31) + perm32(R & 31)) : R;
        voffA[i] = (unsigned)(R * K + C) * 2u; voffB[i] = (unsigned)(Rb * K + C) * 2u; }
    const size_t kstep = (size_t)(BK * 2);
    const size_t hstep = (size_t)HALF * K * 2;
    const size_t tstep = 2 * hstep;
    const unsigned ldsw = (unsigned)wid * 1024u;
    const int aoff = lds_byte(wr * 64 + fr, fq * 8), boff = lds_byte(wc * 32 + fr, fq * 8);
#define PG8_SA(b, h) (((b) * 2 + (h)) * HTB)
#define PG8_SB(b, h) ((4 + (b) * 2 + (h)) * HTB)
#define PG8_STAGE(bufoff, gbase, voff) do { _Pragma("unroll") for (int _i = 0; _i < 2; ++_i) \
        __builtin_amdgcn_global_load_lds((const unsigned*)((const char*)(gbase) + (voff)[_i]), (PG8_LAS unsigned*)(lds + (bufoff) + ldsw + _i * 8192), 16, 0, 0); } while (0)
#define PG8_LDA(dst, b, h) do { _Pragma("unroll") for (int m = 0; m < 4; ++m) _Pragma("unroll") for (int k = 0; k < 2; ++k) dst[m][k] = *(const PG8_LAS bf16x8*)(lds + PG8_SA(b, h) + aoff + m * 2048 + k * 1024); } while (0)
#define PG8_LDB(dst, b, h) do { _Pragma("unroll") for (int n = 0; n < 2; ++n) _Pragma("unroll") for (int k = 0; k < 2; ++k) dst[n][k] = *(const PG8_LAS bf16x8*)(lds + PG8_SB(b, h) + boff + n * 2048 + k * 1024); } while (0)
#define PG8_MMA(ai, bj, At, Bt) do { __builtin_amdgcn_s_setprio(1); _Pragma("unroll") for (int m = 0; m < 4; ++m) _Pragma("unroll") for (int n = 0; n < 2; ++n) _Pragma("unroll") for (int k = 0; k < 2; ++k) \
        acc[ai][bj][m][n] = __builtin_amdgcn_mfma_f32_16x16x32_bf16(Bt[n][k], At[m][k], acc[ai][bj][m][n], 0, 0, 0); __builtin_amdgcn_s_setprio(0); } while (0)
#define PG8_WAIT_V(n) asm volatile("s_waitcnt vmcnt(" #n ")" ::: "memory")
#define PG8_WAIT_L(n) asm volatile("s_waitcnt lgkmcnt(" #n ")" ::: "memory")
#define PG8_BAR __builtin_amdgcn_s_barrier()
#define PG8_SCHED __builtin_amdgcn_sched_barrier(0)
    Unit cur, nxt; int ui = 0;
    if (!S.next(0, cur)) return;
    f32x4 acc[2][2][4][2];
#pragma unroll
    for (int a = 0; a < 2; ++a)
#pragma unroll
        for (int b = 0; b < 2; ++b)
#pragma unroll
            for (int m = 0; m < 4; ++m)
#pragma unroll
                for (int n = 0; n < 2; ++n) acc[a][b][m][n] = (f32x4){0.f, 0.f, 0.f, 0.f};
    bf16x8 At[4][2], B0[2][2], B1[2][2];
    const char* cA = (const char*)g.A + (size_t)cur.pm * tstep; const char* cB = (const char*)g.Bt + (size_t)cur.pn * tstep;
    S.a_ready(cur);
    PG8_STAGE(PG8_SB(0, 0), cB, voffB); PG8_STAGE(PG8_SA(0, 0), cA, voffA); PG8_STAGE(PG8_SB(0, 1), cB + hstep, voffB); PG8_STAGE(PG8_SA(0, 1), cA + hstep, voffA);
    if (wr == 1) PG8_BAR;
    PG8_WAIT_V(4); PG8_BAR;
    PG8_STAGE(PG8_SB(1, 0), cB + kstep, voffB); PG8_STAGE(PG8_SA(1, 0), cA + kstep, voffA); PG8_STAGE(PG8_SB(1, 1), cB + hstep + kstep, voffB);
    PG8_WAIT_V(6); PG8_BAR;
    for (;;) {
        const bool has_next = S.next(ui + 1, nxt);
        const char* nA = has_next ? (const char*)g.A + (size_t)nxt.pm * tstep : cA; const char* nB = has_next ? (const char*)g.Bt + (size_t)nxt.pn * tstep : cB;
        for (int t = 0; t < nt; t += 2) {
            const bool last = (t == nt - 2);
            const char* a1 = cA + (size_t)(t + 1) * kstep;
            const char* a2 = last ? nA : cA + (size_t)(t + 2) * kstep; const char* b2 = last ? nB : cB + (size_t)(t + 2) * kstep;
            const char* a3 = a2 + kstep; const char* b3 = b2 + kstep;
            if (last && has_next) S.a_ready(nxt);
            PG8_LDB(B0, 0, 0); PG8_SCHED; PG8_LDA(At, 0, 0); PG8_STAGE(PG8_SA(1, 1), a1 + hstep, voffA);
            PG8_WAIT_L(8); PG8_BAR; PG8_WAIT_L(0); PG8_MMA(0, 0, At, B0); PG8_BAR; PG8_SCHED;
            PG8_LDB(B1, 0, 1); PG8_STAGE(PG8_SB(0, 0), b2, voffB);
            PG8_BAR; PG8_WAIT_L(0); PG8_MMA(0, 1, At, B1); PG8_BAR;
            PG8_LDA(At, 0, 1); PG8_STAGE(PG8_SA(0, 0), a2, voffA);
            PG8_BAR; PG8_WAIT_L(0); PG8_MMA(1, 0, At, B0); PG8_BAR; PG8_SCHED;
            PG8_STAGE(PG8_SB(0, 1), b2 + hstep, voffB);
            PG8_WAIT_V(6); PG8_BAR; PG8_MMA(1, 1, At, B1); PG8_BAR;
            PG8_LDB(B0, 1, 0); PG8_SCHED; PG8_LDA(At, 1, 0); PG8_STAGE(PG8_SA(0, 1), a2 + hstep, voffA);
            PG8_WAIT_L(8); PG8_BAR; PG8_WAIT_L(0); PG8_MMA(0, 0, At, B0); PG8_BAR; PG8_SCHED;
            PG8_LDB(B1, 1, 1); PG8_STAGE(PG8_SB(1, 0), b3, voffB);
            PG8_BAR; PG8_WAIT_L(0); PG8_MMA(0, 1, At, B1); PG8_BAR;
            PG8_LDA(At, 1, 1); PG8_STAGE(PG8_SA(1, 0), a3, voffA);
            PG8_BAR; PG8_WAIT_L(0); PG8_MMA(1, 0, At, B0); PG8_BAR; PG8_SCHED;
            PG8_STAGE(PG8_SB(1, 1), b3 + hstep, voffB);
            PG8_WAIT_V(6); PG8_BAR; PG8_MMA(1, 1, At, B1); PG8_BAR;
        }
        E(acc, cur, wr, wc, fr, fq); S.done(cur);
        if (!has_next) break;
#pragma unroll
        for (int a = 0; a < 2; ++a)
#pragma unroll
            for (int b = 0; b < 2; ++b)
#pragma unroll
                for (int m = 0; m < 4; ++m)
#pragma unroll
                    for (int n = 0; n < 2; ++n) acc[a][b][m][n] = (f32x4){0.f, 0.f, 0.f, 0.f};
        cur = nxt; cA = nA; cB = nB; ++ui;
    }
    PG8_WAIT_V(0);
    if (wr == 0) PG8_BAR;
    PG8_BAR;
#undef PG8_SA
#undef PG8_SB
#undef PG8_STAGE
#undef PG8_LDA
#undef PG8_LDB
#undef PG8_MMA
#undef PG8_WAIT_V
#undef PG8_WAIT_L
#undef PG8_BAR
#undef PG8_SCHED
}
}

#ifndef P1_MAXU
#define P1_MAXU 4
#endif
#ifndef PROBE_MASK
#define PROBE_MASK 0
#endif

namespace {

typedef unsigned short bf16_t;
constexpr int NT = 512;
constexpr int D = 2048;
constexpr int MP = 4 * 2048;
constexpr int MS = 128 * 8;
constexpr int M = MP + MS;
constexpr int NIN = 7704;
constexpr int LDP = 7936;
constexpr int NPF = 3072, LDH = LDP - NPF;
constexpr int C_QB = 0, C_FB = 1024, C_IB = 2048;
constexpr int C_QA = 0, C_KV = 1024, C_GATE = 2560, C_ZA = 2584, C_ZB = 3608;
constexpr int NCMP = 127;
constexpr int NSEQ = 132;
constexpr float EPS = 1e-6f;
constexpr int LDS_STAGE = 139264;
constexpr int LDS_BYTES = LDS_STAGE + 256;

constexpr size_t O_YP = 0;
constexpr size_t O_YS = O_YP + 16777216;
constexpr size_t O_CMP_P = O_YS + 2097152;
constexpr size_t O_SLC_P = O_CMP_P + 4194304;
constexpr size_t O_WIN_P = O_SLC_P + 4194304;
constexpr size_t O_ST_P = O_WIN_P + 1048576;
constexpr size_t O_CMP_S = O_ST_P + 524288;
constexpr size_t O_SLC_S = O_CMP_S + 524288;
constexpr size_t O_WIN_S = O_SLC_S + 524288;
constexpr size_t O_ST_S = O_WIN_S + 33554432;

struct Params {
    const float *x_prompt, *x_sample, *cache_cmp, *cache_slc, *cache_win, *state;
    const int* page_table;
    const float *g_norm, *w_in, *w_out, *g_q, *g_k_slc, *g_k_win, *g_k_cmp, *w_cmp_k, *w_cmp_v,
        *pe_k, *pe_v, *rel_bias, *lb_logits, *g_o;
    float* out;
    bf16_t *Hb, *Wt_in, *Wt_out, *MIXb, *Wc_t, *Qb, *KVb, *KCb, *VCb;
    float* PEB;
    float* PF; bf16_t* PH;
    float* GATE;
    bf16_t *OC, *OS, *OW;
    float* OH;
    unsigned long long* SEL;
    unsigned* bar;
    unsigned* ctr;
};

__device__ __forceinline__ const float* xrow(const Params& p, int m) {
    return m < MP ? p.x_prompt + (size_t)m * D : p.x_sample + (size_t)(m - MP) * D;
}

__device__ __forceinline__ int rel_bucket(int dist) {
    int n = dist < 0 ? 0 : dist;
    if (n < 16) return n;
    int b = 16;
    b += (n >= 19) + (n >= 21) + (n >= 24) + (n >= 27) + (n >= 31) + (n >= 35) + (n >= 40) +
         (n >= 46) + (n >= 52) + (n >= 59) + (n >= 67) + (n >= 77) + (n >= 87) + (n >= 99) +
         (n >= 113);
    return b;
}

__device__ __forceinline__ float wave_sum(float v) {
#pragma unroll
    for (int o = 32; o >= 1; o >>= 1) v += __shfl_xor(v, o, 64);
    return v;
}
__device__ __forceinline__ float wave_max(float v) {
#pragma unroll
    for (int o = 32; o >= 1; o >>= 1) v = fmaxf(v, __shfl_xor(v, o, 64));
    return v;
}
__device__ __forceinline__ float half_sum(float v) {
#pragma unroll
    for (int o = 16; o >= 1; o >>= 1) v += __shfl_xor(v, o, 64);
    return v;
}
__device__ __forceinline__ float sigmoidf_(float x) { return __builtin_amdgcn_rcpf(1.0f + __expf(-x)); }
__device__ __forceinline__ float siluf_(float x) { return x * __builtin_amdgcn_rcpf(1.0f + __expf(-x)); }
__device__ __forceinline__ unsigned pk2(float lo, float hi) { return pg8::cvt_pk_bf16(lo, hi); }
__device__ __forceinline__ float bflo(unsigned u) { return __uint_as_float(u << 16); }
__device__ __forceinline__ float bfhi(unsigned u) { return __uint_as_float(u & 0xffff0000u); }
__device__ __forceinline__ float4 bf4(uint2 u) { return make_float4(bflo(u.x), bfhi(u.x), bflo(u.y), bfhi(u.y)); }

__device__ __forceinline__ void tok_info(int m, int& n, int& qpos) {
    if (m < MP) { n = m >> 11; qpos = m & 2047; }
    else { int j = m - MP; n = 4 + (j >> 3); qpos = 2048 + (j & 7); }
}

__device__ __forceinline__ int q_next(unsigned* qctr, int cur, int bid, int nb, unsigned char* smem) {
    if (!qctr) return cur < 0 ? bid : cur + nb;
    volatile int* s_q = (volatile int*)(smem + LDS_STAGE + 48);
    __syncthreads();
    if (threadIdx.x == 0) *s_q = (int)__hip_atomic_fetch_add(qctr, 1u, __ATOMIC_RELAXED, __HIP_MEMORY_SCOPE_AGENT);
    __syncthreads();
    return *s_q;
}

__device__ __forceinline__ void tr_item(const float* W, int K, int N, bf16_t* WT, float* scr, int item, int lane, bool perm_in = false) {
    const int nblk = (N + 31) / 32, kb = item / nblk, nbk = item % nblk, k0 = 64 * kb, n0 = 32 * nbk;
    const int nn = n0 + (lane & 31);
    float wv[32];
#pragma unroll
    for (int i = 0; i < 32; ++i) wv[i] = nn < N ? W[(size_t)(k0 + 2 * i + (lane >> 5)) * N + nn] : 0.f;
#pragma unroll
    for (int i = 0; i < 32; ++i) scr[(2 * i + (lane >> 5)) * 33 + (lane & 31)] = wv[i];
    asm volatile("s_waitcnt lgkmcnt(0)" ::: "memory");
    const int c = lane & 7;
#pragma unroll
    for (int j = 0; j < 4; ++j) {
        const int n = (lane >> 3) + 8 * j;
        const float* s = scr + (8 * c) * 33 + n;
        uint4 o;
        o.x = pk2(s[0 * 33], s[1 * 33]); o.y = pk2(s[2 * 33], s[3 * 33]);
        o.z = pk2(s[4 * 33], s[5 * 33]); o.w = pk2(s[6 * 33], s[7 * 33]);
        int nr = n0 + n;
        if (perm_in) nr = nr < 3608 ? nr + NPF : (nr < 6680 ? nr - 3608 : nr);
        if (n0 + n < N) *(uint4*)(WT + (size_t)nr * K + k0 + 8 * c) = o;
    }
    asm volatile("s_waitcnt lgkmcnt(0)" ::: "memory");
}

__device__ __forceinline__ void ph_prologue(const Params& p, int bid, int nb, float* lds) {
    const int tid = threadIdx.x, lane = tid & 63, wave = tid >> 6;
    for (int r = (bid + nb - 64 % nb) % nb; r < 64; r += nb) {
        const int kvsel = r >> 5, l = r & 31;
        const float* W = (kvsel ? p.w_cmp_v : p.w_cmp_k) + (size_t)l * 128 * 128;
        const float* pe = (kvsel ? p.pe_v : p.pe_k) + l * 128;
        const int dsub = lane >> 5, e4 = lane & 31;
        pg8::f32x4 wv4[8]; float pv[8];
#pragma unroll
        for (int i = 0; i < 8; ++i) { const int d = 16 * wave + 2 * i + dsub; wv4[i] = *(const pg8::f32x4*)(W + d * 128 + 4 * e4); pv[i] = pe[d]; }
        pg8::f32x4 a4 = {0.f, 0.f, 0.f, 0.f};
#pragma unroll
        for (int i = 0; i < 8; ++i) a4 += wv4[i] * pv[i];
#pragma unroll
        for (int c = 0; c < 4; ++c) a4[c] += __shfl_xor(a4[c], 32, 64);
        if (lane < 32) *(pg8::f32x4*)(lds + wave * 128 + 4 * e4) = a4;
        __syncthreads();
        if (tid < 128) {
            float sum = 0.f;
#pragma unroll
            for (int w = 0; w < 8; ++w) sum += lds[w * 128 + tid];
            p.PEB[r * 128 + tid] = sum;
        }
        __syncthreads();
    }
    {
        float* scr = lds + wave * (64 * 33 + 16);
        const int gw = bid * 8 + wave, ngw = nb * 8;
        const int I_IN = 32 * ((NIN + 31) / 32), I_OUT = 32 * 64, I_C = 4 * 128;
        for (int it = gw; it < I_IN + I_OUT + I_C; it += ngw) {
            if (it < I_IN) tr_item(p.w_in, D, NIN, p.Wt_in, scr, it, lane, true);
            else if (it < I_IN + I_OUT) tr_item(p.w_out, 2048, D, p.Wt_out, scr, it - I_IN, lane);
            else {
                const int r = it - I_IN - I_OUT, q = r >> 7, kvsel = q >> 1, hh = q & 1;
                const float* W = (kvsel ? p.w_cmp_v : p.w_cmp_k) + (size_t)hh * 2048 * 128;
                tr_item(W, 2048, 128, p.Wc_t + ((size_t)kvsel * 256 + hh * 128) * 2048, scr, r & 127, lane);
            }
        }
    }
    __syncthreads();
    {
        const int gw = bid * 8 + wave, ngw = nb * 8;
        float4 gn[8];
#pragma unroll
        for (int j = 0; j < 8; ++j) gn[j] = ((const float4*)p.g_norm)[lane + 64 * j];
        for (int m = gw; m < M; m += 2 * ngw) {
            const int m1 = m + ngw;
            const bool has1 = m1 < M;
            const float4* x0 = (const float4*)xrow(p, m);
            const float4* x1 = (const float4*)xrow(p, has1 ? m1 : m);
            float4 v0[8], v1[8];
#pragma unroll
            for (int j = 0; j < 8; ++j) { v0[j] = x0[lane + 64 * j]; v1[j] = x1[lane + 64 * j]; }
            float s0 = 0.f, s1 = 0.f;
#pragma unroll
            for (int j = 0; j < 8; ++j) {
                s0 += v0[j].x * v0[j].x + v0[j].y * v0[j].y + v0[j].z * v0[j].z + v0[j].w * v0[j].w;
                s1 += v1[j].x * v1[j].x + v1[j].y * v1[j].y + v1[j].z * v1[j].z + v1[j].w * v1[j].w;
            }
            s0 = wave_sum(s0); s1 = wave_sum(s1);
            const float r0 = rsqrtf(s0 * (1.0f / D) + EPS), r1 = rsqrtf(s1 * (1.0f / D) + EPS);
            uint2* o0 = (uint2*)(p.Hb + (size_t)m * D);
            uint2* o1 = (uint2*)(p.Hb + (size_t)m1 * D);
#pragma unroll
            for (int j = 0; j < 8; ++j) {
                const float4 g = gn[j];
                o0[lane + 64 * j] = make_uint2(pk2(v0[j].x * r0 * g.x, v0[j].y * r0 * g.y), pk2(v0[j].z * r0 * g.z, v0[j].w * r0 * g.w));
                if (has1) o1[lane + 64 * j] = make_uint2(pk2(v1[j].x * r1 * g.x, v1[j].y * r1 * g.y), pk2(v1[j].z * r1 * g.z, v1[j].w * r1 * g.w));
            }
        }
    }
}

__device__ __forceinline__ void ph_wincopy(const Params& p, int bid, int nb, unsigned char* smem = nullptr, unsigned* qctr = nullptr) {
    const int tid = threadIdx.x;
    {
        const float4* srcw = (const float4*)(p.cache_win + 8 * 512);
        float4* dstw = (float4*)(p.out + O_WIN_S);
#define WC_IDX(j) ({ const unsigned i_ = (unsigned)ck * 4096u + (unsigned)(j) * 512u + (unsigned)tid; const unsigned sq_ = i_ / 64512u; sq_ * 65536u + (i_ - sq_ * 64512u); })
        for (int ck = q_next(qctr, -1, bid, nb, smem); ck < 2016; ck = q_next(qctr, ck, bid, nb, smem)) {
            const unsigned i0 = WC_IDX(0), i1 = WC_IDX(1), i2 = WC_IDX(2), i3 = WC_IDX(3), i4 = WC_IDX(4), i5 = WC_IDX(5), i6 = WC_IDX(6), i7 = WC_IDX(7);
            typedef pg8::f32x4 f4;
            const f4* sw_ = (const f4*)srcw; f4* dw_ = (f4*)dstw;
            const f4 w0 = __builtin_nontemporal_load(sw_ + i0), w1 = __builtin_nontemporal_load(sw_ + i1), w2 = __builtin_nontemporal_load(sw_ + i2), w3 = __builtin_nontemporal_load(sw_ + i3),
                     w4 = __builtin_nontemporal_load(sw_ + i4), w5 = __builtin_nontemporal_load(sw_ + i5), w6 = __builtin_nontemporal_load(sw_ + i6), w7 = __builtin_nontemporal_load(sw_ + i7);
            __builtin_nontemporal_store(w0, dw_ + i0); __builtin_nontemporal_store(w1, dw_ + i1); __builtin_nontemporal_store(w2, dw_ + i2); __builtin_nontemporal_store(w3, dw_ + i3);
            __builtin_nontemporal_store(w4, dw_ + i4); __builtin_nontemporal_store(w5, dw_ + i5); __builtin_nontemporal_store(w6, dw_ + i6); __builtin_nontemporal_store(w7, dw_ + i7);
        }
#undef WC_IDX
    }
}

__device__ __forceinline__ void post_token(const Params& p, const int m, const float2 (&v)[20], const float gt, const int lane, const int l2,
                                           const float2 gq, const float2 gs, const float2 gwn) {
        float ss[20];
#pragma unroll
        for (int ch = 0; ch < 20; ++ch) ss[ch] = v[ch].x * v[ch].x + v[ch].y * v[ch].y;
#pragma unroll
        for (int o = 32; o >= 1; o >>= 1) {
#pragma unroll
            for (int ch = 0; ch < 20; ++ch) ss[ch] += __shfl_xor(ss[ch], o, 64);
        }
#pragma unroll
        for (int ch = 0; ch < 8; ++ch) {
            const float r = rsqrtf(ss[ch] * (1.0f / 128) + EPS) * 0.08838834764831845f;
            *(unsigned*)&p.Qb[(size_t)m * 1024 + ch * 128 + l2] = pk2(v[ch].x * r * gq.x, v[ch].y * r * gq.y);
        }
#pragma unroll
        for (int c = 0; c < 12; ++c) {
            const int br = c >> 2, kv = (c >> 1) & 1, gg = c & 1;
            float2 w = v[8 + c];
            if (br >= 1 && kv == 0) {
                const float r = rsqrtf(ss[8 + c] * (1.0f / 128) + EPS);
                const float2 gk = (br == 1) ? gs : gwn;
                w.x *= r * gk.x; w.y *= r * gk.y;
            }
            const int sub = (c & 3) * 128 + l2;
            if (m < MP) {
                const int b = m >> 11, t = m & 2047;
                if (br >= 1)
                    *(unsigned*)&p.KVb[((((size_t)((br - 1) * 2 + kv) * 4 + b) * 2 + gg) * 2048 + t) * 128 + l2] = pk2(w.x, w.y);
                if (br == 0) *(float2*)&p.out[O_CMP_P + (size_t)m * 512 + sub] = w;
                else if (br == 1) *(float2*)&p.out[O_SLC_P + (size_t)m * 512 + sub] = w;
                else if (t >= 1536) *(float2*)&p.out[O_WIN_P + ((size_t)b * 512 + (t - 1536)) * 512 + sub] = w;
            } else {
                const int j = m - MP;
                if (br == 0) *(float2*)&p.out[O_CMP_S + (size_t)j * 512 + sub] = w;
                else if (br == 1) *(float2*)&p.out[O_SLC_S + (size_t)j * 512 + sub] = w;
                else *(float2*)&p.out[O_WIN_S + ((size_t)(j >> 3) * 512 + 504 + (j & 7)) * 512 + sub] = w;
            }
        }
        if (lane < 24) p.GATE[(size_t)m * 24 + lane] = sigmoidf_(gt);
}

__device__ __forceinline__ void ph_post(const Params& p, int bid, int nb) {
    const int lane = threadIdx.x & 63, wave = threadIdx.x >> 6;
    const int gw = bid * 8 + wave, ngw = nb * 8;
    const int l2 = lane * 2;
    const float2 gq = *(const float2*)&p.g_q[l2], gs = *(const float2*)&p.g_k_slc[l2], gwn = *(const float2*)&p.g_k_win[l2];
    for (int m = gw; m < M; m += 2 * ngw) {
        const int m1 = m + ngw;
        const bool has1 = m1 < M;
        const bf16_t* row0 = p.PH + (size_t)m * LDH;
        const bf16_t* row1 = p.PH + (size_t)(has1 ? m1 : m) * LDH;
        float2 v0[20], v1[20];
#pragma unroll
        for (int ch = 0; ch < 20; ++ch) {
            const int col = (ch < 8 ? C_QA + ch * 128 : C_KV + (ch - 8) * 128) + l2;
            const unsigned u0 = *(const unsigned*)&row0[col], u1 = *(const unsigned*)&row1[col];
            v0[ch] = make_float2(bflo(u0), bfhi(u0)); v1[ch] = make_float2(bflo(u1), bfhi(u1));
        }
        const float gt0 = (lane < 24) ? bflo((unsigned)row0[C_GATE + lane]) : 0.f, gt1 = (lane < 24) ? bflo((unsigned)row1[C_GATE + lane]) : 0.f;
        post_token(p, m, v0, gt0, lane, l2, gq, gs, gwn);
        if (has1) post_token(p, m1, v1, gt1, lane, l2, gq, gs, gwn);
    }
}

__device__ __forceinline__ void ph_cmp_mfma(const Params& p, int limit, bool early_stop, unsigned char* smem, int maxu = 1 << 30) {
    typedef pg8::bf16x8 bf16x8;
    typedef pg8::f32x4 f32x4;
    const int tid = threadIdx.x, lane = tid & 63, wid = tid >> 6, wm = wid >> 2, wn = wid & 3, fr = lane & 15, fq = lane >> 4;
    const int arow0 = tid >> 5, apc = tid & 31;
    const int brow0 = tid >> 4, bpc = tid & 15;
    float* Cs = (float*)smem;
    unsigned char* bufA = smem;
    unsigned char* bufB = smem + 32768;
    volatile int* s_u = (volatile int*)(smem + LDS_STAGE + 32);
    for (int nu = 0;; ++nu) {
        __syncthreads();
        if (tid == 0) {
            int uu = limit;
            if (nu < maxu && !(early_stop && __hip_atomic_load(&p.ctr[64], __ATOMIC_RELAXED, __HIP_MEMORY_SCOPE_AGENT) != 0u)) {
                uu = (int)__hip_atomic_fetch_add(&p.ctr[0], 1u, __ATOMIC_RELAXED, __HIP_MEMORY_SCOPE_AGENT);
                if (uu >= limit && limit < NSEQ * 4) {
                    (void)__hip_atomic_fetch_sub(&p.ctr[0], 1u, __ATOMIC_RELAXED, __HIP_MEMORY_SCOPE_AGENT);
                    uu = limit;
                }
            }
            *s_u = uu;
        }
        __syncthreads();
        const int u = *s_u;
        if (u >= limit) break;
        const int n = (u < 512) ? 4 + (u >> 2) : ((u - 512) >> 2);
        const int g = (u >> 1) & 1, kvsel = u & 1;
        const float* abase[8]; size_t lstride;
        if (n >= 4) {
            lstride = 512;
#pragma unroll
            for (int j = 0; j < 8; ++j) {
                const int ar = arow0 + 16 * j;
                const int page = p.page_table[(n - 4) * 16 + (ar >> 3)];
                abase[j] = p.cache_cmp + ((((size_t)page * 128 + 16 * (ar & 7)) * 2 + kvsel) * 2 + g) * 128 + apc * 4;
            }
        } else {
            lstride = LDH / 2;
#pragma unroll
            for (int j = 0; j < 8; ++j)
                abase[j] = (const float*)(p.PH + ((size_t)n * 2048 + 16 * (arow0 + 16 * j)) * LDH + C_KV + kvsel * 256 + g * 128 + (apc & ~1) * 4);
        }
        const bool a16 = (n < 4);
        const bf16_t* bbase = p.Wc_t + ((size_t)kvsel * 256 + brow0) * 2048 + bpc * 8;
        f32x4 acc[4][4];
#pragma unroll
        for (int m = 0; m < 4; ++m)
#pragma unroll
            for (int q = 0; q < 4; ++q) acc[m][q] = (f32x4){0.f, 0.f, 0.f, 0.f};
        f32x4 ra[8]; pg8::u32x4 rb[8];
#pragma unroll
        for (int j = 0; j < 8; ++j) {
            ra[j] = __builtin_nontemporal_load((const f32x4*)abase[j]);
            rb[j] = *(const pg8::u32x4*)(bbase + (size_t)32 * j * 2048);
        }
        for (int ss = 0; ss < 16; ++ss) {
#pragma unroll
            for (int j = 0; j < 8; ++j) {
                const int ar = arow0 + 16 * j, br = brow0 + 32 * j;
                if (a16) { if (!(apc & 1)) *(f32x4*)(bufA + ar * 256 + ((((unsigned)apc >> 1) ^ (unsigned)(ar & 15)) << 4)) = ra[j]; }
                else *(uint2*)(bufA + ar * 256 + ((((unsigned)apc >> 1) ^ (unsigned)(ar & 15)) << 4) + 8 * (apc & 1)) =
                    make_uint2(pk2(ra[j][0], ra[j][1]), pk2(ra[j][2], ra[j][3]));
                *(pg8::u32x4*)(bufB + br * 256 + (((unsigned)bpc ^ (unsigned)(br & 15)) << 4)) = rb[j];
            }
            __syncthreads();
            if (ss + 1 < 16) {
#pragma unroll
                for (int j = 0; j < 8; ++j) {
                    ra[j] = __builtin_nontemporal_load((const f32x4*)(abase[j] + (size_t)(ss + 1) * lstride));
                    rb[j] = *(const pg8::u32x4*)(bbase + (size_t)32 * j * 2048 + (ss + 1) * 128);
                }
            }
#pragma unroll
            for (int sub = 0; sub < 4; ++sub) {
                bf16x8 Af[4], Bf[4];
#pragma unroll
                for (int m = 0; m < 4; ++m) {
                    const int r = wm * 64 + 16 * m + fr;
                    Af[m] = *(const bf16x8*)(bufA + r * 256 + (((unsigned)(4 * sub + fq) ^ (unsigned)(r & 15)) << 4));
                }
#pragma unroll
                for (int q = 0; q < 4; ++q) {
                    const int r = wn * 64 + 16 * q + fr;
                    Bf[q] = *(const bf16x8*)(bufB + r * 256 + (((unsigned)(4 * sub + fq) ^ (unsigned)(r & 15)) << 4));
                }
#pragma unroll
                for (int m = 0; m < 4; ++m)
#pragma unroll
                    for (int q = 0; q < 4; ++q)
                        acc[m][q] = __builtin_amdgcn_mfma_f32_16x16x32_bf16(Bf[q], Af[m], acc[m][q], 0, 0, 0);
            }
            __syncthreads();
        }
        __syncthreads();
#pragma unroll
        for (int m = 0; m < 4; ++m)
#pragma unroll
            for (int q = 0; q < 4; ++q)
                *(f32x4*)(Cs + (wm * 64 + 16 * m + fr) * 260 + wn * 64 + 16 * q + 4 * fq) = acc[m][q];
        __syncthreads();
        {
            float pb0 = 0.f, pb1 = 0.f;
            for (int l = 0; l < 32; ++l) {
                pb0 += p.PEB[(kvsel * 32 + l) * 128 + lane];
                pb1 += p.PEB[(kvsel * 32 + l) * 128 + lane + 64];
            }
            bf16_t* dst = (kvsel ? p.VCb : p.KCb) + ((size_t)(n * 2 + g) * 128) * 128;
            const float g0 = p.g_k_cmp[lane], g1 = p.g_k_cmp[lane + 64];
            for (int c = wid; c < 128; c += 8) {
                float v0 = 0.f, v1 = 0.f;
                if (c < NCMP) {
                    v0 = Cs[c * 260 + lane] + Cs[(c + 1) * 260 + 128 + lane] + pb0;
                    v1 = Cs[c * 260 + lane + 64] + Cs[(c + 1) * 260 + 192 + lane] + pb1;
                    if (kvsel == 0) {
                        const float ss = wave_sum(v0 * v0 + v1 * v1);
                        const float rr = rsqrtf(ss * (1.0f / 128) + EPS);
                        v0 *= rr * g0; v1 *= rr * g1;
                    }
                }
                const unsigned pk = pk2(v0, v1);
                dst[c * 128 + lane] = (bf16_t)(pk & 0xffffu);
                dst[c * 128 + lane + 64] = (bf16_t)(pk >> 16);
            }
        }
        __syncthreads();
    }
}

__device__ __forceinline__ unsigned fvsw(int row) { return (unsigned)(((row & 3) << 2) | (((row >> 2) & 1) << 1) | ((row >> 3) & 1)); }

__device__ __forceinline__ void ph_cmp_attn_mfma(const Params& p, int bid, int nb, unsigned char* smem) {
    typedef pg8::bf16x8 bf16x8;
    typedef pg8::f32x4 f32x4;
    typedef short s16x4 __attribute__((ext_vector_type(4)));
    const int tid = threadIdx.x, lane = tid & 63, wid = tid >> 6, fr = lane & 15, fq = lane >> 4, hl = fr & 3;
    unsigned char* Kb = smem;
    unsigned char* Vb = smem + 32768;
    float* bt = (float*)(smem + 65536);
    float* sA = (float*)(smem + 65536 + 2048);
    float* sB = sA + 1024;
    float* skey = sB + 1024;
    unsigned long long* smask = (unsigned long long*)(skey + 32 * 36);
    for (int it = bid; it < 512 + 256; it += nb) {
        int n, g, m0, qpos0, ntok;
        if (it < 512) { const int bg = it >> 6; n = bg >> 1; g = bg & 1; const int qt = it & 63; m0 = n * 2048 + qt * 32; qpos0 = qt * 32; ntok = 32; }
        else { const int j = it - 512; const int sq = j >> 1; g = j & 1; n = 4 + sq; m0 = MP + sq * 8; qpos0 = 2048; ntok = 8; }
        const int tl = (ntok == 32) ? 4 * wid + (fr >> 2) : 4 * (wid & 1) + (fr >> 2);
        const bool wr = (ntok == 32) || (wid < 2);
        const int m = m0 + tl, tq = qpos0 + tl;
        __syncthreads();
        bf16x8 Qf[4];
        {
            const int row = tid >> 2;
            const bf16_t* kc = p.KCb + ((size_t)(n * 2 + g) * 128 + row) * 128;
            const bf16_t* vc = p.VCb + ((size_t)(n * 2 + g) * 128 + row) * 128;
            pg8::u32x4 kk[4], vk[4];
#pragma unroll
            for (int jj = 0; jj < 4; ++jj) {
                const unsigned ch = (unsigned)((tid & 3) * 4 + jj);
                kk[jj] = *(const pg8::u32x4*)(kc + ch * 8);
                vk[jj] = *(const pg8::u32x4*)(vc + ch * 8);
            }
            const float btv = p.rel_bias[rel_bucket(tid & 127) * 8 + g * 4 + (tid >> 7)];
            const bf16_t* qp = p.Qb + (size_t)m * 1024 + (g * 4 + hl) * 128 + 8 * fq;
#pragma unroll
            for (int sx = 0; sx < 4; ++sx) Qf[sx] = *(const bf16x8*)(qp + 32 * sx);
            asm volatile("" : "+v"(kk[0]), "+v"(kk[1]), "+v"(kk[2]), "+v"(kk[3]), "+v"(vk[0]), "+v"(vk[1]), "+v"(vk[2]), "+v"(vk[3]) :: "memory");
            bt[tid] = btv;
            if (tid < 32) smask[tid] = 0ull;
#pragma unroll
            for (int jj = 0; jj < 4; ++jj) {
                const unsigned ch = (unsigned)((tid & 3) * 4 + jj);
                *(pg8::u32x4*)(Kb + row * 256 + ((ch ^ (unsigned)(row & 15)) << 4)) = kk[jj];
                *(pg8::u32x4*)(Vb + row * 256 + ((ch ^ fvsw(row)) << 4)) = vk[jj];
            }
        }
        __syncthreads();
        f32x4 S[8];
#pragma unroll
        for (int nt = 0; nt < 8; ++nt) {
            const int r = 16 * nt + fr;
            S[nt] = (f32x4){0.f, 0.f, 0.f, 0.f};
#pragma unroll
            for (int sx = 0; sx < 4; ++sx) {
                const bf16x8 Kf = *(const bf16x8*)(Kb + r * 256 + (((unsigned)(4 * sx + fq) ^ (unsigned)(r & 15)) << 4));
                S[nt] = __builtin_amdgcn_mfma_f32_16x16x32_bf16(Kf, Qf[sx], S[nt], 0, 0, 0);
            }
        }
        float tmax = -INFINITY;
#pragma unroll
        for (int nt = 0; nt < 8; ++nt)
#pragma unroll
            for (int i = 0; i < 4; ++i) {
                const int c = 16 * nt + 4 * fq + i;
                const int dist = tq - (16 * c + 31);
                const bool valid = dist >= 0 && c < NCMP;
                const float bias = bt[hl * 128 + (dist < 0 ? 0 : (dist > 127 ? 127 : dist))];
                const float sv = valid ? S[nt][i] + bias : -INFINITY;
                S[nt][i] = sv;
                tmax = fmaxf(tmax, sv);
            }
        tmax = fmaxf(tmax, __shfl_xor(tmax, 16, 64));
        tmax = fmaxf(tmax, __shfl_xor(tmax, 32, 64));
        const bool dead = (tmax == -INFINITY);
        float psum = 0.f;
#pragma unroll
        for (int nt = 0; nt < 8; ++nt)
#pragma unroll
            for (int i = 0; i < 4; ++i) {
                const float pv = dead ? 0.f : __expf(S[nt][i] - tmax);
                S[nt][i] = pv;
                psum += pv;
            }
        psum += __shfl_xor(psum, 16, 64);
        psum += __shfl_xor(psum, 32, 64);
        const float inv = psum > 0.f ? 1.0f / psum : 0.f;
#pragma unroll
        for (int nt = 0; nt < 8; ++nt) { S[nt][0] *= inv; S[nt][1] *= inv; S[nt][2] *= inv; S[nt][3] *= inv; }
#pragma unroll
        for (int nt = 0; nt < 8; ++nt) {
            float av = 2.f * (S[nt][0] + S[nt][1] + S[nt][2]) + S[nt][3];
            float bv = S[nt][3];
            av += __shfl_xor(av, 1, 64); av += __shfl_xor(av, 2, 64);
            bv += __shfl_xor(bv, 1, 64); bv += __shfl_xor(bv, 2, 64);
            if (hl == 0 && wr) { sA[tl * 32 + 4 * nt + fq] = av; sB[tl * 32 + 4 * nt + fq] = bv; }
        }
        f32x4 O[8];
#pragma unroll
        for (int c = 0; c < 8; ++c) O[c] = (f32x4){0.f, 0.f, 0.f, 0.f};
#pragma unroll
        for (int ks = 0; ks < 4; ++ks) {
            union { unsigned u[4]; bf16x8 v; } cv;
            cv.u[0] = pk2(S[2 * ks][0], S[2 * ks][1]); cv.u[1] = pk2(S[2 * ks][2], S[2 * ks][3]);
            cv.u[2] = pk2(S[2 * ks + 1][0], S[2 * ks + 1][1]); cv.u[3] = pk2(S[2 * ks + 1][2], S[2 * ks + 1][3]);
            const bf16x8 Pf = cv.v;
#pragma unroll
            for (int c = 0; c < 8; ++c) {
                const int r0 = 32 * ks + 4 * fq + (fr >> 2), r1 = r0 + 16;
                const unsigned ch = (unsigned)(2 * c + ((fr & 3) >> 1));
                const s16x4 a0 = __builtin_amdgcn_ds_read_tr16_b64_v4i16((__attribute__((address_space(3))) s16x4*)(Vb + r0 * 256 + ((ch ^ fvsw(r0)) << 4) + 8 * (fr & 1)));
                const s16x4 a1 = __builtin_amdgcn_ds_read_tr16_b64_v4i16((__attribute__((address_space(3))) s16x4*)(Vb + r1 * 256 + ((ch ^ fvsw(r1)) << 4) + 8 * (fr & 1)));
                const bf16x8 Vf = {a0[0], a0[1], a0[2], a0[3], a1[0], a1[1], a1[2], a1[3]};
                O[c] = __builtin_amdgcn_mfma_f32_16x16x32_bf16(Vf, Pf, O[c], 0, 0, 0);
            }
        }
        if (wr) {
            bf16_t* op = p.OC + (size_t)m * 1024 + (g * 4 + hl) * 128 + 4 * fq;
#pragma unroll
            for (int c = 0; c < 8; ++c) *(uint2*)(op + 16 * c) = make_uint2(pk2(O[c][0], O[c][1]), pk2(O[c][2], O[c][3]));
        }
        __syncthreads();
        const int tokl = tid >> 4, jb = 2 * (tid & 15);
        const bool active = tokl < ntok;
        const int cur = (qpos0 + tokl) >> 6;
#pragma unroll
        for (int e = 0; e < 2; ++e) {
            const int j = jb + e;
            const float scv = sA[tokl * 32 + j] + (j > 0 ? sB[tokl * 32 + j - 1] : 0.f);
            const bool valid = j <= cur;
            const bool forced = (j == 0) || (j == cur) || (j == cur - 1);
            skey[tokl * 36 + j] = (active && valid) ? (forced ? INFINITY : scv) : -INFINITY;
        }
        if ((tid & 15) == 0) skey[tokl * 36 + 32] = (ntok == 8) ? INFINITY : -INFINITY;
        __syncthreads();
        const int nslc = (ntok == 32) ? 32 : 33;
#pragma unroll
        for (int e = 0; e < 2; ++e) {
            const int j = jb + e;
            const float key = skey[tokl * 36 + j];
            int rank = 0;
            for (int j2 = 0; j2 < nslc; ++j2) {
                const float k2 = skey[tokl * 36 + j2];
                rank += (k2 > key) || (k2 == key && j2 < j);
            }
            if (active && rank < 16 && j <= cur) atomicOr(&smask[tokl], 1ull << j);
        }
        if (ntok == 8 && active && (tid & 15) == 0) atomicOr(&smask[tokl], 1ull << 32);
        __syncthreads();
        if (tid < ntok) p.SEL[(m0 + tid) * 2 + g] = smask[tid];
    }
}


template <int BR>
__device__ __forceinline__ void ph_attn_prompt(const Params& p, int bid, int nb, unsigned char* smem, unsigned* qctr = nullptr) {
    typedef pg8::bf16x8 bf16x8;
    typedef pg8::f32x4 f32x4;
    typedef short s16x4 __attribute__((ext_vector_type(4)));
    const int tid = threadIdx.x, lane = tid & 63, wid = tid >> 6, fr = lane & 15, fq = lane >> 4, hl = fr & 3;
    float* bt = (float*)(smem + 65536);
    const int srow = tid >> 4, spc = tid & 15;
    const unsigned ksw = (unsigned)(srow & 15), vsw = fvsw(srow);
    for (int pi = q_next(qctr, -1, bid, nb, smem); pi < 256; pi = q_next(qctr, pi, bid, nb, smem)) {
        const int bg = pi >> 5, b = bg >> 1, g = bg & 1, a = pi & 31;
        __syncthreads();
        bt[tid] = p.rel_bias[rel_bucket(tid & 127) * 8 + g * 4 + (tid >> 7)];
        float b31 = p.rel_bias[31 * 8 + g * 4 + hl];
        const bf16_t* Kg = p.KVb + ((((size_t)(BR * 2 + 0) * 4 + b) * 2 + g) * 2048) * 128;
        const bf16_t* Vg = p.KVb + ((((size_t)(BR * 2 + 1) * 4 + b) * 2 + g) * 2048) * 128;
        bf16_t* Og = (BR == 0) ? p.OS : p.OW;
        for (int half = 0; half < 2; ++half) {
            const int qt = half ? 63 - a : a, t0 = qt * 32;
            const int tq = t0 + 4 * wid + (fr >> 2);
            const int m = b * 2048 + tq;
            bf16x8 Qf[4];
            {
                const bf16_t* qp = p.Qb + (size_t)m * 1024 + (g * 4 + hl) * 128 + 8 * fq;
#pragma unroll
                for (int sx = 0; sx < 4; ++sx) Qf[sx] = *(const bf16x8*)(qp + 32 * sx);
            }
            unsigned selmask = (BR == 0) ? (unsigned)p.SEL[m * 2 + g] : 0u;
            asm volatile("" : "+v"(Qf[0]), "+v"(Qf[1]), "+v"(Qf[2]), "+v"(Qf[3]), "+v"(b31), "+v"(selmask) :: "memory");
            const int jhi = (t0 + 31) >> 6;
            const int jlo = (BR == 0) ? 0 : ((t0 - 512) > 0 ? ((t0 - 512) >> 6) : 0);
            f32x4 O[8];
#pragma unroll
            for (int c = 0; c < 8; ++c) O[c] = (f32x4){0.f, 0.f, 0.f, 0.f};
            float mrun = -INFINITY, lrun = 0.f;
            typedef pg8::u32x4 u32x4;
            u32x4 kr[2][2], vr[2][2];
#pragma unroll
            for (int par = 0; par < 2; ++par) {
                if (jlo + par <= jhi) {
                    const bf16_t* kp = Kg + ((size_t)(jlo + par) * 64 + srow) * 128 + spc * 8;
                    const bf16_t* vp = Vg + ((size_t)(jlo + par) * 64 + srow) * 128 + spc * 8;
                    kr[par][0] = *(const u32x4*)kp; kr[par][1] = *(const u32x4*)(kp + 32 * 128);
                    vr[par][0] = *(const u32x4*)vp; vr[par][1] = *(const u32x4*)(vp + 32 * 128);
                } else { kr[par][0] = kr[par][1] = vr[par][0] = vr[par][1] = (u32x4){0u, 0u, 0u, 0u}; }
            }
            __syncthreads();
            for (int jj = jlo; jj <= jhi; jj += 2) {
#pragma unroll
              for (int par = 0; par < 2; ++par) {
                const int j = jj + par;
                if (j > jhi) break;
                unsigned char* Kb = smem + par * 32768;
                unsigned char* Vb = Kb + 16384;
                *(u32x4*)(Kb + srow * 256 + (((unsigned)spc ^ ksw) << 4)) = kr[par][0];
                *(u32x4*)(Kb + (srow + 32) * 256 + (((unsigned)spc ^ ksw) << 4)) = kr[par][1];
                *(u32x4*)(Vb + srow * 256 + (((unsigned)spc ^ vsw) << 4)) = vr[par][0];
                *(u32x4*)(Vb + (srow + 32) * 256 + (((unsigned)spc ^ vsw) << 4)) = vr[par][1];
                __syncthreads();
                if (j + 2 <= jhi) {
                    const bf16_t* kp = Kg + ((size_t)(j + 2) * 64 + srow) * 128 + spc * 8;
                    const bf16_t* vp = Vg + ((size_t)(j + 2) * 64 + srow) * 128 + spc * 8;
                    kr[par][0] = *(const u32x4*)kp; kr[par][1] = *(const u32x4*)(kp + 32 * 128);
                    vr[par][0] = *(const u32x4*)vp; vr[par][1] = *(const u32x4*)(vp + 32 * 128);
                }
                const int kbase = j * 64;
                f32x4 S[4];
#pragma unroll
                for (int nt = 0; nt < 4; ++nt) {
                    const int r = 16 * nt + fr;
                    S[nt] = (f32x4){0.f, 0.f, 0.f, 0.f};
#pragma unroll
                    for (int sx = 0; sx < 4; ++sx) {
                        const bf16x8 Kf = *(const bf16x8*)(Kb + r * 256 + (((unsigned)(4 * sx + fq) ^ (unsigned)(r & 15)) << 4));
                        S[nt] = __builtin_amdgcn_mfma_f32_16x16x32_bf16(Kf, Qf[sx], S[nt], 0, 0, 0);
                    }
                }
                const bool far = (t0 - (kbase + 63)) >= 113;
                const bool selok = (BR == 0) ? (((selmask >> j) & 1u) != 0u) : true;
                float tmax = -INFINITY;
                if (far && (BR == 0 || (t0 + 31 - kbase) <= 512)) {
                    const float add = selok ? b31 : -INFINITY;
#pragma unroll
                    for (int nt = 0; nt < 4; ++nt)
#pragma unroll
                        for (int i = 0; i < 4; ++i) { const float sv = S[nt][i] + add; S[nt][i] = sv; tmax = fmaxf(tmax, sv); }
                } else {
#pragma unroll
                for (int nt = 0; nt < 4; ++nt)
#pragma unroll
                    for (int i = 0; i < 4; ++i) {
                        const int dist = tq - (kbase + 16 * nt + 4 * fq + i);
                        bool valid = selok && dist >= 0;
                        if (BR == 1) valid = valid && dist <= 512;
                        const float bias = far ? b31 : bt[hl * 128 + (dist < 0 ? 0 : (dist > 127 ? 127 : dist))];
                        const float sv = valid ? S[nt][i] + bias : -INFINITY;
                        S[nt][i] = sv;
                        tmax = fmaxf(tmax, sv);
                    }
                }
                tmax = fmaxf(tmax, __shfl_xor(tmax, 16, 64));
                tmax = fmaxf(tmax, __shfl_xor(tmax, 32, 64));
                const float mnew = fmaxf(mrun, tmax);
                const bool dead = (mnew == -INFINITY);
                const float scale = (mrun == -INFINITY) ? 0.f : __expf(mrun - mnew);
                float psum = 0.f;
#pragma unroll
                for (int nt = 0; nt < 4; ++nt)
#pragma unroll
                    for (int i = 0; i < 4; ++i) {
                        const float pv = dead ? 0.f : __expf(S[nt][i] - mnew);
                        S[nt][i] = pv;
                        psum += pv;
                    }
                lrun = lrun * scale + psum;
                mrun = mnew;
#pragma unroll
                for (int c = 0; c < 8; ++c) { O[c][0] *= scale; O[c][1] *= scale; O[c][2] *= scale; O[c][3] *= scale; }
                bf16x8 Pf[2];
#pragma unroll
                for (int ks = 0; ks < 2; ++ks) {
                    union { unsigned u[4]; bf16x8 v; } cv;
                    cv.u[0] = pk2(S[2 * ks][0], S[2 * ks][1]); cv.u[1] = pk2(S[2 * ks][2], S[2 * ks][3]);
                    cv.u[2] = pk2(S[2 * ks + 1][0], S[2 * ks + 1][1]); cv.u[3] = pk2(S[2 * ks + 1][2], S[2 * ks + 1][3]);
                    Pf[ks] = cv.v;
                }
#pragma unroll
                for (int c = 0; c < 8; ++c)
#pragma unroll
                    for (int ks = 0; ks < 2; ++ks) {
                        const int r0 = 32 * ks + 4 * fq + (fr >> 2), r1 = r0 + 16;
                        const unsigned ch = (unsigned)(2 * c + ((fr & 3) >> 1));
                        const s16x4 v0 = __builtin_amdgcn_ds_read_tr16_b64_v4i16((__attribute__((address_space(3))) s16x4*)(Vb + r0 * 256 + ((ch ^ fvsw(r0)) << 4) + 8 * (fr & 1)));
                        const s16x4 v1 = __builtin_amdgcn_ds_read_tr16_b64_v4i16((__attribute__((address_space(3))) s16x4*)(Vb + r1 * 256 + ((ch ^ fvsw(r1)) << 4) + 8 * (fr & 1)));
                        const bf16x8 Vf = {v0[0], v0[1], v0[2], v0[3], v1[0], v1[1], v1[2], v1[3]};
                        O[c] = __builtin_amdgcn_mfma_f32_16x16x32_bf16(Vf, Pf[ks], O[c], 0, 0, 0);
                    }
              }
            }
            float l = lrun + __shfl_xor(lrun, 16, 64);
            l += __shfl_xor(l, 32, 64);
            const float inv = l > 0.f ? 1.0f / l : 0.f;
            bf16_t* op = Og + (size_t)m * 1024 + (g * 4 + hl) * 128 + 4 * fq;
#pragma unroll
            for (int c = 0; c < 8; ++c)
                *(uint2*)(op + 16 * c) = make_uint2(pk2(O[c][0] * inv, O[c][1] * inv), pk2(O[c][2] * inv, O[c][3] * inv));
        }
    }
}


template <int BR>
__device__ __forceinline__ void ph_attn_sample(const Params& p, int bid, int nb, unsigned char* smem, unsigned* qctr = nullptr) {
    typedef pg8::bf16x8 bf16x8;
    typedef pg8::f32x4 f32x4;
    typedef short s16x4 __attribute__((ext_vector_type(4)));
    const int tid = threadIdx.x, lane = tid & 63, wid = tid >> 6, fr = lane & 15, fq = lane >> 4, hl = fr & 3;
    const int mt = wid & 1, kh = (wid >> 1) & 1, dh = wid >> 2;
    float* bt = (float*)(smem + 65536);
    float* mrg = (float*)(smem + 65536 + 2048);
    int* pgs = (int*)(smem + 65536 + 2048 + 36864);
    const int srow = tid >> 5, spc = tid & 31;
    const unsigned ksw = (unsigned)(srow & 15), vsw = fvsw(srow);
    for (int it = q_next(qctr, -1, bid, nb, smem); it < 256; it = q_next(qctr, it, bid, nb, smem)) {
        const int s = __builtin_amdgcn_readfirstlane(it >> 1), g = __builtin_amdgcn_readfirstlane(it & 1);
        __syncthreads();
        bt[tid] = p.rel_bias[rel_bucket(tid & 127) * 8 + g * 4 + (tid >> 7)];
        if (BR == 0) { if (tid < 16) pgs[tid] = p.page_table[s * 16 + tid]; __syncthreads(); }
        float b31 = p.rel_bias[31 * 8 + g * 4 + hl];
        const int ti = 4 * mt + (fr >> 2);
        const int m = MP + s * 8 + ti;
        const int tq = (BR == 0) ? 2048 + ti : 512 + ti;
        bf16x8 Qf[4];
        {
            const bf16_t* qp = p.Qb + (size_t)m * 1024 + (g * 4 + hl) * 128 + 8 * fq;
#pragma unroll
            for (int sx = 0; sx < 4; ++sx) Qf[sx] = *(const bf16x8*)(qp + 32 * sx);
        }
        unsigned long long selmask = 0ull, tmask;
        if (BR == 0) {
            selmask = p.SEL[m * 2 + g];
            unsigned long long om = p.SEL[(MP + s * 8 + (lane & 7)) * 2 + g];
            om |= __shfl_xor(om, 1, 64); om |= __shfl_xor(om, 2, 64); om |= __shfl_xor(om, 4, 64);
            tmask = om;
        } else tmask = 0x1ffull;
        asm volatile("" : "+v"(Qf[0]), "+v"(Qf[1]), "+v"(Qf[2]), "+v"(Qf[3]), "+v"(b31), "+v"(selmask) :: "memory");
        auto rowptr = [&](int j, int jj) -> const float* {
            const int r = 64 * j + srow + 16 * jj;
            if (BR == 0) {
                if (r < 2048) {
                    const int page = pgs[j >> 1];
                    return p.cache_slc + (((size_t)page * 128 + (r & 127)) * 4 + g) * 128;
                }
                if (r < 2056) return p.out + O_SLC_S + ((size_t)s * 8 + (r - 2048)) * 512 + g * 128;
                return nullptr;
            } else {
                if (r < 512) return p.cache_win + (((size_t)s * 512 + r) * 4 + g) * 128;
                if (r < 520) return p.out + O_WIN_S + ((size_t)s * 512 + 504 + (r - 512)) * 512 + g * 128;
                return nullptr;
            }
        };
        f32x4 O[4];
#pragma unroll
        for (int c = 0; c < 4; ++c) O[c] = (f32x4){0.f, 0.f, 0.f, 0.f};
        float mrun = -INFINITY, lrun = 0.f;
        f32x4 kx[2][4], vx[2][4];
        int jt[2];
        unsigned rowok[2];
#define GLD_NT(dst, ptr) asm volatile("global_load_dwordx4 %0, %1, off nt" : "=v"(dst) : "v"(ptr) : "memory")
#define LOAD_ROWS(j, par) do { rowok[par] = 0u; _Pragma("unroll") for (int jj_ = 0; jj_ < 4; ++jj_) { const float* rp_ = rowptr(j, jj_); \
            if (rp_) rowok[par] |= 1u << jj_; else rp_ = p.cache_win; \
            GLD_NT(kx[par][jj_], rp_ + spc * 4); GLD_NT(vx[par][jj_], rp_ + 256 + spc * 4); } } while (0)
#pragma unroll
        for (int par = 0; par < 2; ++par) {
            jt[par] = __builtin_amdgcn_readfirstlane(tmask ? (int)__builtin_ctzll(tmask) : -1);
            tmask &= tmask - 1;
            rowok[par] = 0u;
            if (jt[par] >= 0) LOAD_ROWS(jt[par], par);
            else {
#pragma unroll
                for (int jj_ = 0; jj_ < 4; ++jj_) { kx[par][jj_] = (f32x4){0.f, 0.f, 0.f, 0.f}; vx[par][jj_] = (f32x4){0.f, 0.f, 0.f, 0.f}; }
            }
        }
        __syncthreads();
        bool more = true;
        while (more) {
#pragma unroll
          for (int par = 0; par < 2; ++par) {
            const int j = jt[par];
            if (j < 0) { more = false; break; }
            unsigned char* Kb = smem + par * 32768;
            unsigned char* Vb = Kb + 16384;
            if (jt[par ^ 1] >= 0) asm volatile("s_waitcnt vmcnt(8)" ::: "memory"); else asm volatile("s_waitcnt vmcnt(0)" ::: "memory");
            asm volatile("" : "+v"(kx[par][0]), "+v"(kx[par][1]), "+v"(kx[par][2]), "+v"(kx[par][3]), "+v"(vx[par][0]), "+v"(vx[par][1]), "+v"(vx[par][2]), "+v"(vx[par][3]) :: "memory");
            {
                const unsigned kof = ((((unsigned)spc >> 1) ^ ksw) << 4) + 8u * ((unsigned)spc & 1u);
                const unsigned vof = ((((unsigned)spc >> 1) ^ vsw) << 4) + 8u * ((unsigned)spc & 1u);
#pragma unroll
                for (int jj_ = 0; jj_ < 4; ++jj_) {
                    const bool ok = (rowok[par] >> jj_) & 1u;
                    const uint2 kw = ok ? make_uint2(pk2(kx[par][jj_][0], kx[par][jj_][1]), pk2(kx[par][jj_][2], kx[par][jj_][3])) : make_uint2(0u, 0u);
                    const uint2 vw = ok ? make_uint2(pk2(vx[par][jj_][0], vx[par][jj_][1]), pk2(vx[par][jj_][2], vx[par][jj_][3])) : make_uint2(0u, 0u);
                    *(uint2*)(Kb + (srow + 16 * jj_) * 256 + kof) = kw;
                    *(uint2*)(Vb + (srow + 16 * jj_) * 256 + vof) = vw;
                }
            }
            __syncthreads();
            jt[par] = __builtin_amdgcn_readfirstlane(tmask ? (int)__builtin_ctzll(tmask) : -1);
            tmask &= tmask - 1;
            if (jt[par] >= 0) LOAD_ROWS(jt[par], par);
            const int kbase = j * 64 + 32 * kh;
            f32x4 S[2];
#pragma unroll
            for (int nt = 0; nt < 2; ++nt) {
                const int r = 32 * kh + 16 * nt + fr;
                S[nt] = (f32x4){0.f, 0.f, 0.f, 0.f};
#pragma unroll
                for (int sx = 0; sx < 4; ++sx) {
                    const bf16x8 Kf = *(const bf16x8*)(Kb + r * 256 + (((unsigned)(4 * sx + fq) ^ (unsigned)(r & 15)) << 4));
                    S[nt] = __builtin_amdgcn_mfma_f32_16x16x32_bf16(Kf, Qf[sx], S[nt], 0, 0, 0);
                }
            }
            const int q0 = (BR == 0) ? 2048 : 512;
            const bool far = (q0 - (j * 64 + 63)) >= 113;
            const bool selok = (BR == 0) ? (((selmask >> j) & 1ull) != 0ull) : true;
            float tmax = -INFINITY;
#pragma unroll
            for (int nt = 0; nt < 2; ++nt)
#pragma unroll
                for (int i = 0; i < 4; ++i) {
                    const int dist = tq - (kbase + 16 * nt + 4 * fq + i);
                    bool valid = selok && dist >= 0;
                    if (BR == 1) valid = valid && dist <= 512;
                    const float bias = far ? b31 : bt[hl * 128 + (dist < 0 ? 0 : (dist > 127 ? 127 : dist))];
                    const float sv = valid ? S[nt][i] + bias : -INFINITY;
                    S[nt][i] = sv;
                    tmax = fmaxf(tmax, sv);
                }
            tmax = fmaxf(tmax, __shfl_xor(tmax, 16, 64));
            tmax = fmaxf(tmax, __shfl_xor(tmax, 32, 64));
            const float mnew = fmaxf(mrun, tmax);
            const bool dead = (mnew == -INFINITY);
            const float scale = (mrun == -INFINITY) ? 0.f : __expf(mrun - mnew);
            float psum = 0.f;
#pragma unroll
            for (int nt = 0; nt < 2; ++nt)
#pragma unroll
                for (int i = 0; i < 4; ++i) {
                    const float pv = dead ? 0.f : __expf(S[nt][i] - mnew);
                    S[nt][i] = pv;
                    psum += pv;
                }
            lrun = lrun * scale + psum;
            mrun = mnew;
#pragma unroll
            for (int c = 0; c < 4; ++c) { O[c][0] *= scale; O[c][1] *= scale; O[c][2] *= scale; O[c][3] *= scale; }
            bf16x8 Pf;
            {
                union { unsigned u[4]; bf16x8 v; } cv;
                cv.u[0] = pk2(S[0][0], S[0][1]); cv.u[1] = pk2(S[0][2], S[0][3]);
                cv.u[2] = pk2(S[1][0], S[1][1]); cv.u[3] = pk2(S[1][2], S[1][3]);
                Pf = cv.v;
            }
#pragma unroll
            for (int c = 0; c < 4; ++c) {
                const int r0 = 32 * kh + 4 * fq + (fr >> 2), r1 = r0 + 16;
                const unsigned ch = (unsigned)(2 * (4 * dh + c) + ((fr & 3) >> 1));
                const s16x4 a0 = __builtin_amdgcn_ds_read_tr16_b64_v4i16((__attribute__((address_space(3))) s16x4*)(Vb + r0 * 256 + ((ch ^ fvsw(r0)) << 4) + 8 * (fr & 1)));
                const s16x4 a1 = __builtin_amdgcn_ds_read_tr16_b64_v4i16((__attribute__((address_space(3))) s16x4*)(Vb + r1 * 256 + ((ch ^ fvsw(r1)) << 4) + 8 * (fr & 1)));
                const bf16x8 Vf = {a0[0], a0[1], a0[2], a0[3], a1[0], a1[1], a1[2], a1[3]};
                O[c] = __builtin_amdgcn_mfma_f32_16x16x32_bf16(Vf, Pf, O[c], 0, 0, 0);
            }
          }
        }
#undef LOAD_ROWS
#undef GLD_NT
        float l = lrun + __shfl_xor(lrun, 16, 64);
        l += __shfl_xor(l, 32, 64);
#pragma unroll
        for (int c = 0; c < 4; ++c) *(f32x4*)(mrg + ((wid * 4 + c) * 64 + lane) * 4) = O[c];
        mrg[8192 + (wid * 64 + lane) * 2] = mrun;
        mrg[8192 + (wid * 64 + lane) * 2 + 1] = l;
        __syncthreads();
        if (kh == 0) {
            const int pw = wid + 2;
            const float m1 = mrg[8192 + (pw * 64 + lane) * 2], l1 = mrg[8192 + (pw * 64 + lane) * 2 + 1];
            const float mm = fmaxf(mrun, m1);
            float w0 = 0.f, w1 = 0.f;
            if (mm != -INFINITY) {
                w0 = (mrun == -INFINITY) ? 0.f : __expf(mrun - mm);
                w1 = (m1 == -INFINITY) ? 0.f : __expf(m1 - mm);
            }
            const float lt = l * w0 + l1 * w1;
            const float inv = lt > 0.f ? 1.0f / lt : 0.f;
            bf16_t* Og = (BR == 0) ? p.OS : p.OW;
            bf16_t* op = Og + (size_t)m * 1024 + (g * 4 + hl) * 128 + dh * 64 + 4 * fq;
#pragma unroll
            for (int c = 0; c < 4; ++c) {
                const f32x4 o1 = *(const f32x4*)(mrg + ((pw * 4 + c) * 64 + lane) * 4);
                *(uint2*)(op + 16 * c) = make_uint2(pk2((O[c][0] * w0 + o1[0] * w1) * inv, (O[c][1] * w0 + o1[1] * w1) * inv),
                                                    pk2((O[c][2] * w0 + o1[2] * w1) * inv, (O[c][3] * w0 + o1[3] * w1) * inv));
            }
        }
    }
}


__device__ __forceinline__ void ph_hgrn(const Params& p, int bid, int nb, float* lds, unsigned* qctr = nullptr) {
    const int tid = threadIdx.x, v = tid & 127, kq = tid >> 7;
    float* sq = lds;
    float* sf = lds + 2048;
    float* si = lds + 4096;
    float* so = lds + 6144;
    for (int it = 32 + q_next(qctr, -1, bid, nb, (unsigned char*)lds); it < 32 + 1024; it = 32 + q_next(qctr, it - 32, bid, nb, (unsigned char*)lds)) {
        int h, T;
        size_t mbase;
        const float* s0 = nullptr;
        float* sout;
        if (it < 32) {
            int n = it >> 3; h = it & 7; T = 2048; mbase = (size_t)n * 2048;
            sout = p.out + O_ST_P + (size_t)it * 16384;
        } else {
            int j = it - 32; h = j & 7; T = 8; mbase = (size_t)MP + (size_t)(j >> 3) * 8;
            s0 = p.state + (size_t)j * 16384;
            sout = p.out + O_ST_S + (size_t)j * 16384;
        }
        float S[32];
#pragma unroll
        for (int k = 0; k < 32; ++k) S[k] = s0 ? s0[(size_t)(kq * 32 + k) * 128 + v] : 0.f;
        for (int t0 = 0; t0 < T; t0 += 16) {
            const int nt = min(16, T - t0);
            __syncthreads();
            for (int e = tid; e < nt * 128; e += NT) {
                int tt = e >> 7, d = e & 127;
                const float* row = p.PF + (mbase + t0 + tt) * NPF;
                sq[e] = row[C_QB + h * 128 + d];
                {
                    const float l0 = p.lb_logits[h * 128 + d], l1 = p.lb_logits[1024 + h * 128 + d];
                    const float lb = 1.0f / (1.0f + expf(l1 - l0));
                    sf[e] = lb + (1.0f - lb) * sigmoidf_(row[C_FB + h * 128 + d]);
                }
                si[e] = row[C_IB + h * 128 + d];
            }
            __syncthreads();
            for (int tt = 0; tt < nt; ++tt) {
                const float iv = si[tt * 128 + v];
                float o = 0.f;
#pragma unroll
                for (int k = 0; k < 32; ++k) {
                    float f = sf[tt * 128 + kq * 32 + k];
                    float q = sq[tt * 128 + kq * 32 + k];
                    S[k] = f * S[k] + (1.0f - f) * iv;
                    o += q * S[k];
                }
                so[(tt * 4 + kq) * 128 + v] = o;
            }
            __syncthreads();
            for (int e = tid; e < nt * 128; e += NT) {
                const int tt = e >> 7, vv = e & 127;
                const float* sp = so + tt * 512 + vv;
                p.OH[(mbase + t0 + tt) * 1024 + h * 128 + vv] = (sp[0] + sp[128]) + (sp[256] + sp[384]);
            }
        }
#pragma unroll
        for (int k = 0; k < 32; ++k) sout[(size_t)(kq * 32 + k) * 128 + v] = S[k];
    }
}

template <int CTRL> __device__ __forceinline__ float dpp_f(float x) {
    return __int_as_float(__builtin_amdgcn_update_dpp(0, __float_as_int(x), CTRL, 0xf, 0xf, false));
}
__device__ __forceinline__ float row_prefix16(float x) {
    x += dpp_f<0x111>(x); x += dpp_f<0x112>(x); x += dpp_f<0x114>(x); x += dpp_f<0x118>(x);
    return x;
}
__device__ __forceinline__ float row_suffix16(float x) {
    x += dpp_f<0x101>(x); x += dpp_f<0x102>(x); x += dpp_f<0x104>(x); x += dpp_f<0x108>(x);
    return x;
}
__device__ __forceinline__ float fsig(float x) { return __builtin_amdgcn_rcpf(1.0f + __expf(-x)); }
__device__ __forceinline__ float flog2(float x) { return __builtin_amdgcn_logf(x); }
__device__ __forceinline__ float fexp2(float x) { return __builtin_amdgcn_exp2f(x); }
__device__ __forceinline__ float row_last16(float x) {
    return __int_as_float(__builtin_amdgcn_ds_swizzle(__float_as_int(x), 0x1F0));
}

struct ChainCtx {
    size_t mbase; int h, st, kg, sk4, wid, fr, fq; float4 lb4;
};

__device__ __forceinline__ void chain_step(const Params& p, unsigned char* smem, const ChainCtx& c, const int step,
                                           float4& rq, float4& rfraw, float4& ri, pg8::f32x4 (&Sacc)[8]) {
    typedef pg8::bf16x8 bf16x8;
    typedef pg8::f32x4 f32x4;
    typedef short s16x4 __attribute__((ext_vector_type(4)));
    constexpr int BUF = 17408;
    unsigned char* B = smem + (step & 1) * BUF;
    unsigned char* QD = B;
    unsigned char* KH = B + 4096;
    bf16_t* KET = (bf16_t*)(B + 8192);
    bf16_t* VT = (bf16_t*)(B + 12288);
    float* DEND = (float*)(B + 16384);
    const int st = c.st, kg = c.kg, sk4 = c.sk4, wid = c.wid, fr = c.fr, fq = c.fq;
    {
        const float fx = c.lb4.x + (1.0f - c.lb4.x) * fsig(rfraw.x), fy = c.lb4.y + (1.0f - c.lb4.y) * fsig(rfraw.y);
        const float fz = c.lb4.z + (1.0f - c.lb4.z) * fsig(rfraw.z), fw = c.lb4.w + (1.0f - c.lb4.w) * fsig(rfraw.w);
        const float lx = flog2(fx), ly = flog2(fy), lz = flog2(fz), lw = flog2(fw);
        const float bsx = row_prefix16(lx), bsy = row_prefix16(ly), bsz = row_prefix16(lz), bsw = row_prefix16(lw);
        const float ex = row_last16(bsx) - bsx, ey = row_last16(bsy) - bsy, ez = row_last16(bsz) - bsz, ew = row_last16(bsw) - bsw;
        const float kx = 1.0f - fx, ky = 1.0f - fy, kz = 1.0f - fz, kw = 1.0f - fw;
        const unsigned v01 = pk2(ri.x, ri.y), v23 = pk2(ri.z, ri.w);
        VT[(sk4 + 0) * 16 + st] = (bf16_t)(v01 & 0xffffu); VT[(sk4 + 1) * 16 + st] = (bf16_t)(v01 >> 16);
        VT[(sk4 + 2) * 16 + st] = (bf16_t)(v23 & 0xffffu); VT[(sk4 + 3) * 16 + st] = (bf16_t)(v23 >> 16);
        const float dx = fexp2(bsx), dy = fexp2(bsy), dz = fexp2(bsz), dw = fexp2(bsw);
        const unsigned qd0 = pk2(rq.x * dx, rq.y * dy), qd1 = pk2(rq.z * dz, rq.w * dw);
        const unsigned kh0 = pk2(kx * fexp2(fminf(-bsx, 115.4f)), ky * fexp2(fminf(-bsy, 115.4f)));
        const unsigned kh1 = pk2(kz * fexp2(fminf(-bsz, 115.4f)), kw * fexp2(fminf(-bsw, 115.4f)));
        const unsigned ke0 = pk2(kx * fexp2(ex), ky * fexp2(ey));
        const unsigned ke1 = pk2(kz * fexp2(ez), kw * fexp2(ew));
        const unsigned off = (unsigned)st * 256u + ((((unsigned)kg >> 1) ^ (unsigned)st) << 4) + 8u * ((unsigned)kg & 1u);
        *(uint2*)(QD + off) = make_uint2(qd0, qd1);
        *(uint2*)(KH + off) = make_uint2(kh0, kh1);
        KET[(sk4 + 0) * 16 + st] = (bf16_t)(ke0 & 0xffffu); KET[(sk4 + 1) * 16 + st] = (bf16_t)(ke0 >> 16);
        KET[(sk4 + 2) * 16 + st] = (bf16_t)(ke1 & 0xffffu); KET[(sk4 + 3) * 16 + st] = (bf16_t)(ke1 >> 16);
        if (st == 15) *(float4*)(DEND + sk4) = make_float4(dx, dy, dz, dw);
    }
    __syncthreads();
    if (step + 2 < 128) {
        const float* row = p.PF + (c.mbase + (size_t)(step + 2) * 16 + st) * NPF + c.h * 128 + sk4;
        rq = *(const float4*)(row + C_QB); rfraw = *(const float4*)(row + C_FB); ri = *(const float4*)(row + C_IB);
    }
    const s16x4 vv = *(const s16x4*)(VT + (16 * wid + fr) * 16 + 4 * fq);
    s16x4 Kef[8];
    f32x4 d4[8];
#pragma unroll
    for (int kt = 0; kt < 8; ++kt) {
        Kef[kt] = *(const s16x4*)(KET + (16 * kt + fr) * 16 + 4 * fq);
        d4[kt] = *(const f32x4*)(DEND + 16 * kt + 4 * fq);
    }
    f32x4 oacc = (f32x4){0.f, 0.f, 0.f, 0.f};
#pragma unroll
    for (int ks = 0; ks < 4; ++ks) {
        const unsigned c0 = (unsigned)(4 * ks + (fq >> 1)), c1 = c0 + 2u;
        const s16x4 qa = *(const s16x4*)(QD + fr * 256 + ((c0 ^ (unsigned)fr) << 4) + 8 * (fq & 1));
        const s16x4 qb = *(const s16x4*)(QD + fr * 256 + ((c1 ^ (unsigned)fr) << 4) + 8 * (fq & 1));
        const bf16x8 Qp = {qa[0], qa[1], qa[2], qa[3], qb[0], qb[1], qb[2], qb[3]};
        union { unsigned u[4]; bf16x8 v; } sv;
        sv.u[0] = pk2(Sacc[2 * ks][0], Sacc[2 * ks][1]); sv.u[1] = pk2(Sacc[2 * ks][2], Sacc[2 * ks][3]);
        sv.u[2] = pk2(Sacc[2 * ks + 1][0], Sacc[2 * ks + 1][1]); sv.u[3] = pk2(Sacc[2 * ks + 1][2], Sacc[2 * ks + 1][3]);
        oacc = __builtin_amdgcn_mfma_f32_16x16x32_bf16(Qp, sv.v, oacc, 0, 0, 0);
    }
    f32x4 A = (f32x4){0.f, 0.f, 0.f, 0.f};
#pragma unroll
    for (int ks = 0; ks < 4; ++ks) {
        const unsigned o16 = (unsigned)fr * 256u + ((((unsigned)(4 * ks + fq)) ^ (unsigned)fr) << 4);
        const bf16x8 Khf = *(const bf16x8*)(KH + o16);
        const bf16x8 Qdf = *(const bf16x8*)(QD + o16);
        A = __builtin_amdgcn_mfma_f32_16x16x32_bf16(Khf, Qdf, A, 0, 0, 0);
    }
    {
        union { unsigned u[2]; s16x4 v; } av;
        av.u[0] = pk2((4 * fq + 0 <= fr) ? A[0] : 0.f, (4 * fq + 1 <= fr) ? A[1] : 0.f);
        av.u[1] = pk2((4 * fq + 2 <= fr) ? A[2] : 0.f, (4 * fq + 3 <= fr) ? A[3] : 0.f);
        oacc = __builtin_amdgcn_mfma_f32_16x16x16bf16_1k(av.v, vv, oacc, 0, 0, 0);
    }
    {
        float* op = p.OH + (c.mbase + (size_t)step * 16 + 4 * fq) * 1024 + c.h * 128 + 16 * wid + fr;
        op[0] = oacc[0]; op[1024] = oacc[1]; op[2048] = oacc[2]; op[3072] = oacc[3];
    }
#pragma unroll
    for (int kt = 0; kt < 8; ++kt) {
        Sacc[kt] = Sacc[kt] * d4[kt];
        Sacc[kt] = __builtin_amdgcn_mfma_f32_16x16x16bf16_1k(Kef[kt], vv, Sacc[kt], 0, 0, 0);
    }
}

__device__ __forceinline__ void ph_hgrn_chain(const Params& p, int item, unsigned char* smem) {
    typedef pg8::f32x4 f32x4;
    const int tid = threadIdx.x, lane = tid & 63;
    ChainCtx c;
    c.wid = tid >> 6; c.fr = lane & 15; c.fq = lane >> 4;
    const int n = item >> 3;
    c.h = item & 7;
    c.mbase = (size_t)n * 2048;
    c.st = tid & 15; c.kg = tid >> 4; c.sk4 = c.kg * 4;
    {
        const float4 l0 = *(const float4*)&p.lb_logits[c.h * 128 + c.sk4], l1 = *(const float4*)&p.lb_logits[1024 + c.h * 128 + c.sk4];
        c.lb4 = make_float4(1.0f / (1.0f + expf(l1.x - l0.x)), 1.0f / (1.0f + expf(l1.y - l0.y)), 1.0f / (1.0f + expf(l1.z - l0.z)), 1.0f / (1.0f + expf(l1.w - l0.w)));
    }
    f32x4 Sacc[8];
#pragma unroll
    for (int kt = 0; kt < 8; ++kt) Sacc[kt] = (f32x4){0.f, 0.f, 0.f, 0.f};
    float4 q0, f0, i0, q1, f1, i1;
    {
        const float* row = p.PF + (c.mbase + c.st) * NPF + c.h * 128 + c.sk4;
        q0 = *(const float4*)(row + C_QB); f0 = *(const float4*)(row + C_FB); i0 = *(const float4*)(row + C_IB);
        row += (size_t)16 * NPF;
        q1 = *(const float4*)(row + C_QB); f1 = *(const float4*)(row + C_FB); i1 = *(const float4*)(row + C_IB);
    }
    __syncthreads();
    for (int s2 = 0; s2 < 128; s2 += 2) {
        chain_step(p, smem, c, s2, q0, f0, i0, Sacc);
        chain_step(p, smem, c, s2 + 1, q1, f1, i1, Sacc);
    }
    float* so = p.out + O_ST_P + (size_t)item * 16384;
#pragma unroll
    for (int kt = 0; kt < 8; ++kt)
#pragma unroll
        for (int i = 0; i < 4; ++i) so[(size_t)(16 * kt + 4 * c.fq + i) * 128 + 16 * c.wid + c.fr] = Sacc[kt][i];
    __syncthreads();
}

__device__ __forceinline__ void ph_combine(const Params& p, int bid, int nb, int m_begin, int m_end) {
    const int lane = threadIdx.x & 63, wave = threadIdx.x >> 6;
    const int gw = bid * 8 + wave, ngw = nb * 8;
    const int c0 = lane * 16, hd = lane >> 3;
    float4 gov[4];
#pragma unroll
    for (int j = 0; j < 4; ++j) gov[j] = *(const float4*)&p.g_o[(c0 & 127) + 4 * j];
    for (int m = m_begin + gw; m < m_end; m += ngw) {
        const bf16_t* row = p.PH + (size_t)m * LDH;
        float4 oc[4], os[4], ow[4], oh[4], za[4], zb[4];
#pragma unroll
        for (int j = 0; j < 4; ++j) {
            const uint2 c2 = *(const uint2*)&p.OC[(size_t)m * 1024 + c0 + 4 * j], s2 = *(const uint2*)&p.OS[(size_t)m * 1024 + c0 + 4 * j];
            const uint2 w2 = *(const uint2*)&p.OW[(size_t)m * 1024 + c0 + 4 * j];
            oc[j] = make_float4(__uint_as_float(c2.x << 16), __uint_as_float(c2.x & 0xffff0000u), __uint_as_float(c2.y << 16), __uint_as_float(c2.y & 0xffff0000u));
            os[j] = make_float4(__uint_as_float(s2.x << 16), __uint_as_float(s2.x & 0xffff0000u), __uint_as_float(s2.y << 16), __uint_as_float(s2.y & 0xffff0000u));
            ow[j] = make_float4(__uint_as_float(w2.x << 16), __uint_as_float(w2.x & 0xffff0000u), __uint_as_float(w2.y << 16), __uint_as_float(w2.y & 0xffff0000u));
            oh[j] = *(const float4*)&p.OH[(size_t)m * 1024 + c0 + 4 * j];
            za[j] = bf4(*(const uint2*)&row[C_ZA + c0 + 4 * j]);
            zb[j] = bf4(*(const uint2*)&row[C_ZB + c0 + 4 * j]);
        }
        const float gc = p.GATE[(size_t)m * 24 + hd], gs = p.GATE[(size_t)m * 24 + 8 + hd], gw_ = p.GATE[(size_t)m * 24 + 16 + hd];
        float ss = 0.f;
#pragma unroll
        for (int j = 0; j < 4; ++j) ss += oh[j].x * oh[j].x + oh[j].y * oh[j].y + oh[j].z * oh[j].z + oh[j].w * oh[j].w;
        ss += __shfl_xor(ss, 1, 64); ss += __shfl_xor(ss, 2, 64); ss += __shfl_xor(ss, 4, 64);
        const float rr = rsqrtf(ss * (1.0f / 128) + EPS);
        uint2 a[4], bq[4];
#pragma unroll
        for (int j = 0; j < 4; ++j) {
            const float4 go = gov[j];
            a[j].x = pk2((gc * oc[j].x + gs * os[j].x + gw_ * ow[j].x) * siluf_(za[j].x), (gc * oc[j].y + gs * os[j].y + gw_ * ow[j].y) * siluf_(za[j].y));
            a[j].y = pk2((gc * oc[j].z + gs * os[j].z + gw_ * ow[j].z) * siluf_(za[j].z), (gc * oc[j].w + gs * os[j].w + gw_ * ow[j].w) * siluf_(za[j].w));
            bq[j].x = pk2(oh[j].x * rr * go.x * siluf_(zb[j].x), oh[j].y * rr * go.y * siluf_(zb[j].y));
            bq[j].y = pk2(oh[j].z * rr * go.z * siluf_(zb[j].z), oh[j].w * rr * go.w * siluf_(zb[j].w));
        }
        uint4* oa = (uint4*)&p.MIXb[(size_t)m * 2048 + c0];
        uint4* ob = (uint4*)&p.MIXb[(size_t)m * 2048 + 1024 + c0];
        oa[0] = make_uint4(a[0].x, a[0].y, a[1].x, a[1].y); oa[1] = make_uint4(a[2].x, a[2].y, a[3].x, a[3].y);
        ob[0] = make_uint4(bq[0].x, bq[0].y, bq[1].x, bq[1].y); ob[1] = make_uint4(bq[2].x, bq[2].y, bq[3].x, bq[3].y);
    }
}

__global__ void __launch_bounds__(NT, 2) k_mega(Params p) {
    extern __shared__ __attribute__((aligned(16))) unsigned char smem[];
    float* lds = (float*)smem;
    volatile LAS unsigned* misc = (volatile LAS unsigned*)(smem + LDS_STAGE);
    if (threadIdx.x == 0) { misc[0] = 0u; misc[1] = 0u; }
    __syncthreads();
    XcdBarrier bar = xcd_barrier_post(p.bar, misc);
    const int bid = blockIdx.x, nb = gridDim.x;
#define PH0 { ph_prologue(p, bid, nb, lds); xcd_barrier(bar); }
#define PH1 { if (bid < nb - 32 || nb <= 64) { const int gg = (nb > 64) ? nb - 32 : nb; \
                pg8::Gemm g{p.Hb, p.Wt_in, M, LDP, D}; pg8::StaticOrder S; S.init(M, LDP, gg, bid); pg8::EpiMix E{p.PF, p.PH, LDH}; \
                pg8::gemm_phase<pg8::EpiMix, pg8::StaticOrder>((PG8_LAS unsigned char*)smem, g, S, E); \
                if (threadIdx.x == 0) (void)__hip_atomic_fetch_add(&p.ctr[64], 1u, __ATOMIC_RELAXED, __HIP_MEMORY_SCOPE_AGENT); } \
              else { ph_cmp_mfma(p, 512, true, smem, P1_MAXU); } \
              xcd_barrier(bar); }
#define PH2 { ph_post(p, bid, nb); xcd_barrier(bar); }
#define PH3 { if (bid < 32 && nb > 64) { ph_hgrn_chain(p, bid, smem); } \
              else if (nb <= 64) { for (int it = bid; it < 32; it += nb) ph_hgrn_chain(p, it, smem); } \
                \
              ph_cmp_mfma(p, NSEQ * 4, false, smem); __syncthreads(); \
              ph_attn_prompt<1>(p, bid, nb, smem, p.ctr + 1); __syncthreads(); \
              ph_attn_sample<1>(p, bid, nb, smem, p.ctr + 2); __syncthreads(); \
              ph_hgrn(p, bid, nb, lds, p.ctr + 3); \
              xcd_barrier(bar); }
#define PH5 { ph_cmp_attn_mfma(p, bid, nb, smem); xcd_barrier(bar); }
#define PH6 {   \
              if (bid & 1) { ph_attn_prompt<0>(p, bid, nb, smem); __syncthreads(); ph_attn_sample<0>(p, bid, nb, smem); } \
              else { ph_attn_sample<0>(p, bid, nb, smem); __syncthreads(); ph_attn_prompt<0>(p, bid, nb, smem); } \
              xcd_barrier(bar); }
#define PH7A { ph_combine(p, bid, nb, MP, M); xcd_barrier(bar); }
#define PH7B { if (bid < 32 && nb > 64) {   \
                 pg8::Gemm g{p.MIXb + (size_t)MP * 2048, p.Wt_out, MS, D, 2048}; pg8::StaticOrder S; S.init(MS, D, 32, bid); \
                 pg8::EpiResF32S E{p.out + O_YS, p.x_sample}; \
                 pg8::gemm_phase<pg8::EpiResF32S, pg8::StaticOrder>((PG8_LAS unsigned char*)smem, g, S, E); } \
               else { const int rb = (nb > 64) ? bid - 32 : bid, rnb = (nb > 64) ? nb - 32 : nb; \
                 ph_combine(p, rb, rnb, 0, MP); } \
               __syncthreads(); ph_wincopy(p, bid, nb, smem, p.ctr + 4);   \
               xcd_barrier(bar); }
#define PH8 { if (nb > 64) { pg8::Gemm g{p.MIXb, p.Wt_out, MP, D, 2048}; pg8::StaticOrder S; S.init(MP, D, nb, bid); pg8::EpiResF32 E{p.out, p.x_prompt, p.x_sample}; \
                pg8::gemm_phase<pg8::EpiResF32, pg8::StaticOrder>((PG8_LAS unsigned char*)smem, g, S, E); } \
              else { pg8::Gemm g{p.MIXb, p.Wt_out, M, D, 2048}; pg8::StaticOrder S; S.init(M, D, nb, bid); pg8::EpiResF32 E{p.out, p.x_prompt, p.x_sample}; \
                pg8::gemm_phase<pg8::EpiResF32, pg8::StaticOrder>((PG8_LAS unsigned char*)smem, g, S, E); } }
    PH0
#if (PROBE_MASK >> 0) & 1
    PH0
#endif
    PH1
#if (PROBE_MASK >> 1) & 1
    PH1
#endif
    PH2
#if (PROBE_MASK >> 2) & 1
    PH2
#endif
    PH3
#if (PROBE_MASK >> 3) & 1
    PH3
#endif
    PH5
#if (PROBE_MASK >> 5) & 1
    PH5
#endif
    PH6
#if (PROBE_MASK >> 6) & 1
    PH6
#endif
    PH7A
    PH7B
#if (PROBE_MASK >> 8) & 1
    PH8
    xcd_barrier(bar);
#endif
    PH8
}

}

extern "C" void kernel_launch(void* const* d_in, const int* in_sizes, int n_in, void* d_out,
                              int out_size, void* d_ws, size_t ws_size, hipStream_t stream) {
    (void)in_sizes; (void)n_in; (void)out_size; (void)ws_size;
    Params p{};
    p.x_prompt = (const float*)d_in[0];
    p.x_sample = (const float*)d_in[1];
    p.cache_cmp = (const float*)d_in[2];
    p.cache_slc = (const float*)d_in[3];
    p.cache_win = (const float*)d_in[4];
    p.state = (const float*)d_in[5];
    p.page_table = (const int*)d_in[6];
    p.g_norm = (const float*)d_in[7];
    p.w_in = (const float*)d_in[8];
    p.w_out = (const float*)d_in[9];
    p.g_q = (const float*)d_in[10];
    p.g_k_slc = (const float*)d_in[11];
    p.g_k_win = (const float*)d_in[12];
    p.g_k_cmp = (const float*)d_in[13];
    p.w_cmp_k = (const float*)d_in[14];
    p.w_cmp_v = (const float*)d_in[15];
    p.pe_k = (const float*)d_in[16];
    p.pe_v = (const float*)d_in[17];
    p.rel_bias = (const float*)d_in[18];
    p.lb_logits = (const float*)d_in[19];
    p.g_o = (const float*)d_in[20];
    p.out = (float*)d_out;
    float* ws = (float*)d_ws;
    size_t off = 0;
    auto take = [&](size_t nfloats) { float* r = ws + off; off += (nfloats + 63) & ~(size_t)63; return r; };
    p.bar = (unsigned*)take(XCD_BAR_WORDS + 128);
    p.ctr = p.bar + XCD_BAR_WORDS;
    p.Hb = (bf16_t*)take((size_t)M * D / 2);
    p.Wt_in = (bf16_t*)take((size_t)LDP * D / 2);
    p.Wt_out = (bf16_t*)take((size_t)D * 2048 / 2);
    p.MIXb = (bf16_t*)take((size_t)M * 2048 / 2);
    p.Wc_t = (bf16_t*)take((size_t)2 * 256 * 2048 / 2);
    p.PEB = take(64 * 128);
    p.Qb = (bf16_t*)take((size_t)M * 1024 / 2);
    p.KVb = (bf16_t*)take((size_t)2 * 2 * 4 * 2 * 2048 * 128 / 2);
    p.PF = take((size_t)M * NPF);
    p.PH = (bf16_t*)take((size_t)M * LDH / 2);
    p.KCb = (bf16_t*)take((size_t)NSEQ * 2 * 128 * 128 / 2);
    p.VCb = (bf16_t*)take((size_t)NSEQ * 2 * 128 * 128 / 2);
    p.OC = (bf16_t*)take((size_t)M * 1024 / 2);
    p.OS = (bf16_t*)take((size_t)M * 1024 / 2);
    p.OW = (bf16_t*)take((size_t)M * 1024 / 2);
    p.OH = take((size_t)M * 1024);
    p.GATE = take((size_t)M * 24);
    p.SEL = (unsigned long long*)take((size_t)M * 2 * 2);

    static int grid = 0;
    if (!grid) {
        int dev = 0, cus = 0;
        (void)hipGetDevice(&dev);
        (void)hipDeviceGetAttribute(&cus, hipDeviceAttributeMultiprocessorCount, dev);
        (void)hipFuncSetAttribute((const void*)k_mega, hipFuncAttributeMaxDynamicSharedMemorySize, LDS_BYTES);
        grid = cus > 0 ? cus : 256;
    }
    (void)hipMemsetAsync(p.bar, 0, (XCD_BAR_WORDS + 128) * sizeof(unsigned), stream);
    hipLaunchKernelGGL(k_mega, dim3(grid), dim3(NT), LDS_BYTES, stream, p);
}
```

```cpp
#include <hip/hip_runtime.h>
#include <stdint.h>
#include <stdio.h>

#define XB_TMO      128
#define XB_XCNT(j)  (256  + 64 * (j))
#define XB_XSUB(j)  (1280 + 64 * (j))
#define XB_XGEN(j)  (2304 + 64 * (j))
#define XB_TOP      3328
#define XB_TOPGEN   3392
#define XCD_BAR_WORDS 3456
#define XB_SPIN_CAP (1u << 18)
#define LAS __attribute__((address_space(3)))

__device__ __forceinline__ unsigned xb_ld(unsigned* p)              { return __hip_atomic_load(p, __ATOMIC_RELAXED, __HIP_MEMORY_SCOPE_AGENT); }
__device__ __forceinline__ unsigned xb_add(unsigned* p, unsigned v) { return __hip_atomic_fetch_add(p, v, __ATOMIC_RELAXED, __HIP_MEMORY_SCOPE_AGENT); }
__device__ __forceinline__ unsigned xb_xcc_id() { return (unsigned)__builtin_amdgcn_s_getreg((3 << 11) | 20) & 0xFu; }
#define XB_SPIN(cond, bar) do { unsigned _sp = 0; while (cond) { __builtin_amdgcn_s_sleep(1); \
    if ((++_sp & 255u) == 0u) { if (xb_ld(&(bar)[XB_TMO])) break; if (_sp > XB_SPIN_CAP) { atomicAdd(&(bar)[XB_TMO], 1u); break; } } } } while (0)

struct XcdBarrier {
    unsigned* bar; unsigned x;
    volatile LAS unsigned* st;
};

__device__ __forceinline__ XcdBarrier xcd_barrier_post(unsigned* bar, volatile LAS unsigned* st) {
    XcdBarrier b; b.bar = bar; b.x = xb_xcc_id(); b.st = st;
    if (threadIdx.x == 0) (void)xb_add(&bar[XB_XCNT(b.x)], 1u);
    return b;
}
__device__ __forceinline__ void xcd_barrier_complete(unsigned* bar, unsigned x, unsigned& nloc, unsigned& nx) {
    const unsigned G = gridDim.x * gridDim.y * gridDim.z;
    unsigned sum, cnt, mine, sp = 0u;
    for (;;) {
        sum = 0u; cnt = 0u; mine = 0u;
#pragma unroll
        for (unsigned j = 0; j < 16; ++j) { const unsigned c = xb_ld(&bar[XB_XCNT(j)]); sum += c; cnt += (c > 0u) ? 1u : 0u; mine = (j == x) ? c : mine; }
        if (sum == G) break;
        __builtin_amdgcn_s_sleep(1);
        if ((++sp & 255u) == 0u) { if (xb_ld(&bar[XB_TMO])) break; if (sp > XB_SPIN_CAP) { atomicAdd(&bar[XB_TMO], 1u); break; } }
    }
    nloc = mine > 0u ? mine : 1u; nx = cnt > 0u ? cnt : 1u;
}
__device__ __forceinline__ void xcd_barrier(const XcdBarrier& b) {
    asm volatile("s_waitcnt vmcnt(0)" ::: "memory");
    __syncthreads();
    if (threadIdx.x == 0) {
        unsigned* bar = b.bar;
        __builtin_amdgcn_s_waitcnt(0);
        unsigned nloc = b.st[0], nx = b.st[1];
        if (nloc == 0u) { xcd_barrier_complete(bar, b.x, nloc, nx); b.st[0] = nloc; b.st[1] = nx; }
        const unsigned old = xb_add(&bar[XB_XSUB(b.x)], 1u);
        const unsigned gen = old / nloc;
        if (old + 1u == (gen + 1u) * nloc) {
            __builtin_amdgcn_fence(__ATOMIC_RELEASE, "agent");
            asm volatile("s_waitcnt vmcnt(0)" ::: "memory");
            const unsigned og = xb_add(&bar[XB_TOP], 1u);
            const unsigned tg = og / nx;
            if (og + 1u == (tg + 1u) * nx) xb_add(&bar[XB_TOPGEN], 1u);
            else XB_SPIN(xb_ld(&bar[XB_TOPGEN]) == tg, bar);
            __builtin_amdgcn_fence(__ATOMIC_ACQUIRE, "agent");
            xb_add(&bar[XB_XGEN(b.x)], 1u);
            asm volatile("s_waitcnt vmcnt(0)" ::: "memory");
        } else {
            XB_SPIN(xb_ld(&bar[XB_XGEN(b.x)]) == gen, bar);
            __builtin_amdgcn_fence(__ATOMIC_ACQUIRE, "agent");
            asm volatile("s_waitcnt vmcnt(0)" ::: "memory");
        }
    }
    __syncthreads();
}


namespace pg8 {
#define PG8_LAS __attribute__((address_space(3)))
typedef unsigned short bf16_t;
typedef short bf16x8 __attribute__((ext_vector_type(8)));
typedef float f32x4 __attribute__((ext_vector_type(4)));
typedef unsigned u32x4 __attribute__((ext_vector_type(4)));
constexpr int BM = 256, BK = 64, HALF = 128, HTB = HALF * BK * 2, STAGE_BYTES = 8 * HTB, NXCD = 8, WGM = 8;

__host__ __device__ __forceinline__ int lds_byte(int r, int c) { const int st = (r >> 4) * 2 + (c >> 5), rr = r & 15, cc = c & 31, ob = rr * 64 + cc * 2; return st * 1024 + (ob ^ (((ob >> 9) & 1) << 5)); }
__host__ __device__ __forceinline__ void stage_rc(int b, int& R, int& C) { const int st = b / 1024, sb = b % 1024, swz = sb ^ (((sb >> 9) & 1) << 5); R = (st >> 1) * 16 + swz / 64; C = (st & 1) * 32 + (swz % 64) / 2; }
__host__ __device__ __forceinline__ int perm32(int rho) { const int n = rho >> 4, i = rho & 15; return 8 * (i >> 2) + 4 * n + (i & 3); }

struct Unit { int pm, pn; };
struct Gemm { const bf16_t* A; const bf16_t* Bt; int M, N, K; };

struct StaticOrder {
    int nM, nN, nwg, G, c;
    __host__ __device__ void init(int M, int N, int G_, int c_) { nM = M / BM; nN = N / BM; nwg = nM * nN; G = G_; c = c_; }
    __host__ __device__ bool next(int i, Unit& u) const {
        const long L = (long)i * G + c; if (L >= nwg) return false;
        int wgid = (int)L; { const int q = nwg / NXCD, r = nwg % NXCD, xcd = wgid % NXCD, off = wgid / NXCD; wgid = (xcd < r ? xcd * (q + 1) : r * (q + 1) + (xcd - r) * q) + off; }
        const int nig = WGM * nN, gid = wgid / nig, fm = gid * WGM, gsz = (nM - fm) < WGM ? (nM - fm) : WGM;
        u.pm = fm + ((wgid % nig) % gsz); u.pn = (wgid % nig) / gsz; return true;
    }
    __device__ __forceinline__ void a_ready(const Unit&) const {}
    __device__ __forceinline__ void done(const Unit&) const {}
};

__device__ __forceinline__ unsigned cvt_pk_bf16(float lo, float hi) { unsigned r; asm volatile("v_cvt_pk_bf16_f32 %0, %1, %2" : "=v"(r) : "v"(lo), "v"(hi)); return r; }

struct EpiF32 {
    static constexpr bool PERM = false, AFTER_DRAIN = false;
    float* C; int ldc;
    __device__ __forceinline__ void operator()(const f32x4 (&acc)[2][2][4][2], const Unit& u, int wr, int wc, int fr, int fq) const {
        const int row0 = u.pm * BM + wr * 64 + fr, col0 = u.pn * BM + wc * 32 + 4 * fq;
#pragma unroll
        for (int ai = 0; ai < 2; ++ai)
#pragma unroll
            for (int m = 0; m < 4; ++m) { float* rowp = C + (size_t)(row0 + ai * HALF + m * 16) * ldc + col0;
#pragma unroll
                for (int bj = 0; bj < 2; ++bj)
#pragma unroll
                    for (int n = 0; n < 2; ++n) *(f32x4*)(rowp + bj * HALF + n * 16) = acc[ai][bj][m][n]; }
    }
};
struct EpiMix {
    static constexpr bool PERM = true, AFTER_DRAIN = false;
    float* F; bf16_t* H; int ldh;
    __device__ __forceinline__ void operator()(const f32x4 (&acc)[2][2][4][2], const Unit& u, int wr, int wc, int fr, int fq) const {
        const int row0 = u.pm * BM + wr * 64 + fr;
        if (u.pn < 12) {
            const int col0 = u.pn * BM + wc * 32 + 8 * fq;
#pragma unroll
            for (int ai = 0; ai < 2; ++ai)
#pragma unroll
                for (int m = 0; m < 4; ++m) { float* rowp = F + (size_t)(row0 + ai * HALF + m * 16) * 3072 + col0;
#pragma unroll
                    for (int bj = 0; bj < 2; ++bj) { *(f32x4*)(rowp + bj * HALF) = acc[ai][bj][m][0]; *(f32x4*)(rowp + bj * HALF + 4) = acc[ai][bj][m][1]; } }
        } else {
            const int col0 = (u.pn - 12) * BM + wc * 32 + 8 * fq;
#pragma unroll
            for (int ai = 0; ai < 2; ++ai)
#pragma unroll
                for (int m = 0; m < 4; ++m) { bf16_t* rowp = H + (size_t)(row0 + ai * HALF + m * 16) * ldh + col0;
#pragma unroll
                    for (int bj = 0; bj < 2; ++bj) { const f32x4 v0 = acc[ai][bj][m][0], v1 = acc[ai][bj][m][1];
                        u32x4 w; w.x = cvt_pk_bf16(v0[0], v0[1]); w.y = cvt_pk_bf16(v0[2], v0[3]); w.z = cvt_pk_bf16(v1[0], v1[1]); w.w = cvt_pk_bf16(v1[2], v1[3]);
                        *(u32x4*)(rowp + bj * HALF) = w; } }
        }
    }
};
#define PG8_RES_LD(q, dst, XROW) { const int ai_ = (q) >> 2, m_ = (q) & 3; const int r_ = row0 + ai_ * HALF + m_ * 16; const float* xr_ = (XROW) + col0; \
        dst[0] = *(const f32x4*)(xr_); dst[1] = *(const f32x4*)(xr_ + 16); dst[2] = *(const f32x4*)(xr_ + HALF); dst[3] = *(const f32x4*)(xr_ + HALF + 16); }
#define PG8_RES_ST(q, src) { const int ai_ = (q) >> 2, m_ = (q) & 3; const int r_ = row0 + ai_ * HALF + m_ * 16; float* rowp_ = C + (size_t)r_ * 2048 + col0; \
        *(f32x4*)(rowp_) = acc[ai_][0][m_][0] + src[0]; *(f32x4*)(rowp_ + 16) = acc[ai_][0][m_][1] + src[1]; \
        *(f32x4*)(rowp_ + HALF) = acc[ai_][1][m_][0] + src[2]; *(f32x4*)(rowp_ + HALF + 16) = acc[ai_][1][m_][1] + src[3]; }
#define PG8_RES_BODY(XROWF) \
        f32x4 xa0[4], xa1[4], xb0[4], xb1[4]; \
        PG8_RES_LD(0, xa0, XROWF(r_)) PG8_RES_LD(1, xa1, XROWF(r_)) PG8_RES_LD(2, xb0, XROWF(r_)) PG8_RES_LD(3, xb1, XROWF(r_)) \
        PG8_RES_ST(0, xa0) PG8_RES_ST(1, xa1) \
        PG8_RES_LD(4, xa0, XROWF(r_)) PG8_RES_LD(5, xa1, XROWF(r_)) \
        PG8_RES_ST(2, xb0) PG8_RES_ST(3, xb1) \
        PG8_RES_LD(6, xb0, XROWF(r_)) PG8_RES_LD(7, xb1, XROWF(r_)) \
        PG8_RES_ST(4, xa0) PG8_RES_ST(5, xa1) PG8_RES_ST(6, xb0) PG8_RES_ST(7, xb1)
struct EpiResF32 {
    static constexpr bool PERM = false, AFTER_DRAIN = false;
    float* C; const float* xp; const float* xs;
    __device__ __forceinline__ void operator()(const f32x4 (&acc)[2][2][4][2], const Unit& u, int wr, int wc, int fr, int fq) const {
        const int row0 = u.pm * BM + wr * 64 + fr, col0 = u.pn * BM + wc * 32 + 4 * fq;
#define PG8_XROW_A(r) ((r) < 8192 ? xp + (size_t)(r) * 2048 : xs + (size_t)((r) - 8192) * 2048)
        PG8_RES_BODY(PG8_XROW_A)
#undef PG8_XROW_A
    }
};

struct EpiResF32S {
    static constexpr bool PERM = false, AFTER_DRAIN = false;
    float* C; const float* x;
    __device__ __forceinline__ void operator()(const f32x4 (&acc)[2][2][4][2], const Unit& u, int wr, int wc, int fr, int fq) const {
        const int row0 = u.pm * BM + wr * 64 + fr, col0 = u.pn * BM + wc * 32 + 4 * fq;
#define PG8_XROW_S(r) (x + (size_t)(r) * 2048)
        PG8_RES_BODY(PG8_XROW_S)
#undef PG8_XROW_S
    }
};
#undef PG8_RES_BODY
#undef PG8_RES_ST
#undef PG8_RES_LD

template <class Epi, class Sched>
__device__ __forceinline__ void gemm_phase(PG8_LAS unsigned char* lds, const Gemm g, const Sched& S, const Epi& E) {
    const int tid = threadIdx.x, wid = __builtin_amdgcn_readfirstlane(tid >> 6), lane = tid & 63, wr = wid >> 2, wc = wid & 3, fr = lane & 15, fq = lane >> 4;
    const int K = g.K, nt = K / BK;
    unsigned voffA[2], voffB[2];
#pragma unroll
    for (int i = 0; i < 2; ++i) { int R, C; stage_rc(tid * 16 + i * 8192, R, C); const int Rb = Epi::PERM ? ((R & ~31) + perm32(R & 31)) : R;
        voffA[i] = (unsigned)(R * K + C) * 2u; voffB[i] = (unsigned)(Rb * K + C) * 2u; }
    const size_t kstep = (size_t)(BK * 2);
    const size_t hstep = (size_t)HALF * K * 2;
    const size_t tstep = 2 * hstep;
    const unsigned ldsw = (unsigned)wid * 1024u;
    const int aoff = lds_byte(wr * 64 + fr, fq * 8), boff = lds_byte(wc * 32 + fr, fq * 8);
#define PG8_SA(b, h) (((b) * 2 + (h)) * HTB)
#define PG8_SB(b, h) ((4 + (b) * 2 + (h)) * HTB)
#define PG8_STAGE(bufoff, gbase, voff) do { _Pragma("unroll") for (int _i = 0; _i < 2; ++_i) \
        __builtin_amdgcn_global_load_lds((const unsigned*)((const char*)(gbase) + (voff)[_i]), (PG8_LAS unsigned*)(lds + (bufoff) + ldsw + _i * 8192), 16, 0, 0); } while (0)
#define PG8_LDA(dst, b, h) do { _Pragma("unroll") for (int m = 0; m < 4; ++m) _Pragma("unroll") for (int k = 0; k < 2; ++k) dst[m][k] = *(const PG8_LAS bf16x8*)(lds + PG8_SA(b, h) + aoff + m * 2048 + k * 1024); } while (0)
#define PG8_LDB(dst, b, h) do { _Pragma("unroll") for (int n = 0; n < 2; ++n) _Pragma("unroll") for (int k = 0; k < 2; ++k) dst[n][k] = *(const PG8_LAS bf16x8*)(lds + PG8_SB(b, h) + boff + n * 2048 + k * 1024); } while (0)
#define PG8_MMA(ai, bj, At, Bt) do { __builtin_amdgcn_s_setprio(1); _Pragma("unroll") for (int m = 0; m < 4; ++m) _Pragma("unroll") for (int n = 0; n < 2; ++n) _Pragma("unroll") for (int k = 0; k < 2; ++k) \
        acc[ai][bj][m][n] = __builtin_amdgcn_mfma_f32_16x16x32_bf16(Bt[n][k], At[m][k], acc[ai][bj][m][n], 0, 0, 0); __builtin_amdgcn_s_setprio(0); } while (0)
#define PG8_WAIT_V(n) asm volatile("s_waitcnt vmcnt(" #n ")" ::: "memory")
#define PG8_WAIT_L(n) asm volatile("s_waitcnt lgkmcnt(" #n ")" ::: "memory")
#define PG8_BAR __builtin_amdgcn_s_barrier()
#define PG8_SCHED __builtin_amdgcn_sched_barrier(0)
    Unit cur, nxt; int ui = 0;
    if (!S.next(0, cur)) return;
    f32x4 acc[2][2][4][2];
#pragma unroll
    for (int a = 0; a < 2; ++a)
#pragma unroll
        for (int b = 0; b < 2; ++b)
#pragma unroll
            for (int m = 0; m < 4; ++m)
#pragma unroll
                for (int n = 0; n < 2; ++n) acc[a][b][m][n] = (f32x4){0.f, 0.f, 0.f, 0.f};
    bf16x8 At[4][2], B0[2][2], B1[2][2];
    const char* cA = (const char*)g.A + (size_t)cur.pm * tstep; const char* cB = (const char*)g.Bt + (size_t)cur.pn * tstep;
    S.a_ready(cur);
    PG8_STAGE(PG8_SB(0, 0), cB, voffB); PG8_STAGE(PG8_SA(0, 0), cA, voffA); PG8_STAGE(PG8_SB(0, 1), cB + hstep, voffB); PG8_STAGE(PG8_SA(0, 1), cA + hstep, voffA);
    if (wr == 1) PG8_BAR;
    PG8_WAIT_V(4); PG8_BAR;
    PG8_STAGE(PG8_SB(1, 0), cB + kstep, voffB); PG8_STAGE(PG8_SA(1, 0), cA + kstep, voffA); PG8_STAGE(PG8_SB(1, 1), cB + hstep + kstep, voffB);
    PG8_WAIT_V(6); PG8_BAR;
    for (;;) {
        const bool has_next = S.next(ui + 1, nxt);
        const char* nA = has_next ? (const char*)g.A + (size_t)nxt.pm * tstep : cA; const char* nB = has_next ? (const char*)g.Bt + (size_t)nxt.pn * tstep : cB;
        for (int t = 0; t < nt; t += 2) {
            const bool last = (t == nt - 2);
            const char* a1 = cA + (size_t)(t + 1) * kstep;
            const char* a2 = last ? nA : cA + (size_t)(t + 2) * kstep; const char* b2 = last ? nB : cB + (size_t)(t + 2) * kstep;
            const char* a3 = a2 + kstep; const char* b3 = b2 + kstep;
            if (last && has_next) S.a_ready(nxt);
            PG8_LDB(B0, 0, 0); PG8_SCHED; PG8_LDA(At, 0, 0); PG8_STAGE(PG8_SA(1, 1), a1 + hstep, voffA);
            PG8_WAIT_L(8); PG8_BAR; PG8_WAIT_L(0); PG8_MMA(0, 0, At, B0); PG8_BAR; PG8_SCHED;
            PG8_LDB(B1, 0, 1); PG8_STAGE(PG8_SB(0, 0), b2, voffB);
            PG8_BAR; PG8_WAIT_L(0); PG8_MMA(0, 1, At, B1); PG8_BAR;
            PG8_LDA(At, 0, 1); PG8_STAGE(PG8_SA(0, 0), a2, voffA);
            PG8_BAR; PG8_WAIT_L(0); PG8_MMA(1, 0, At, B0); PG8_BAR; PG8_SCHED;
            PG8_STAGE(PG8_SB(0, 1), b2 + hstep, voffB);
            PG8_WAIT_V(6); PG8_BAR; PG8_MMA(1, 1, At, B1); PG8_BAR;
            PG8_LDB(B0, 1, 0); PG8_SCHED; PG8_LDA(At, 1, 0); PG8_STAGE(PG8_SA(0, 1), a2 + hstep, voffA);
            PG8_WAIT_L(8); PG8_BAR; PG8_WAIT_L(0); PG8_MMA(0, 0, At, B0); PG8_BAR; PG8_SCHED;
            PG8_LDB(B1, 1, 1); PG8_STAGE(PG8_SB(1, 0), b3, voffB);
            PG8_BAR; PG8_WAIT_L(0); PG8_MMA(0, 1, At, B1); PG8_BAR;
            PG8_LDA(At, 1, 1); PG8_STAGE(PG8_SA(1, 0), a3, voffA);
            PG8_BAR; PG8_WAIT_L(0); PG8_MMA(1, 0, At, B0); PG8_BAR; PG8_SCHED;
            PG8_STAGE(PG8_SB(1, 1), b3 + hstep, voffB);
            PG8_WAIT_V(6); PG8_BAR; PG8_MMA(1, 1, At, B1); PG8_BAR;
        }
        E(acc, cur, wr, wc, fr, fq); S.done(cur);
        if (!has_next) break;
#pragma unroll
        for (int a = 0; a < 2; ++a)
#pragma unroll
            for (int b = 0; b < 2; ++b)
#pragma unroll
                for (int m = 0; m < 4; ++m)
#pragma unroll
                    for (int n = 0; n < 2; ++n) acc[a][b][m][n] = (f32x4){0.f, 0.f, 0.f, 0.f};
        cur = nxt; cA = nA; cB = nB; ++ui;
    }
    PG8_WAIT_V(0);
    if (wr == 0) PG8_BAR;
    PG8_BAR;
#undef PG8_SA
#undef PG8_SB
#undef PG8_STAGE
#undef PG8_LDA
#undef PG8_LDB
#undef PG8_MMA
#undef PG8_WAIT_V
#undef PG8_WAIT_L
#undef PG8_BAR
#undef PG8_SCHED
}
}

#ifndef P1_MAXU
#define P1_MAXU 4
#endif
#ifndef PROBE_MASK
#define PROBE_MASK 0
#endif

namespace {

typedef unsigned short bf16_t;
constexpr int NT = 512;
constexpr int D = 2048;
constexpr int MP = 4 * 2048;
constexpr int MS = 128 * 8;
constexpr int M = MP + MS;
constexpr int NIN = 7704;
constexpr int LDP = 7936;
constexpr int NPF = 3072, LDH = LDP - NPF;
constexpr int C_QB = 0, C_FB = 1024, C_IB = 2048;
constexpr int C_QA = 0, C_KV = 1024, C_GATE = 2560, C_ZA = 2584, C_ZB = 3608;
constexpr int NCMP = 127;
constexpr int NSEQ = 132;
constexpr float EPS = 1e-6f;
constexpr int LDS_STAGE = 139264;
constexpr int LDS_BYTES = LDS_STAGE + 256;

constexpr size_t O_YP = 0;
constexpr size_t O_YS = O_YP + 16777216;
constexpr size_t O_CMP_P = O_YS + 2097152;
constexpr size_t O_SLC_P = O_CMP_P + 4194304;
constexpr size_t O_WIN_P = O_SLC_P + 4194304;
constexpr size_t O_ST_P = O_WIN_P + 1048576;
constexpr size_t O_CMP_S = O_ST_P + 524288;
constexpr size_t O_SLC_S = O_CMP_S + 524288;
constexpr size_t O_WIN_S = O_SLC_S + 524288;
constexpr size_t O_ST_S = O_WIN_S + 33554432;

struct Params {
    const float *x_prompt, *x_sample, *cache_cmp, *cache_slc, *cache_win, *state;
    const int* page_table;
    const float *g_norm, *w_in, *w_out, *g_q, *g_k_slc, *g_k_win, *g_k_cmp, *w_cmp_k, *w_cmp_v,
        *pe_k, *pe_v, *rel_bias, *lb_logits, *g_o;
    float* out;
    bf16_t *Hb, *Wt_in, *Wt_out, *MIXb, *Wc_t, *Qb, *KVb, *KCb, *VCb;
    float* PEB;
    float* PF; bf16_t* PH;
    float* GATE;
    bf16_t *OC, *OS, *OW;
    float* OH;
    unsigned long long* SEL;
    unsigned* bar;
    unsigned* ctr;
};

__device__ __forceinline__ const float* xrow(const Params& p, int m) {
    return m < MP ? p.x_prompt + (size_t)m * D : p.x_sample + (size_t)(m - MP) * D;
}

__device__ __forceinline__ int rel_bucket(int dist) {
    int n = dist < 0 ? 0 : dist;
    if (n < 16) return n;
    int b = 16;
    b += (n >= 19) + (n >= 21) + (n >= 24) + (n >= 27) + (n >= 31) + (n >= 35) + (n >= 40) +
         (n >= 46) + (n >= 52) + (n >= 59) + (n >= 67) + (n >= 77) + (n >= 87) + (n >= 99) +
         (n >= 113);
    return b;
}

__device__ __forceinline__ float wave_sum(float v) {
#pragma unroll
    for (int o = 32; o >= 1; o >>= 1) v += __shfl_xor(v, o, 64);
    return v;
}
__device__ __forceinline__ float wave_max(float v) {
#pragma unroll
    for (int o = 32; o >= 1; o >>= 1) v = fmaxf(v, __shfl_xor(v, o, 64));
    return v;
}
__device__ __forceinline__ float half_sum(float v) {
#pragma unroll
    for (int o = 16; o >= 1; o >>= 1) v += __shfl_xor(v, o, 64);
    return v;
}
__device__ __forceinline__ float sigmoidf_(float x) { return __builtin_amdgcn_rcpf(1.0f + __expf(-x)); }
__device__ __forceinline__ float siluf_(float x) { return x * __builtin_amdgcn_rcpf(1.0f + __expf(-x)); }
__device__ __forceinline__ unsigned pk2(float lo, float hi) { return pg8::cvt_pk_bf16(lo, hi); }
__device__ __forceinline__ float bflo(unsigned u) { return __uint_as_float(u << 16); }
__device__ __forceinline__ float bfhi(unsigned u) { return __uint_as_float(u & 0xffff0000u); }
__device__ __forceinline__ float4 bf4(uint2 u) { return make_float4(bflo(u.x), bfhi(u.x), bflo(u.y), bfhi(u.y)); }

__device__ __forceinline__ void tok_info(int m, int& n, int& qpos) {
    if (m < MP) { n = m >> 11; qpos = m & 2047; }
    else { int j = m - MP; n = 4 + (j >> 3); qpos = 2048 + (j & 7); }
}

__device__ __forceinline__ int q_next(unsigned* qctr, int cur, int bid, int nb, unsigned char* smem) {
    if (!qctr) return cur < 0 ? bid : cur + nb;
    volatile int* s_q = (volatile int*)(smem + LDS_STAGE + 48);
    __syncthreads();
    if (threadIdx.x == 0) *s_q = (int)__hip_atomic_fetch_add(qctr, 1u, __ATOMIC_RELAXED, __HIP_MEMORY_SCOPE_AGENT);
    __syncthreads();
    return *s_q;
}

__device__ __forceinline__ void tr_item(const float* W, int K, int N, bf16_t* WT, float* scr, int item, int lane, bool perm_in = false) {
    const int nblk = (N + 31) / 32, kb = item / nblk, nbk = item % nblk, k0 = 64 * kb, n0 = 32 * nbk;
    const int nn = n0 + (lane & 31);
    float wv[32];
#pragma unroll
    for (int i = 0; i < 32; ++i) wv[i] = nn < N ? W[(size_t)(k0 + 2 * i + (lane >> 5)) * N + nn] : 0.f;
#pragma unroll
    for (int i = 0; i < 32; ++i) scr[(2 * i + (lane >> 5)) * 33 + (lane & 31)] = wv[i];
    asm volatile("s_waitcnt lgkmcnt(0)" ::: "memory");
    const int c = lane & 7;
#pragma unroll
    for (int j = 0; j < 4; ++j) {
        const int n = (lane >> 3) + 8 * j;
        const float* s = scr + (8 * c) * 33 + n;
        uint4 o;
        o.x = pk2(s[0 * 33], s[1 * 33]); o.y = pk2(s[2 * 33], s[3 * 33]);
        o.z = pk2(s[4 * 33], s[5 * 33]); o.w = pk2(s[6 * 33], s[7 * 33]);
        int nr = n0 + n;
        if (perm_in) nr = nr < 3608 ? nr + NPF : (nr < 6680 ? nr - 3608 : nr);
        if (n0 + n < N) *(uint4*)(WT + (size_t)nr * K + k0 + 8 * c) = o;
    }
    asm volatile("s_waitcnt lgkmcnt(0)" ::: "memory");
}

__device__ __forceinline__ void ph_prologue(const Params& p, int bid, int nb, float* lds) {
    const int tid = threadIdx.x, lane = tid & 63, wave = tid >> 6;
    for (int r = (bid + nb - 64 % nb) % nb; r < 64; r += nb) {
        const int kvsel = r >> 5, l = r & 31;
        const float* W = (kvsel ? p.w_cmp_v : p.w_cmp_k) + (size_t)l * 128 * 128;
        const float* pe = (kvsel ? p.pe_v : p.pe_k) + l * 128;
        const int dsub = lane >> 5, e4 = lane & 31;
        pg8::f32x4 wv4[8]; float pv[8];
#pragma unroll
        for (int i = 0; i < 8; ++i) { const int d = 16 * wave + 2 * i + dsub; wv4[i] = *(const pg8::f32x4*)(W + d * 128 + 4 * e4); pv[i] = pe[d]; }
        pg8::f32x4 a4 = {0.f, 0.f, 0.f, 0.f};
#pragma unroll
        for (int i = 0; i < 8; ++i) a4 += wv4[i] * pv[i];
#pragma unroll
        for (int c = 0; c < 4; ++c) a4[c] += __shfl_xor(a4[c], 32, 64);
        if (lane < 32) *(pg8::f32x4*)(lds + wave * 128 + 4 * e4) = a4;
        __syncthreads();
        if (tid < 128) {
            float sum = 0.f;
#pragma unroll
            for (int w = 0; w < 8; ++w) sum += lds[w * 128 + tid];
            p.PEB[r * 128 + tid] = sum;
        }
        __syncthreads();
    }
    {
        float* scr = lds + wave * (64 * 33 + 16);
        const int gw = bid * 8 + wave, ngw = nb * 8;
        const int I_IN = 32 * ((NIN + 31) / 32), I_OUT = 32 * 64, I_C = 4 * 128;
        for (int it = gw; it < I_IN + I_OUT + I_C; it += ngw) {
            if (it < I_IN) tr_item(p.w_in, D, NIN, p.Wt_in, scr, it, lane, true);
            else if (it < I_IN + I_OUT) tr_item(p.w_out, 2048, D, p.Wt_out, scr, it - I_IN, lane);
            else {
                const int r = it - I_IN - I_OUT, q = r >> 7, kvsel = q >> 1, hh = q & 1;
                const float* W = (kvsel ? p.w_cmp_v : p.w_cmp_k) + (size_t)hh * 2048 * 128;
                tr_item(W, 2048, 128, p.Wc_t + ((size_t)kvsel * 256 + hh * 128) * 2048, scr, r & 127, lane);
            }
        }
    }
    __syncthreads();
    {
        const int gw = bid * 8 + wave, ngw = nb * 8;
        float4 gn[8];
#pragma unroll
        for (int j = 0; j < 8; ++j) gn[j] = ((const float4*)p.g_norm)[lane + 64 * j];
        for (int m = gw; m < M; m += 2 * ngw) {
            const int m1 = m + ngw;
            const bool has1 = m1 < M;
            const float4* x0 = (const float4*)xrow(p, m);
            const float4* x1 = (const float4*)xrow(p, has1 ? m1 : m);
            float4 v0[8], v1[8];
#pragma unroll
            for (int j = 0; j < 8; ++j) { v0[j] = x0[lane + 64 * j]; v1[j] = x1[lane + 64 * j]; }
            float s0 = 0.f, s1 = 0.f;
#pragma unroll
            for (int j = 0; j < 8; ++j) {
                s0 += v0[j].x * v0[j].x + v0[j].y * v0[j].y + v0[j].z * v0[j].z + v0[j].w * v0[j].w;
                s1 += v1[j].x * v1[j].x + v1[j].y * v1[j].y + v1[j].z * v1[j].z + v1[j].w * v1[j].w;
            }
            s0 = wave_sum(s0); s1 = wave_sum(s1);
            const float r0 = rsqrtf(s0 * (1.0f / D) + EPS), r1 = rsqrtf(s1 * (1.0f / D) + EPS);
            uint2* o0 = (uint2*)(p.Hb + (size_t)m * D);
            uint2* o1 = (uint2*)(p.Hb + (size_t)m1 * D);
#pragma unroll
            for (int j = 0; j < 8; ++j) {
                const float4 g = gn[j];
                o0[lane + 64 * j] = make_uint2(pk2(v0[j].x * r0 * g.x, v0[j].y * r0 * g.y), pk2(v0[j].z * r0 * g.z, v0[j].w * r0 * g.w));
                if (has1) o1[lane + 64 * j] = make_uint2(pk2(v1[j].x * r1 * g.x, v1[j].y * r1 * g.y), pk2(v1[j].z * r1 * g.z, v1[j].w * r1 * g.w));
            }
        }
    }
}

__device__ __forceinline__ void ph_wincopy(const Params& p, int bid, int nb, unsigned char* smem = nullptr, unsigned* qctr = nullptr) {
    const int tid = threadIdx.x;
    {
        const float4* srcw = (const float4*)(p.cache_win + 8 * 512);
        float4* dstw = (float4*)(p.out + O_WIN_S);
#define WC_IDX(j) ({ const unsigned i_ = (unsigned)ck * 4096u + (unsigned)(j) * 512u + (unsigned)tid; const unsigned sq_ = i_ / 64512u; sq_ * 65536u + (i_ - sq_ * 64512u); })
        for (int ck = q_next(qctr, -1, bid, nb, smem); ck < 2016; ck = q_next(qctr, ck, bid, nb, smem)) {
            const unsigned i0 = WC_IDX(0), i1 = WC_IDX(1), i2 = WC_IDX(2), i3 = WC_IDX(3), i4 = WC_IDX(4), i5 = WC_IDX(5), i6 = WC_IDX(6), i7 = WC_IDX(7);
            typedef pg8::f32x4 f4;
            const f4* sw_ = (const f4*)srcw; f4* dw_ = (f4*)dstw;
            const f4 w0 = __builtin_nontemporal_load(sw_ + i0), w1 = __builtin_nontemporal_load(sw_ + i1), w2 = __builtin_nontemporal_load(sw_ + i2), w3 = __builtin_nontemporal_load(sw_ + i3),
                     w4 = __builtin_nontemporal_load(sw_ + i4), w5 = __builtin_nontemporal_load(sw_ + i5), w6 = __builtin_nontemporal_load(sw_ + i6), w7 = __builtin_nontemporal_load(sw_ + i7);
            __builtin_nontemporal_store(w0, dw_ + i0); __builtin_nontemporal_store(w1, dw_ + i1); __builtin_nontemporal_store(w2, dw_ + i2); __builtin_nontemporal_store(w3, dw_ + i3);
            __builtin_nontemporal_store(w4, dw_ + i4); __builtin_nontemporal_store(w5, dw_ + i5); __builtin_nontemporal_store(w6, dw_ + i6); __builtin_nontemporal_store(w7, dw_ + i7);
        }
#undef WC_IDX
    }
}

__device__ __forceinline__ void post_token(const Params& p, const int m, const float2 (&v)[20], const float gt, const int lane, const int l2,
                                           const float2 gq, const float2 gs, const float2 gwn) {
        float ss[20];
#pragma unroll
        for (int ch = 0; ch < 20; ++ch) ss[ch] = v[ch].x * v[ch].x + v[ch].y * v[ch].y;
#pragma unroll
        for (int o = 32; o >= 1; o >>= 1) {
#pragma unroll
            for (int ch = 0; ch < 20; ++ch) ss[ch] += __shfl_xor(ss[ch], o, 64);
        }
#pragma unroll
        for (int ch = 0; ch < 8; ++ch) {
            const float r = rsqrtf(ss[ch] * (1.0f / 128) + EPS) * 0.08838834764831845f;
            *(unsigned*)&p.Qb[(size_t)m * 1024 + ch * 128 + l2] = pk2(v[ch].x * r * gq.x, v[ch].y * r * gq.y);
        }
#pragma unroll
        for (int c = 0; c < 12; ++c) {
            const int br = c >> 2, kv = (c >> 1) & 1, gg = c & 1;
            float2 w = v[8 + c];
            if (br >= 1 && kv == 0) {
                const float r = rsqrtf(ss[8 + c] * (1.0f / 128) + EPS);
                const float2 gk = (br == 1) ? gs : gwn;
                w.x *= r * gk.x; w.y *= r * gk.y;
            }
            const int sub = (c & 3) * 128 + l2;
            if (m < MP) {
                const int b = m >> 11, t = m & 2047;
                if (br >= 1)
                    *(unsigned*)&p.KVb[((((size_t)((br - 1) * 2 + kv) * 4 + b) * 2 + gg) * 2048 + t) * 128 + l2] = pk2(w.x, w.y);
                if (br == 0) *(float2*)&p.out[O_CMP_P + (size_t)m * 512 + sub] = w;
                else if (br == 1) *(float2*)&p.out[O_SLC_P + (size_t)m * 512 + sub] = w;
                else if (t >= 1536) *(float2*)&p.out[O_WIN_P + ((size_t)b * 512 + (t - 1536)) * 512 + sub] = w;
            } else {
                const int j = m - MP;
                if (br == 0) *(float2*)&p.out[O_CMP_S + (size_t)j * 512 + sub] = w;
                else if (br == 1) *(float2*)&p.out[O_SLC_S + (size_t)j * 512 + sub] = w;
                else *(float2*)&p.out[O_WIN_S + ((size_t)(j >> 3) * 512 + 504 + (j & 7)) * 512 + sub] = w;
            }
        }
        if (lane < 24) p.GATE[(size_t)m * 24 + lane] = sigmoidf_(gt);
}

__device__ __forceinline__ void ph_post(const Params& p, int bid, int nb) {
    const int lane = threadIdx.x & 63, wave = threadIdx.x >> 6;
    const int gw = bid * 8 + wave, ngw = nb * 8;
    const int l2 = lane * 2;
    const float2 gq = *(const float2*)&p.g_q[l2], gs = *(const float2*)&p.g_k_slc[l2], gwn = *(const float2*)&p.g_k_win[l2];
    for (int m = gw; m < M; m += 2 * ngw) {
        const int m1 = m + ngw;
        const bool has1 = m1 < M;
        const bf16_t* row0 = p.PH + (size_t)m * LDH;
        const bf16_t* row1 = p.PH + (size_t)(has1 ? m1 : m) * LDH;
        float2 v0[20], v1[20];
#pragma unroll
        for (int ch = 0; ch < 20; ++ch) {
            const int col = (ch < 8 ? C_QA + ch * 128 : C_KV + (ch - 8) * 128) + l2;
            const unsigned u0 = *(const unsigned*)&row0[col], u1 = *(const unsigned*)&row1[col];
            v0[ch] = make_float2(bflo(u0), bfhi(u0)); v1[ch] = make_float2(bflo(u1), bfhi(u1));
        }
        const float gt0 = (lane < 24) ? bflo((unsigned)row0[C_GATE + lane]) : 0.f, gt1 = (lane < 24) ? bflo((unsigned)row1[C_GATE + lane]) : 0.f;
        post_token(p, m, v0, gt0, lane, l2, gq, gs, gwn);
        if (has1) post_token(p, m1, v1, gt1, lane, l2, gq, gs, gwn);
    }
}

__device__ __forceinline__ void ph_cmp_mfma(const Params& p, int limit, bool early_stop, unsigned char* smem, int maxu = 1 << 30) {
    typedef pg8::bf16x8 bf16x8;
    typedef pg8::f32x4 f32x4;
    const int tid = threadIdx.x, lane = tid & 63, wid = tid >> 6, wm = wid >> 2, wn = wid & 3, fr = lane & 15, fq = lane >> 4;
    const int arow0 = tid >> 5, apc = tid & 31;
    const int brow0 = tid >> 4, bpc = tid & 15;
    float* Cs = (float*)smem;
    unsigned char* bufA = smem;
    unsigned char* bufB = smem + 32768;
    volatile int* s_u = (volatile int*)(smem + LDS_STAGE + 32);
    for (int nu = 0;; ++nu) {
        __syncthreads();
        if (tid == 0) {
            int uu = limit;
            if (nu < maxu && !(early_stop && __hip_atomic_load(&p.ctr[64], __ATOMIC_RELAXED, __HIP_MEMORY_SCOPE_AGENT) != 0u)) {
                uu = (int)__hip_atomic_fetch_add(&p.ctr[0], 1u, __ATOMIC_RELAXED, __HIP_MEMORY_SCOPE_AGENT);
                if (uu >= limit && limit < NSEQ * 4) {
                    (void)__hip_atomic_fetch_sub(&p.ctr[0], 1u, __ATOMIC_RELAXED, __HIP_MEMORY_SCOPE_AGENT);
                    uu = limit;
                }
            }
            *s_u = uu;
        }
        __syncthreads();
        const int u = *s_u;
        if (u >= limit) break;
        const int n = (u < 512) ? 4 + (u >> 2) : ((u - 512) >> 2);
        const int g = (u >> 1) & 1, kvsel = u & 1;
        const float* abase[8]; size_t lstride;
        if (n >= 4) {
            lstride = 512;
#pragma unroll
            for (int j = 0; j < 8; ++j) {
                const int ar = arow0 + 16 * j;
                const int page = p.page_table[(n - 4) * 16 + (ar >> 3)];
                abase[j] = p.cache_cmp + ((((size_t)page * 128 + 16 * (ar & 7)) * 2 + kvsel) * 2 + g) * 128 + apc * 4;
            }
        } else {
            lstride = LDH / 2;
#pragma unroll
            for (int j = 0; j < 8; ++j)
                abase[j] = (const float*)(p.PH + ((size_t)n * 2048 + 16 * (arow0 + 16 * j)) * LDH + C_KV + kvsel * 256 + g * 128 + (apc & ~1) * 4);
        }
        const bool a16 = (n < 4);
        const bf16_t* bbase = p.Wc_t + ((size_t)kvsel * 256 + brow0) * 2048 + bpc * 8;
        f32x4 acc[4][4];
#pragma unroll
        for (int m = 0; m < 4; ++m)
#pragma unroll
            for (int q = 0; q < 4; ++q) acc[m][q] = (f32x4){0.f, 0.f, 0.f, 0.f};
        f32x4 ra[8]; pg8::u32x4 rb[8];
#pragma unroll
        for (int j = 0; j < 8; ++j) {
            ra[j] = __builtin_nontemporal_load((const f32x4*)abase[j]);
            rb[j] = *(const pg8::u32x4*)(bbase + (size_t)32 * j * 2048);
        }
        for (int ss = 0; ss < 16; ++ss) {
#pragma unroll
            for (int j = 0; j < 8; ++j) {
                const int ar = arow0 + 16 * j, br = brow0 + 32 * j;
                if (a16) { if (!(apc & 1)) *(f32x4*)(bufA + ar * 256 + ((((unsigned)apc >> 1) ^ (unsigned)(ar & 15)) << 4)) = ra[j]; }
                else *(uint2*)(bufA + ar * 256 + ((((unsigned)apc >> 1) ^ (unsigned)(ar & 15)) << 4) + 8 * (apc & 1)) =
                    make_uint2(pk2(ra[j][0], ra[j][1]), pk2(ra[j][2], ra[j][3]));
                *(pg8::u32x4*)(bufB + br * 256 + (((unsigned)bpc ^ (unsigned)(br & 15)) << 4)) = rb[j];
            }
            __syncthreads();
            if (ss + 1 < 16) {
#pragma unroll
                for (int j = 0; j < 8; ++j) {
                    ra[j] = __builtin_nontemporal_load((const f32x4*)(abase[j] + (size_t)(ss + 1) * lstride));
                    rb[j] = *(const pg8::u32x4*)(bbase + (size_t)32 * j * 2048 + (ss + 1) * 128);
                }
            }
#pragma unroll
            for (int sub = 0; sub < 4; ++sub) {
                bf16x8 Af[4], Bf[4];
#pragma unroll
                for (int m = 0; m < 4; ++m) {
                    const int r = wm * 64 + 16 * m + fr;
                    Af[m] = *(const bf16x8*)(bufA + r * 256 + (((unsigned)(4 * sub + fq) ^ (unsigned)(r & 15)) << 4));
                }
#pragma unroll
                for (int q = 0; q < 4; ++q) {
                    const int r = wn * 64 + 16 * q + fr;
                    Bf[q] = *(const bf16x8*)(bufB + r * 256 + (((unsigned)(4 * sub + fq) ^ (unsigned)(r & 15)) << 4));
                }
#pragma unroll
                for (int m = 0; m < 4; ++m)
#pragma unroll
                    for (int q = 0; q < 4; ++q)
                        acc[m][q] = __builtin_amdgcn_mfma_f32_16x16x32_bf16(Bf[q], Af[m], acc[m][q], 0, 0, 0);
            }
            __syncthreads();
        }
        __syncthreads();
#pragma unroll
        for (int m = 0; m < 4; ++m)
#pragma unroll
            for (int q = 0; q < 4; ++q)
                *(f32x4*)(Cs + (wm * 64 + 16 * m + fr) * 260 + wn * 64 + 16 * q + 4 * fq) = acc[m][q];
        __syncthreads();
        {
            float pb0 = 0.f, pb1 = 0.f;
            for (int l = 0; l < 32; ++l) {
                pb0 += p.PEB[(kvsel * 32 + l) * 128 + lane];
                pb1 += p.PEB[(kvsel * 32 + l) * 128 + lane + 64];
            }
            bf16_t* dst = (kvsel ? p.VCb : p.KCb) + ((size_t)(n * 2 + g) * 128) * 128;
            const float g0 = p.g_k_cmp[lane], g1 = p.g_k_cmp[lane + 64];
            for (int c = wid; c < 128; c += 8) {
                float v0 = 0.f, v1 = 0.f;
                if (c < NCMP) {
                    v0 = Cs[c * 260 + lane] + Cs[(c + 1) * 260 + 128 + lane] + pb0;
                    v1 = Cs[c * 260 + lane + 64] + Cs[(c + 1) * 260 + 192 + lane] + pb1;
                    if (kvsel == 0) {
                        const float ss = wave_sum(v0 * v0 + v1 * v1);
                        const float rr = rsqrtf(ss * (1.0f / 128) + EPS);
                        v0 *= rr * g0; v1 *= rr * g1;
                    }
                }
                const unsigned pk = pk2(v0, v1);
                dst[c * 128 + lane] = (bf16_t)(pk & 0xffffu);
                dst[c * 128 + lane + 64] = (bf16_t)(pk >> 16);
            }
        }
        __syncthreads();
    }
}

__device__ __forceinline__ unsigned fvsw(int row) { return (unsigned)(((row & 3) << 2) | (((row >> 2) & 1) << 1) | ((row >> 3) & 1)); }

__device__ __forceinline__ void ph_cmp_attn_mfma(const Params& p, int bid, int nb, unsigned char* smem) {
    typedef pg8::bf16x8 bf16x8;
    typedef pg8::f32x4 f32x4;
    typedef short s16x4 __attribute__((ext_vector_type(4)));
    const int tid = threadIdx.x, lane = tid & 63, wid = tid >> 6, fr = lane & 15, fq = lane >> 4, hl = fr & 3;
    unsigned char* Kb = smem;
    unsigned char* Vb = smem + 32768;
    float* bt = (float*)(smem + 65536);
    float* sA = (float*)(smem + 65536 + 2048);
    float* sB = sA + 1024;
    float* skey = sB + 1024;
    unsigned long long* smask = (unsigned long long*)(skey + 32 * 36);
    for (int it = bid; it < 512 + 256; it += nb) {
        int n, g, m0, qpos0, ntok;
        if (it < 512) { const int bg = it >> 6; n = bg >> 1; g = bg & 1; const int qt = it & 63; m0 = n * 2048 + qt * 32; qpos0 = qt * 32; ntok = 32; }
        else { const int j = it - 512; const int sq = j >> 1; g = j & 1; n = 4 + sq; m0 = MP + sq * 8; qpos0 = 2048; ntok = 8; }
        const int tl = (ntok == 32) ? 4 * wid + (fr >> 2) : 4 * (wid & 1) + (fr >> 2);
        const bool wr = (ntok == 32) || (wid < 2);
        const int m = m0 + tl, tq = qpos0 + tl;
        __syncthreads();
        bf16x8 Qf[4];
        {
            const int row = tid >> 2;
            const bf16_t* kc = p.KCb + ((size_t)(n * 2 + g) * 128 + row) * 128;
            const bf16_t* vc = p.VCb + ((size_t)(n * 2 + g) * 128 + row) * 128;
            pg8::u32x4 kk[4], vk[4];
#pragma unroll
            for (int jj = 0; jj < 4; ++jj) {
                const unsigned ch = (unsigned)((tid & 3) * 4 + jj);
                kk[jj] = *(const pg8::u32x4*)(kc + ch * 8);
                vk[jj] = *(const pg8::u32x4*)(vc + ch * 8);
            }
            const float btv = p.rel_bias[rel_bucket(tid & 127) * 8 + g * 4 + (tid >> 7)];
            const bf16_t* qp = p.Qb + (size_t)m * 1024 + (g * 4 + hl) * 128 + 8 * fq;
#pragma unroll
            for (int sx = 0; sx < 4; ++sx) Qf[sx] = *(const bf16x8*)(qp + 32 * sx);
            asm volatile("" : "+v"(kk[0]), "+v"(kk[1]), "+v"(kk[2]), "+v"(kk[3]), "+v"(vk[0]), "+v"(vk[1]), "+v"(vk[2]), "+v"(vk[3]) :: "memory");
            bt[tid] = btv;
            if (tid < 32) smask[tid] = 0ull;
#pragma unroll
            for (int jj = 0; jj < 4; ++jj) {
                const unsigned ch = (unsigned)((tid & 3) * 4 + jj);
                *(pg8::u32x4*)(Kb + row * 256 + ((ch ^ (unsigned)(row & 15)) << 4)) = kk[jj];
                *(pg8::u32x4*)(Vb + row * 256 + ((ch ^ fvsw(row)) << 4)) = vk[jj];
            }
        }
        __syncthreads();
        f32x4 S[8];
#pragma unroll
        for (int nt = 0; nt < 8; ++nt) {
            const int r = 16 * nt + fr;
            S[nt] = (f32x4){0.f, 0.f, 0.f, 0.f};
#pragma unroll
            for (int sx = 0; sx < 4; ++sx) {
                const bf16x8 Kf = *(const bf16x8*)(Kb + r * 256 + (((unsigned)(4 * sx + fq) ^ (unsigned)(r & 15)) << 4));
                S[nt] = __builtin_amdgcn_mfma_f32_16x16x32_bf16(Kf, Qf[sx], S[nt], 0, 0, 0);
            }
        }
        float tmax = -INFINITY;
#pragma unroll
        for (int nt = 0; nt < 8; ++nt)
#pragma unroll
            for (int i = 0; i < 4; ++i) {
                const int c = 16 * nt + 4 * fq + i;
                const int dist = tq - (16 * c + 31);
                const bool valid = dist >= 0 && c < NCMP;
                const float bias = bt[hl * 128 + (dist < 0 ? 0 : (dist > 127 ? 127 : dist))];
                const float sv = valid ? S[nt][i] + bias : -INFINITY;
                S[nt][i] = sv;
                tmax = fmaxf(tmax, sv);
            }
        tmax = fmaxf(tmax, __shfl_xor(tmax, 16, 64));
        tmax = fmaxf(tmax, __shfl_xor(tmax, 32, 64));
        const bool dead = (tmax == -INFINITY);
        float psum = 0.f;
#pragma unroll
        for (int nt = 0; nt < 8; ++nt)
#pragma unroll
            for (int i = 0; i < 4; ++i) {
                const float pv = dead ? 0.f : __expf(S[nt][i] - tmax);
                S[nt][i] = pv;
                psum += pv;
            }
        psum += __shfl_xor(psum, 16, 64);
        psum += __shfl_xor(psum, 32, 64);
        const float inv = psum > 0.f ? 1.0f / psum : 0.f;
#pragma unroll
        for (int nt = 0; nt < 8; ++nt) { S[nt][0] *= inv; S[nt][1] *= inv; S[nt][2] *= inv; S[nt][3] *= inv; }
#pragma unroll
        for (int nt = 0; nt < 8; ++nt) {
            float av = 2.f * (S[nt][0] + S[nt][1] + S[nt][2]) + S[nt][3];
            float bv = S[nt][3];
            av += __shfl_xor(av, 1, 64); av += __shfl_xor(av, 2, 64);
            bv += __shfl_xor(bv, 1, 64); bv += __shfl_xor(bv, 2, 64);
            if (hl == 0 && wr) { sA[tl * 32 + 4 * nt + fq] = av; sB[tl * 32 + 4 * nt + fq] = bv; }
        }
        f32x4 O[8];
#pragma unroll
        for (int c = 0; c < 8; ++c) O[c] = (f32x4){0.f, 0.f, 0.f, 0.f};
#pragma unroll
        for (int ks = 0; ks < 4; ++ks) {
            union { unsigned u[4]; bf16x8 v; } cv;
            cv.u[0] = pk2(S[2 * ks][0], S[2 * ks][1]); cv.u[1] = pk2(S[2 * ks][2], S[2 * ks][3]);
            cv.u[2] = pk2(S[2 * ks + 1][0], S[2 * ks + 1][1]); cv.u[3] = pk2(S[2 * ks + 1][2], S[2 * ks + 1][3]);
            const bf16x8 Pf = cv.v;
#pragma unroll
            for (int c = 0; c < 8; ++c) {
                const int r0 = 32 * ks + 4 * fq + (fr >> 2), r1 = r0 + 16;
                const unsigned ch = (unsigned)(2 * c + ((fr & 3) >> 1));
                const s16x4 a0 = __builtin_amdgcn_ds_read_tr16_b64_v4i16((__attribute__((address_space(3))) s16x4*)(Vb + r0 * 256 + ((ch ^ fvsw(r0)) << 4) + 8 * (fr & 1)));
                const s16x4 a1 = __builtin_amdgcn_ds_read_tr16_b64_v4i16((__attribute__((address_space(3))) s16x4*)(Vb + r1 * 256 + ((ch ^ fvsw(r1)) << 4) + 8 * (fr & 1)));
                const bf16x8 Vf = {a0[0], a0[1], a0[2], a0[3], a1[0], a1[1], a1[2], a1[3]};
                O[c] = __builtin_amdgcn_mfma_f32_16x16x32_bf16(Vf, Pf, O[c], 0, 0, 0);
            }
        }
        if (wr) {
            bf16_t* op = p.OC + (size_t)m * 1024 + (g * 4 + hl) * 128 + 4 * fq;
#pragma unroll
            for (int c = 0; c < 8; ++c) *(uint2*)(op + 16 * c) = make_uint2(pk2(O[c][0], O[c][1]), pk2(O[c][2], O[c][3]));
        }
        __syncthreads();
        const int tokl = tid >> 4, jb = 2 * (tid & 15);
        const bool active = tokl < ntok;
        const int cur = (qpos0 + tokl) >> 6;
#pragma unroll
        for (int e = 0; e < 2; ++e) {
            const int j = jb + e;
            const float scv = sA[tokl * 32 + j] + (j > 0 ? sB[tokl * 32 + j - 1] : 0.f);
            const bool valid = j <= cur;
            const bool forced = (j == 0) || (j == cur) || (j == cur - 1);
            skey[tokl * 36 + j] = (active && valid) ? (forced ? INFINITY : scv) : -INFINITY;
        }
        if ((tid & 15) == 0) skey[tokl * 36 + 32] = (ntok == 8) ? INFINITY : -INFINITY;
        __syncthreads();
        const int nslc = (ntok == 32) ? 32 : 33;
#pragma unroll
        for (int e = 0; e < 2; ++e) {
            const int j = jb + e;
            const float key = skey[tokl * 36 + j];
            int rank = 0;
            for (int j2 = 0; j2 < nslc; ++j2) {
                const float k2 = skey[tokl * 36 + j2];
                rank += (k2 > key) || (k2 == key && j2 < j);
            }
            if (active && rank < 16 && j <= cur) atomicOr(&smask[tokl], 1ull << j);
        }
        if (ntok == 8 && active && (tid & 15) == 0) atomicOr(&smask[tokl], 1ull << 32);
        __syncthreads();
        if (tid < ntok) p.SEL[(m0 + tid) * 2 + g] = smask[tid];
    }
}


template <int BR>
__device__ __forceinline__ void ph_attn_prompt(const Params& p, int bid, int nb, unsigned char* smem, unsigned* qctr = nullptr) {
    typedef pg8::bf16x8 bf16x8;
    typedef pg8::f32x4 f32x4;
    typedef short s16x4 __attribute__((ext_vector_type(4)));
    const int tid = threadIdx.x, lane = tid & 63, wid = tid >> 6, fr = lane & 15, fq = lane >> 4, hl = fr & 3;
    float* bt = (float*)(smem + 65536);
    const int srow = tid >> 4, spc = tid & 15;
    const unsigned ksw = (unsigned)(srow & 15), vsw = fvsw(srow);
    for (int pi = q_next(qctr, -1, bid, nb, smem); pi < 256; pi = q_next(qctr, pi, bid, nb, smem)) {
        const int bg = pi >> 5, b = bg >> 1, g = bg & 1, a = pi & 31;
        __syncthreads();
        bt[tid] = p.rel_bias[rel_bucket(tid & 127) * 8 + g * 4 + (tid >> 7)];
        float b31 = p.rel_bias[31 * 8 + g * 4 + hl];
        const bf16_t* Kg = p.KVb + ((((size_t)(BR * 2 + 0) * 4 + b) * 2 + g) * 2048) * 128;
        const bf16_t* Vg = p.KVb + ((((size_t)(BR * 2 + 1) * 4 + b) * 2 + g) * 2048) * 128;
        bf16_t* Og = (BR == 0) ? p.OS : p.OW;
        for (int half = 0; half < 2; ++half) {
            const int qt = half ? 63 - a : a, t0 = qt * 32;
            const int tq = t0 + 4 * wid + (fr >> 2);
            const int m = b * 2048 + tq;
            bf16x8 Qf[4];
            {
                const bf16_t* qp = p.Qb + (size_t)m * 1024 + (g * 4 + hl) * 128 + 8 * fq;
#pragma unroll
                for (int sx = 0; sx < 4; ++sx) Qf[sx] = *(const bf16x8*)(qp + 32 * sx);
            }
            unsigned selmask = (BR == 0) ? (unsigned)p.SEL[m * 2 + g] : 0u;
            const int jhi = (t0 + 31) >> 6;
            const int jlo = (BR == 0) ? 0 : ((t0 - 512) > 0 ? ((t0 - 512) >> 6) : 0);
            f32x4 O[8];
#pragma unroll
            for (int c = 0; c < 8; ++c) O[c] = (f32x4){0.f, 0.f, 0.f, 0.f};
            float mrun = -INFINITY, lrun = 0.f;
            typedef pg8::u32x4 u32x4;
            u32x4 kr[2][2], vr[2][2];
#pragma unroll
            for (int par = 0; par < 2; ++par) {
                {
                    const int jl = (jlo + par <= jhi) ? jlo + par : jhi;
                    const bf16_t* kp = Kg + ((size_t)jl * 64 + srow) * 128 + spc * 8;
                    const bf16_t* vp = Vg + ((size_t)jl * 64 + srow) * 128 + spc * 8;
                    kr[par][0] = *(const u32x4*)kp; kr[par][1] = *(const u32x4*)(kp + 32 * 128);
                    vr[par][0] = *(const u32x4*)vp; vr[par][1] = *(const u32x4*)(vp + 32 * 128);
                }
            }
            asm volatile("" : "+v"(Qf[0]), "+v"(Qf[1]), "+v"(Qf[2]), "+v"(Qf[3]), "+v"(b31), "+v"(selmask) :: "memory");
            __syncthreads();
            for (int jj = jlo; jj <= jhi; jj += 2) {
#pragma unroll
              for (int par = 0; par < 2; ++par) {
                const int j = jj + par;
                if (j > jhi) break;
                unsigned char* Kb = smem + par * 32768;
                unsigned char* Vb = Kb + 16384;
                *(u32x4*)(Kb + srow * 256 + (((unsigned)spc ^ ksw) << 4)) = kr[par][0];
                *(u32x4*)(Kb + (srow + 32) * 256 + (((unsigned)spc ^ ksw) << 4)) = kr[par][1];
                *(u32x4*)(Vb + srow * 256 + (((unsigned)spc ^ vsw) << 4)) = vr[par][0];
                *(u32x4*)(Vb + (srow + 32) * 256 + (((unsigned)spc ^ vsw) << 4)) = vr[par][1];
                __syncthreads();
                {
                    const int jn = (j + 2 <= jhi) ? j + 2 : jhi;
                    const bf16_t* kp = Kg + ((size_t)jn * 64 + srow) * 128 + spc * 8;
                    const bf16_t* vp = Vg + ((size_t)jn * 64 + srow) * 128 + spc * 8;
                    kr[par][0] = *(const u32x4*)kp; kr[par][1] = *(const u32x4*)(kp + 32 * 128);
                    vr[par][0] = *(const u32x4*)vp; vr[par][1] = *(const u32x4*)(vp + 32 * 128);
                }
                const int kbase = j * 64;
                f32x4 S[4];
#pragma unroll
                for (int nt = 0; nt < 4; ++nt) {
                    const int r = 16 * nt + fr;
                    S[nt] = (f32x4){0.f, 0.f, 0.f, 0.f};
#pragma unroll
                    for (int sx = 0; sx < 4; ++sx) {
                        const bf16x8 Kf = *(const bf16x8*)(Kb + r * 256 + (((unsigned)(4 * sx + fq) ^ (unsigned)(r & 15)) << 4));
                        S[nt] = __builtin_amdgcn_mfma_f32_16x16x32_bf16(Kf, Qf[sx], S[nt], 0, 0, 0);
                    }
                }
                const bool far = (t0 - (kbase + 63)) >= 113;
                const bool selok = (BR == 0) ? (((selmask >> j) & 1u) != 0u) : true;
                float tmax = -INFINITY;
                if (far && (BR == 0 || (t0 + 31 - kbase) <= 512)) {
                    const float add = selok ? b31 : -INFINITY;
#pragma unroll
                    for (int nt = 0; nt < 4; ++nt)
#pragma unroll
                        for (int i = 0; i < 4; ++i) { const float sv = S[nt][i] + add; S[nt][i] = sv; tmax = fmaxf(tmax, sv); }
                } else {
#pragma unroll
                for (int nt = 0; nt < 4; ++nt)
#pragma unroll
                    for (int i = 0; i < 4; ++i) {
                        const int dist = tq - (kbase + 16 * nt + 4 * fq + i);
                        bool valid = selok && dist >= 0;
                        if (BR == 1) valid = valid && dist <= 512;
                        const float bias = far ? b31 : bt[hl * 128 + (dist < 0 ? 0 : (dist > 127 ? 127 : dist))];
                        const float sv = valid ? S[nt][i] + bias : -INFINITY;
                        S[nt][i] = sv;
                        tmax = fmaxf(tmax, sv);
                    }
                }
                tmax = fmaxf(tmax, __shfl_xor(tmax, 16, 64));
                tmax = fmaxf(tmax, __shfl_xor(tmax, 32, 64));
                const float mnew = fmaxf(mrun, tmax);
                const bool dead = (mnew == -INFINITY);
                const float scale = (mrun == -INFINITY) ? 0.f : __expf(mrun - mnew);
                float psum = 0.f;
#pragma unroll
                for (int nt = 0; nt < 4; ++nt)
#pragma unroll
                    for (int i = 0; i < 4; ++i) {
                        const float pv = dead ? 0.f : __expf(S[nt][i] - mnew);
                        S[nt][i] = pv;
                        psum += pv;
                    }
                lrun = lrun * scale + psum;
                mrun = mnew;
#pragma unroll
                for (int c = 0; c < 8; ++c) { O[c][0] *= scale; O[c][1] *= scale; O[c][2] *= scale; O[c][3] *= scale; }
                bf16x8 Pf[2];
#pragma unroll
                for (int ks = 0; ks < 2; ++ks) {
                    union { unsigned u[4]; bf16x8 v; } cv;
                    cv.u[0] = pk2(S[2 * ks][0], S[2 * ks][1]); cv.u[1] = pk2(S[2 * ks][2], S[2 * ks][3]);
                    cv.u[2] = pk2(S[2 * ks + 1][0], S[2 * ks + 1][1]); cv.u[3] = pk2(S[2 * ks + 1][2], S[2 * ks + 1][3]);
                    Pf[ks] = cv.v;
                }
#pragma unroll
                for (int c = 0; c < 8; ++c)
#pragma unroll
                    for (int ks = 0; ks < 2; ++ks) {
                        const int r0 = 32 * ks + 4 * fq + (fr >> 2), r1 = r0 + 16;
                        const unsigned ch = (unsigned)(2 * c + ((fr & 3) >> 1));
                        const s16x4 v0 = __builtin_amdgcn_ds_read_tr16_b64_v4i16((__attribute__((address_space(3))) s16x4*)(Vb + r0 * 256 + ((ch ^ fvsw(r0)) << 4) + 8 * (fr & 1)));
                        const s16x4 v1 = __builtin_amdgcn_ds_read_tr16_b64_v4i16((__attribute__((address_space(3))) s16x4*)(Vb + r1 * 256 + ((ch ^ fvsw(r1)) << 4) + 8 * (fr & 1)));
                        const bf16x8 Vf = {v0[0], v0[1], v0[2], v0[3], v1[0], v1[1], v1[2], v1[3]};
                        O[c] = __builtin_amdgcn_mfma_f32_16x16x32_bf16(Vf, Pf[ks], O[c], 0, 0, 0);
                    }
              }
            }
            float l = lrun + __shfl_xor(lrun, 16, 64);
            l += __shfl_xor(l, 32, 64);
            const float inv = l > 0.f ? 1.0f / l : 0.f;
            bf16_t* op = Og + (size_t)m * 1024 + (g * 4 + hl) * 128 + 4 * fq;
#pragma unroll
            for (int c = 0; c < 8; ++c)
                *(uint2*)(op + 16 * c) = make_uint2(pk2(O[c][0] * inv, O[c][1] * inv), pk2(O[c][2] * inv, O[c][3] * inv));
        }
    }
}


template <int BR>
__device__ __forceinline__ void ph_attn_sample(const Params& p, int bid, int nb, unsigned char* smem, unsigned* qctr = nullptr) {
    typedef pg8::bf16x8 bf16x8;
    typedef pg8::f32x4 f32x4;
    typedef short s16x4 __attribute__((ext_vector_type(4)));
    const int tid = threadIdx.x, lane = tid & 63, wid = tid >> 6, fr = lane & 15, fq = lane >> 4, hl = fr & 3;
    const int mt = wid & 1, kh = (wid >> 1) & 1, dh = wid >> 2;
    float* bt = (float*)(smem + 65536);
    float* mrg = (float*)(smem + 65536 + 2048);
    int* pgs = (int*)(smem + 65536 + 2048 + 36864);
    const int srow = tid >> 5, spc = tid & 31;
    const unsigned ksw = (unsigned)(srow & 15), vsw = fvsw(srow);
    for (int it = q_next(qctr, -1, bid, nb, smem); it < 256; it = q_next(qctr, it, bid, nb, smem)) {
        const int s = __builtin_amdgcn_readfirstlane(it >> 1), g = __builtin_amdgcn_readfirstlane(it & 1);
        __syncthreads();
        bt[tid] = p.rel_bias[rel_bucket(tid & 127) * 8 + g * 4 + (tid >> 7)];
        if (BR == 0) { if (tid < 16) pgs[tid] = p.page_table[s * 16 + tid]; __syncthreads(); }
        float b31 = p.rel_bias[31 * 8 + g * 4 + hl];
        const int ti = 4 * mt + (fr >> 2);
        const int m = MP + s * 8 + ti;
        const int tq = (BR == 0) ? 2048 + ti : 512 + ti;
        bf16x8 Qf[4];
        {
            const bf16_t* qp = p.Qb + (size_t)m * 1024 + (g * 4 + hl) * 128 + 8 * fq;
#pragma unroll
            for (int sx = 0; sx < 4; ++sx) Qf[sx] = *(const bf16x8*)(qp + 32 * sx);
        }
        unsigned long long selmask = 0ull, tmask;
        if (BR == 0) {
            selmask = p.SEL[m * 2 + g];
            unsigned long long om = p.SEL[(MP + s * 8 + (lane & 7)) * 2 + g];
            om |= __shfl_xor(om, 1, 64); om |= __shfl_xor(om, 2, 64); om |= __shfl_xor(om, 4, 64);
            tmask = om;
        } else tmask = 0x1ffull;
        asm volatile("" : "+v"(Qf[0]), "+v"(Qf[1]), "+v"(Qf[2]), "+v"(Qf[3]), "+v"(b31), "+v"(selmask) :: "memory");
        auto rowptr = [&](int j, int jj) -> const float* {
            const int r = 64 * j + srow + 16 * jj;
            if (BR == 0) {
                if (r < 2048) {
                    const int page = pgs[j >> 1];
                    return p.cache_slc + (((size_t)page * 128 + (r & 127)) * 4 + g) * 128;
                }
                if (r < 2056) return p.out + O_SLC_S + ((size_t)s * 8 + (r - 2048)) * 512 + g * 128;
                return nullptr;
            } else {
                if (r < 512) return p.cache_win + (((size_t)s * 512 + r) * 4 + g) * 128;
                if (r < 520) return p.out + O_WIN_S + ((size_t)s * 512 + 504 + (r - 512)) * 512 + g * 128;
                return nullptr;
            }
        };
        f32x4 O[4];
#pragma unroll
        for (int c = 0; c < 4; ++c) O[c] = (f32x4){0.f, 0.f, 0.f, 0.f};
        float mrun = -INFINITY, lrun = 0.f;
        f32x4 kx[2][4], vx[2][4];
        int jt[2];
        unsigned rowok[2];
#define GLD_NT(dst, ptr) asm volatile("global_load_dwordx4 %0, %1, off nt" : "=v"(dst) : "v"(ptr) : "memory")
#define LOAD_ROWS(j, par) do { rowok[par] = 0u; _Pragma("unroll") for (int jj_ = 0; jj_ < 4; ++jj_) { const float* rp_ = rowptr(j, jj_); \
            if (rp_) rowok[par] |= 1u << jj_; else rp_ = p.cache_win; \
            GLD_NT(kx[par][jj_], rp_ + spc * 4); GLD_NT(vx[par][jj_], rp_ + 256 + spc * 4); } } while (0)
#pragma unroll
        for (int par = 0; par < 2; ++par) {
            jt[par] = __builtin_amdgcn_readfirstlane(tmask ? (int)__builtin_ctzll(tmask) : -1);
            tmask &= tmask - 1;
            rowok[par] = 0u;
            if (jt[par] >= 0) LOAD_ROWS(jt[par], par);
            else {
#pragma unroll
                for (int jj_ = 0; jj_ < 4; ++jj_) { kx[par][jj_] = (f32x4){0.f, 0.f, 0.f, 0.f}; vx[par][jj_] = (f32x4){0.f, 0.f, 0.f, 0.f}; }
            }
        }
        __syncthreads();
        bool more = true;
        while (more) {
#pragma unroll
          for (int par = 0; par < 2; ++par) {
            const int j = jt[par];
            if (j < 0) { more = false; break; }
            unsigned char* Kb = smem + par * 32768;
            unsigned char* Vb = Kb + 16384;
            if (jt[par ^ 1] >= 0) asm volatile("s_waitcnt vmcnt(8)" ::: "memory"); else asm volatile("s_waitcnt vmcnt(0)" ::: "memory");
            asm volatile("" : "+v"(kx[par][0]), "+v"(kx[par][1]), "+v"(kx[par][2]), "+v"(kx[par][3]), "+v"(vx[par][0]), "+v"(vx[par][1]), "+v"(vx[par][2]), "+v"(vx[par][3]) :: "memory");
            {
                const unsigned kof = ((((unsigned)spc >> 1) ^ ksw) << 4) + 8u * ((unsigned)spc & 1u);
                const unsigned vof = ((((unsigned)spc >> 1) ^ vsw) << 4) + 8u * ((unsigned)spc & 1u);
#pragma unroll
                for (int jj_ = 0; jj_ < 4; ++jj_) {
                    const bool ok = (rowok[par] >> jj_) & 1u;
                    const uint2 kw = ok ? make_uint2(pk2(kx[par][jj_][0], kx[par][jj_][1]), pk2(kx[par][jj_][2], kx[par][jj_][3])) : make_uint2(0u, 0u);
                    const uint2 vw = ok ? make_uint2(pk2(vx[par][jj_][0], vx[par][jj_][1]), pk2(vx[par][jj_][2], vx[par][jj_][3])) : make_uint2(0u, 0u);
                    *(uint2*)(Kb + (srow + 16 * jj_) * 256 + kof) = kw;
                    *(uint2*)(Vb + (srow + 16 * jj_) * 256 + vof) = vw;
                }
            }
            __syncthreads();
            jt[par] = __builtin_amdgcn_readfirstlane(tmask ? (int)__builtin_ctzll(tmask) : -1);
            tmask &= tmask - 1;
            if (jt[par] >= 0) LOAD_ROWS(jt[par], par);
            const int kbase = j * 64 + 32 * kh;
            f32x4 S[2];
#pragma unroll
            for (int nt = 0; nt < 2; ++nt) {
                const int r = 32 * kh + 16 * nt + fr;
                S[nt] = (f32x4){0.f, 0.f, 0.f, 0.f};
#pragma unroll
                for (int sx = 0; sx < 4; ++sx) {
                    const bf16x8 Kf = *(const bf16x8*)(Kb + r * 256 + (((unsigned)(4 * sx + fq) ^ (unsigned)(r & 15)) << 4));
                    S[nt] = __builtin_amdgcn_mfma_f32_16x16x32_bf16(Kf, Qf[sx], S[nt], 0, 0, 0);
                }
            }
            const int q0 = (BR == 0) ? 2048 : 512;
            const bool far = (q0 - (j * 64 + 63)) >= 113;
            const bool selok = (BR == 0) ? (((selmask >> j) & 1ull) != 0ull) : true;
            float tmax = -INFINITY;
#pragma unroll
            for (int nt = 0; nt < 2; ++nt)
#pragma unroll
                for (int i = 0; i < 4; ++i) {
                    const int dist = tq - (kbase + 16 * nt + 4 * fq + i);
                    bool valid = selok && dist >= 0;
                    if (BR == 1) valid = valid && dist <= 512;
                    const float bias = far ? b31 : bt[hl * 128 + (dist < 0 ? 0 : (dist > 127 ? 127 : dist))];
                    const float sv = valid ? S[nt][i] + bias : -INFINITY;
                    S[nt][i] = sv;
                    tmax = fmaxf(tmax, sv);
                }
            tmax = fmaxf(tmax, __shfl_xor(tmax, 16, 64));
            tmax = fmaxf(tmax, __shfl_xor(tmax, 32, 64));
            const float mnew = fmaxf(mrun, tmax);
            const bool dead = (mnew == -INFINITY);
            const float scale = (mrun == -INFINITY) ? 0.f : __expf(mrun - mnew);
            float psum = 0.f;
#pragma unroll
            for (int nt = 0; nt < 2; ++nt)
#pragma unroll
                for (int i = 0; i < 4; ++i) {
                    const float pv = dead ? 0.f : __expf(S[nt][i] - mnew);
                    S[nt][i] = pv;
                    psum += pv;
                }
            lrun = lrun * scale + psum;
            mrun = mnew;
#pragma unroll
            for (int c = 0; c < 4; ++c) { O[c][0] *= scale; O[c][1] *= scale; O[c][2] *= scale; O[c][3] *= scale; }
            bf16x8 Pf;
            {
                union { unsigned u[4]; bf16x8 v; } cv;
                cv.u[0] = pk2(S[0][0], S[0][1]); cv.u[1] = pk2(S[0][2], S[0][3]);
                cv.u[2] = pk2(S[1][0], S[1][1]); cv.u[3] = pk2(S[1][2], S[1][3]);
                Pf = cv.v;
            }
#pragma unroll
            for (int c = 0; c < 4; ++c) {
                const int r0 = 32 * kh + 4 * fq + (fr >> 2), r1 = r0 + 16;
                const unsigned ch = (unsigned)(2 * (4 * dh + c) + ((fr & 3) >> 1));
                const s16x4 a0 = __builtin_amdgcn_ds_read_tr16_b64_v4i16((__attribute__((address_space(3))) s16x4*)(Vb + r0 * 256 + ((ch ^ fvsw(r0)) << 4) + 8 * (fr & 1)));
                const s16x4 a1 = __builtin_amdgcn_ds_read_tr16_b64_v4i16((__attribute__((address_space(3))) s16x4*)(Vb + r1 * 256 + ((ch ^ fvsw(r1)) << 4) + 8 * (fr & 1)));
                const bf16x8 Vf = {a0[0], a0[1], a0[2], a0[3], a1[0], a1[1], a1[2], a1[3]};
                O[c] = __builtin_amdgcn_mfma_f32_16x16x32_bf16(Vf, Pf, O[c], 0, 0, 0);
            }
          }
        }
#undef LOAD_ROWS
#undef GLD_NT
        float l = lrun + __shfl_xor(lrun, 16, 64);
        l += __shfl_xor(l, 32, 64);
#pragma unroll
        for (int c = 0; c < 4; ++c) *(f32x4*)(mrg + ((wid * 4 + c) * 64 + lane) * 4) = O[c];
        mrg[8192 + (wid * 64 + lane) * 2] = mrun;
        mrg[8192 + (wid * 64 + lane) * 2 + 1] = l;
        __syncthreads();
        if (kh == 0) {
            const int pw = wid + 2;
            const float m1 = mrg[8192 + (pw * 64 + lane) * 2], l1 = mrg[8192 + (pw * 64 + lane) * 2 + 1];
            const float mm = fmaxf(mrun, m1);
            float w0 = 0.f, w1 = 0.f;
            if (mm != -INFINITY) {
                w0 = (mrun == -INFINITY) ? 0.f : __expf(mrun - mm);
                w1 = (m1 == -INFINITY) ? 0.f : __expf(m1 - mm);
            }
            const float lt = l * w0 + l1 * w1;
            const float inv = lt > 0.f ? 1.0f / lt : 0.f;
            bf16_t* Og = (BR == 0) ? p.OS : p.OW;
            bf16_t* op = Og + (size_t)m * 1024 + (g * 4 + hl) * 128 + dh * 64 + 4 * fq;
#pragma unroll
            for (int c = 0; c < 4; ++c) {
                const f32x4 o1 = *(const f32x4*)(mrg + ((pw * 4 + c) * 64 + lane) * 4);
                *(uint2*)(op + 16 * c) = make_uint2(pk2((O[c][0] * w0 + o1[0] * w1) * inv, (O[c][1] * w0 + o1[1] * w1) * inv),
                                                    pk2((O[c][2] * w0 + o1[2] * w1) * inv, (O[c][3] * w0 + o1[3] * w1) * inv));
            }
        }
    }
}


__device__ __forceinline__ void ph_hgrn(const Params& p, int bid, int nb, float* lds, unsigned* qctr = nullptr) {
    const int tid = threadIdx.x, v = tid & 127, kq = tid >> 7;
    float* sq = lds;
    float* sf = lds + 2048;
    float* si = lds + 4096;
    float* so = lds + 6144;
    for (int j = q_next(qctr, -1, bid, nb, (unsigned char*)lds); j < 1024; j = q_next(qctr, j, bid, nb, (unsigned char*)lds)) {
        const int h = j & 7;
        const size_t mbase = (size_t)MP + (size_t)(j >> 3) * 8;
        const float* s0 = p.state + (size_t)j * 16384;
        float* sout = p.out + O_ST_S + (size_t)j * 16384;
        float S[32];
#pragma unroll
        for (int k = 0; k < 32; ++k) S[k] = s0[(size_t)(kq * 32 + k) * 128 + v];
        const float l0 = p.lb_logits[h * 128 + v], l1 = p.lb_logits[1024 + h * 128 + v];
        const float* rowa = p.PF + (mbase + (tid >> 7)) * NPF + h * 128 + v;
        const float* rowb = rowa + (size_t)4 * NPF;
        const float qa = rowa[C_QB], fa = rowa[C_FB], ia = rowa[C_IB], qb = rowb[C_QB], fb = rowb[C_FB], ib = rowb[C_IB];
        __syncthreads();
        {
            const float lb = 1.0f / (1.0f + expf(l1 - l0));
            sq[tid] = qa; sf[tid] = lb + (1.0f - lb) * sigmoidf_(fa); si[tid] = ia;
            sq[tid + NT] = qb; sf[tid + NT] = lb + (1.0f - lb) * sigmoidf_(fb); si[tid + NT] = ib;
        }
        __syncthreads();
#pragma unroll
        for (int tt = 0; tt < 8; ++tt) {
            const float iv = si[tt * 128 + v];
            float o = 0.f;
#pragma unroll
            for (int k = 0; k < 32; ++k) {
                const float f = sf[tt * 128 + kq * 32 + k];
                const float q = sq[tt * 128 + kq * 32 + k];
                S[k] = f * S[k] + (1.0f - f) * iv;
                o += q * S[k];
            }
            so[(tt * 4 + kq) * 128 + v] = o;
        }
        __syncthreads();
#pragma unroll
        for (int r = 0; r < 2; ++r) {
            const int e = tid + r * NT, tt = e >> 7;
            const float* sp = so + tt * 512 + v;
            p.OH[(mbase + tt) * 1024 + h * 128 + v] = (sp[0] + sp[128]) + (sp[256] + sp[384]);
        }
#pragma unroll
        for (int k = 0; k < 32; ++k) sout[(size_t)(kq * 32 + k) * 128 + v] = S[k];
    }
}

template <int CTRL> __device__ __forceinline__ float dpp_f(float x) {
    return __int_as_float(__builtin_amdgcn_update_dpp(0, __float_as_int(x), CTRL, 0xf, 0xf, false));
}
__device__ __forceinline__ float row_prefix16(float x) {
    x += dpp_f<0x111>(x); x += dpp_f<0x112>(x); x += dpp_f<0x114>(x); x += dpp_f<0x118>(x);
    return x;
}
__device__ __forceinline__ float row_suffix16(float x) {
    x += dpp_f<0x101>(x); x += dpp_f<0x102>(x); x += dpp_f<0x104>(x); x += dpp_f<0x108>(x);
    return x;
}
__device__ __forceinline__ float fsig(float x) { return __builtin_amdgcn_rcpf(1.0f + __expf(-x)); }
__device__ __forceinline__ float flog2(float x) { return __builtin_amdgcn_logf(x); }
__device__ __forceinline__ float fexp2(float x) { return __builtin_amdgcn_exp2f(x); }
__device__ __forceinline__ float row_last16(float x) {
    return __int_as_float(__builtin_amdgcn_ds_swizzle(__float_as_int(x), 0x1F0));
}

struct ChainCtx {
    size_t mbase; int h, st, kg, sk4, wid, fr, fq; float4 lb4;
};

__device__ __forceinline__ void chain_step(const Params& p, unsigned char* smem, const ChainCtx& c, const int step,
                                           float4& rq, float4& rfraw, float4& ri, pg8::f32x4 (&Sacc)[8]) {
    typedef pg8::bf16x8 bf16x8;
    typedef pg8::f32x4 f32x4;
    typedef short s16x4 __attribute__((ext_vector_type(4)));
    constexpr int BUF = 17408;
    unsigned char* B = smem + (step & 1) * BUF;
    unsigned char* QD = B;
    unsigned char* KH = B + 4096;
    bf16_t* KET = (bf16_t*)(B + 8192);
    bf16_t* VT = (bf16_t*)(B + 12288);
    float* DEND = (float*)(B + 16384);
    const int st = c.st, kg = c.kg, sk4 = c.sk4, wid = c.wid, fr = c.fr, fq = c.fq;
    {
        const float fx = c.lb4.x + (1.0f - c.lb4.x) * fsig(rfraw.x), fy = c.lb4.y + (1.0f - c.lb4.y) * fsig(rfraw.y);
        const float fz = c.lb4.z + (1.0f - c.lb4.z) * fsig(rfraw.z), fw = c.lb4.w + (1.0f - c.lb4.w) * fsig(rfraw.w);
        const float lx = flog2(fx), ly = flog2(fy), lz = flog2(fz), lw = flog2(fw);
        const float bsx = row_prefix16(lx), bsy = row_prefix16(ly), bsz = row_prefix16(lz), bsw = row_prefix16(lw);
        const float ex = row_last16(bsx) - bsx, ey = row_last16(bsy) - bsy, ez = row_last16(bsz) - bsz, ew = row_last16(bsw) - bsw;
        const float kx = 1.0f - fx, ky = 1.0f - fy, kz = 1.0f - fz, kw = 1.0f - fw;
        const unsigned v01 = pk2(ri.x, ri.y), v23 = pk2(ri.z, ri.w);
        VT[(sk4 + 0) * 16 + st] = (bf16_t)(v01 & 0xffffu); VT[(sk4 + 1) * 16 + st] = (bf16_t)(v01 >> 16);
        VT[(sk4 + 2) * 16 + st] = (bf16_t)(v23 & 0xffffu); VT[(sk4 + 3) * 16 + st] = (bf16_t)(v23 >> 16);
        const float dx = fexp2(bsx), dy = fexp2(bsy), dz = fexp2(bsz), dw = fexp2(bsw);
        const unsigned qd0 = pk2(rq.x * dx, rq.y * dy), qd1 = pk2(rq.z * dz, rq.w * dw);
        const unsigned kh0 = pk2(kx * fexp2(fminf(-bsx, 115.4f)), ky * fexp2(fminf(-bsy, 115.4f)));
        const unsigned kh1 = pk2(kz * fexp2(fminf(-bsz, 115.4f)), kw * fexp2(fminf(-bsw, 115.4f)));
        const unsigned ke0 = pk2(kx * fexp2(ex), ky * fexp2(ey));
        const unsigned ke1 = pk2(kz * fexp2(ez), kw * fexp2(ew));
        const unsigned off = (unsigned)st * 256u + ((((unsigned)kg >> 1) ^ (unsigned)st) << 4) + 8u * ((unsigned)kg & 1u);
        *(uint2*)(QD + off) = make_uint2(qd0, qd1);
        *(uint2*)(KH + off) = make_uint2(kh0, kh1);
        KET[(sk4 + 0) * 16 + st] = (bf16_t)(ke0 & 0xffffu); KET[(sk4 + 1) * 16 + st] = (bf16_t)(ke0 >> 16);
        KET[(sk4 + 2) * 16 + st] = (bf16_t)(ke1 & 0xffffu); KET[(sk4 + 3) * 16 + st] = (bf16_t)(ke1 >> 16);
        if (st == 15) *(float4*)(DEND + sk4) = make_float4(dx, dy, dz, dw);
    }
    __syncthreads();
    if (step + 2 < 128) {
        const float* row = p.PF + (c.mbase + (size_t)(step + 2) * 16 + st) * NPF + c.h * 128 + sk4;
        rq = *(const float4*)(row + C_QB); rfraw = *(const float4*)(row + C_FB); ri = *(const float4*)(row + C_IB);
    }
    const s16x4 vv = *(const s16x4*)(VT + (16 * wid + fr) * 16 + 4 * fq);
    s16x4 Kef[8];
    f32x4 d4[8];
#pragma unroll
    for (int kt = 0; kt < 8; ++kt) {
        Kef[kt] = *(const s16x4*)(KET + (16 * kt + fr) * 16 + 4 * fq);
        d4[kt] = *(const f32x4*)(DEND + 16 * kt + 4 * fq);
    }
    f32x4 oacc = (f32x4){0.f, 0.f, 0.f, 0.f};
#pragma unroll
    for (int ks = 0; ks < 4; ++ks) {
        const unsigned c0 = (unsigned)(4 * ks + (fq >> 1)), c1 = c0 + 2u;
        const s16x4 qa = *(const s16x4*)(QD + fr * 256 + ((c0 ^ (unsigned)fr) << 4) + 8 * (fq & 1));
        const s16x4 qb = *(const s16x4*)(QD + fr * 256 + ((c1 ^ (unsigned)fr) << 4) + 8 * (fq & 1));
        const bf16x8 Qp = {qa[0], qa[1], qa[2], qa[3], qb[0], qb[1], qb[2], qb[3]};
        union { unsigned u[4]; bf16x8 v; } sv;
        sv.u[0] = pk2(Sacc[2 * ks][0], Sacc[2 * ks][1]); sv.u[1] = pk2(Sacc[2 * ks][2], Sacc[2 * ks][3]);
        sv.u[2] = pk2(Sacc[2 * ks + 1][0], Sacc[2 * ks + 1][1]); sv.u[3] = pk2(Sacc[2 * ks + 1][2], Sacc[2 * ks + 1][3]);
        oacc = __builtin_amdgcn_mfma_f32_16x16x32_bf16(Qp, sv.v, oacc, 0, 0, 0);
    }
    f32x4 A = (f32x4){0.f, 0.f, 0.f, 0.f};
#pragma unroll
    for (int ks = 0; ks < 4; ++ks) {
        const unsigned o16 = (unsigned)fr * 256u + ((((unsigned)(4 * ks + fq)) ^ (unsigned)fr) << 4);
        const bf16x8 Khf = *(const bf16x8*)(KH + o16);
        const bf16x8 Qdf = *(const bf16x8*)(QD + o16);
        A = __builtin_amdgcn_mfma_f32_16x16x32_bf16(Khf, Qdf, A, 0, 0, 0);
    }
    {
        union { unsigned u[2]; s16x4 v; } av;
        av.u[0] = pk2((4 * fq + 0 <= fr) ? A[0] : 0.f, (4 * fq + 1 <= fr) ? A[1] : 0.f);
        av.u[1] = pk2((4 * fq + 2 <= fr) ? A[2] : 0.f, (4 * fq + 3 <= fr) ? A[3] : 0.f);
        oacc = __builtin_amdgcn_mfma_f32_16x16x16bf16_1k(av.v, vv, oacc, 0, 0, 0);
    }
    {
        float* op = p.OH + (c.mbase + (size_t)step * 16 + 4 * fq) * 1024 + c.h * 128 + 16 * wid + fr;
        op[0] = oacc[0]; op[1024] = oacc[1]; op[2048] = oacc[2]; op[3072] = oacc[3];
    }
#pragma unroll
    for (int kt = 0; kt < 8; ++kt) {
        Sacc[kt] = Sacc[kt] * d4[kt];
        Sacc[kt] = __builtin_amdgcn_mfma_f32_16x16x16bf16_1k(Kef[kt], vv, Sacc[kt], 0, 0, 0);
    }
}

__device__ __forceinline__ void ph_hgrn_chain(const Params& p, int item, unsigned char* smem) {
    typedef pg8::f32x4 f32x4;
    const int tid = threadIdx.x, lane = tid & 63;
    ChainCtx c;
    c.wid = tid >> 6; c.fr = lane & 15; c.fq = lane >> 4;
    const int n = item >> 3;
    c.h = item & 7;
    c.mbase = (size_t)n * 2048;
    c.st = tid & 15; c.kg = tid >> 4; c.sk4 = c.kg * 4;
    {
        const float4 l0 = *(const float4*)&p.lb_logits[c.h * 128 + c.sk4], l1 = *(const float4*)&p.lb_logits[1024 + c.h * 128 + c.sk4];
        c.lb4 = make_float4(1.0f / (1.0f + expf(l1.x - l0.x)), 1.0f / (1.0f + expf(l1.y - l0.y)), 1.0f / (1.0f + expf(l1.z - l0.z)), 1.0f / (1.0f + expf(l1.w - l0.w)));
    }
    f32x4 Sacc[8];
#pragma unroll
    for (int kt = 0; kt < 8; ++kt) Sacc[kt] = (f32x4){0.f, 0.f, 0.f, 0.f};
    float4 q0, f0, i0, q1, f1, i1;
    {
        const float* row = p.PF + (c.mbase + c.st) * NPF + c.h * 128 + c.sk4;
        q0 = *(const float4*)(row + C_QB); f0 = *(const float4*)(row + C_FB); i0 = *(const float4*)(row + C_IB);
        row += (size_t)16 * NPF;
        q1 = *(const float4*)(row + C_QB); f1 = *(const float4*)(row + C_FB); i1 = *(const float4*)(row + C_IB);
    }
    __syncthreads();
    for (int s2 = 0; s2 < 128; s2 += 2) {
        chain_step(p, smem, c, s2, q0, f0, i0, Sacc);
        chain_step(p, smem, c, s2 + 1, q1, f1, i1, Sacc);
    }
    float* so = p.out + O_ST_P + (size_t)item * 16384;
#pragma unroll
    for (int kt = 0; kt < 8; ++kt)
#pragma unroll
        for (int i = 0; i < 4; ++i) so[(size_t)(16 * kt + 4 * c.fq + i) * 128 + 16 * c.wid + c.fr] = Sacc[kt][i];
    __syncthreads();
}

__device__ __forceinline__ void ph_combine(const Params& p, int bid, int nb, int m_begin, int m_end) {
    const int lane = threadIdx.x & 63, wave = threadIdx.x >> 6;
    const int gw = bid * 8 + wave, ngw = nb * 8;
    const int c0 = lane * 16, hd = lane >> 3;
    float4 gov[4];
#pragma unroll
    for (int j = 0; j < 4; ++j) gov[j] = *(const float4*)&p.g_o[(c0 & 127) + 4 * j];
    for (int m = m_begin + gw; m < m_end; m += ngw) {
        const bf16_t* row = p.PH + (size_t)m * LDH;
        float4 oc[4], os[4], ow[4], oh[4], za[4], zb[4];
#pragma unroll
        for (int j = 0; j < 4; ++j) {
            const uint2 c2 = *(const uint2*)&p.OC[(size_t)m * 1024 + c0 + 4 * j], s2 = *(const uint2*)&p.OS[(size_t)m * 1024 + c0 + 4 * j];
            const uint2 w2 = *(const uint2*)&p.OW[(size_t)m * 1024 + c0 + 4 * j];
            oc[j] = make_float4(__uint_as_float(c2.x << 16), __uint_as_float(c2.x & 0xffff0000u), __uint_as_float(c2.y << 16), __uint_as_float(c2.y & 0xffff0000u));
            os[j] = make_float4(__uint_as_float(s2.x << 16), __uint_as_float(s2.x & 0xffff0000u), __uint_as_float(s2.y << 16), __uint_as_float(s2.y & 0xffff0000u));
            ow[j] = make_float4(__uint_as_float(w2.x << 16), __uint_as_float(w2.x & 0xffff0000u), __uint_as_float(w2.y << 16), __uint_as_float(w2.y & 0xffff0000u));
            oh[j] = *(const float4*)&p.OH[(size_t)m * 1024 + c0 + 4 * j];
            za[j] = bf4(*(const uint2*)&row[C_ZA + c0 + 4 * j]);
            zb[j] = bf4(*(const uint2*)&row[C_ZB + c0 + 4 * j]);
        }
        const float gc = p.GATE[(size_t)m * 24 + hd], gs = p.GATE[(size_t)m * 24 + 8 + hd], gw_ = p.GATE[(size_t)m * 24 + 16 + hd];
        float ss = 0.f;
#pragma unroll
        for (int j = 0; j < 4; ++j) ss += oh[j].x * oh[j].x + oh[j].y * oh[j].y + oh[j].z * oh[j].z + oh[j].w * oh[j].w;
        ss += __shfl_xor(ss, 1, 64); ss += __shfl_xor(ss, 2, 64); ss += __shfl_xor(ss, 4, 64);
        const float rr = rsqrtf(ss * (1.0f / 128) + EPS);
        uint2 a[4], bq[4];
#pragma unroll
        for (int j = 0; j < 4; ++j) {
            const float4 go = gov[j];
            a[j].x = pk2((gc * oc[j].x + gs * os[j].x + gw_ * ow[j].x) * siluf_(za[j].x), (gc * oc[j].y + gs * os[j].y + gw_ * ow[j].y) * siluf_(za[j].y));
            a[j].y = pk2((gc * oc[j].z + gs * os[j].z + gw_ * ow[j].z) * siluf_(za[j].z), (gc * oc[j].w + gs * os[j].w + gw_ * ow[j].w) * siluf_(za[j].w));
            bq[j].x = pk2(oh[j].x * rr * go.x * siluf_(zb[j].x), oh[j].y * rr * go.y * siluf_(zb[j].y));
            bq[j].y = pk2(oh[j].z * rr * go.z * siluf_(zb[j].z), oh[j].w * rr * go.w * siluf_(zb[j].w));
        }
        uint4* oa = (uint4*)&p.MIXb[(size_t)m * 2048 + c0];
        uint4* ob = (uint4*)&p.MIXb[(size_t)m * 2048 + 1024 + c0];
        oa[0] = make_uint4(a[0].x, a[0].y, a[1].x, a[1].y); oa[1] = make_uint4(a[2].x, a[2].y, a[3].x, a[3].y);
        ob[0] = make_uint4(bq[0].x, bq[0].y, bq[1].x, bq[1].y); ob[1] = make_uint4(bq[2].x, bq[2].y, bq[3].x, bq[3].y);
    }
}

__global__ void __launch_bounds__(NT, 2) k_mega(Params p) {
    extern __shared__ __attribute__((aligned(16))) unsigned char smem[];
    float* lds = (float*)smem;
    volatile LAS unsigned* misc = (volatile LAS unsigned*)(smem + LDS_STAGE);
    if (threadIdx.x == 0) { misc[0] = 0u; misc[1] = 0u; }
    __syncthreads();
    XcdBarrier bar = xcd_barrier_post(p.bar, misc);
    const int bid = blockIdx.x, nb = gridDim.x;
#define PH0 { ph_prologue(p, bid, nb, lds); xcd_barrier(bar); }
#define PH1 { if (bid < nb - 32 || nb <= 64) { const int gg = (nb > 64) ? nb - 32 : nb; \
                pg8::Gemm g{p.Hb, p.Wt_in, M, LDP, D}; pg8::StaticOrder S; S.init(M, LDP, gg, bid); pg8::EpiMix E{p.PF, p.PH, LDH}; \
                pg8::gemm_phase<pg8::EpiMix, pg8::StaticOrder>((PG8_LAS unsigned char*)smem, g, S, E); \
                if (threadIdx.x == 0) (void)__hip_atomic_fetch_add(&p.ctr[64], 1u, __ATOMIC_RELAXED, __HIP_MEMORY_SCOPE_AGENT); } \
              else { ph_cmp_mfma(p, 512, true, smem, P1_MAXU); } \
              xcd_barrier(bar); }
#define PH2 { ph_post(p, bid, nb); xcd_barrier(bar); }
#define PH3 { if (bid < 32 && nb > 64) { ph_hgrn_chain(p, bid, smem); } \
              else if (nb <= 64) { for (int it = bid; it < 32; it += nb) ph_hgrn_chain(p, it, smem); } \
                \
              ph_cmp_mfma(p, NSEQ * 4, false, smem); __syncthreads(); \
              ph_attn_prompt<1>(p, bid, nb, smem, p.ctr + 1); __syncthreads(); \
              ph_attn_sample<1>(p, bid, nb, smem, p.ctr + 2); __syncthreads(); \
              ph_hgrn(p, bid, nb, lds, p.ctr + 3); \
              xcd_barrier(bar); }
#define PH5 { ph_cmp_attn_mfma(p, bid, nb, smem); xcd_barrier(bar); }
#define PH6 {   \
              if (bid & 1) { ph_attn_prompt<0>(p, bid, nb, smem); __syncthreads(); ph_attn_sample<0>(p, bid, nb, smem); } \
              else { ph_attn_sample<0>(p, bid, nb, smem); __syncthreads(); ph_attn_prompt<0>(p, bid, nb, smem); } \
              xcd_barrier(bar); }
#define PH7A { ph_combine(p, bid, nb, MP, M); xcd_barrier(bar); }
#define PH7B { if (bid < 32 && nb > 64) {   \
                 pg8::Gemm g{p.MIXb + (size_t)MP * 2048, p.Wt_out, MS, D, 2048}; pg8::StaticOrder S; S.init(MS, D, 32, bid); \
                 pg8::EpiResF32S E{p.out + O_YS, p.x_sample}; \
                 pg8::gemm_phase<pg8::EpiResF32S, pg8::StaticOrder>((PG8_LAS unsigned char*)smem, g, S, E); } \
               else { const int rb = (nb > 64) ? bid - 32 : bid, rnb = (nb > 64) ? nb - 32 : nb; \
                 ph_combine(p, rb, rnb, 0, MP); } \
               __syncthreads(); ph_wincopy(p, bid, nb, smem, p.ctr + 4);   \
               xcd_barrier(bar); }
#define PH8 { if (nb > 64) { pg8::Gemm g{p.MIXb, p.Wt_out, MP, D, 2048}; pg8::StaticOrder S; S.init(MP, D, nb, bid); pg8::EpiResF32 E{p.out, p.x_prompt, p.x_sample}; \
                pg8::gemm_phase<pg8::EpiResF32, pg8::StaticOrder>((PG8_LAS unsigned char*)smem, g, S, E); } \
              else { pg8::Gemm g{p.MIXb, p.Wt_out, M, D, 2048}; pg8::StaticOrder S; S.init(M, D, nb, bid); pg8::EpiResF32 E{p.out, p.x_prompt, p.x_sample}; \
                pg8::gemm_phase<pg8::EpiResF32, pg8::StaticOrder>((PG8_LAS unsigned char*)smem, g, S, E); } }
    PH0
#if (PROBE_MASK >> 0) & 1
    PH0
#endif
    PH1
#if (PROBE_MASK >> 1) & 1
    PH1
#endif
    PH2
#if (PROBE_MASK >> 2) & 1
    PH2
#endif
    PH3
#if (PROBE_MASK >> 3) & 1
    PH3
#endif
    PH5
#if (PROBE_MASK >> 5) & 1
    PH5
#endif
    PH6
#if (PROBE_MASK >> 6) & 1
    PH6
#endif
    PH7A
    PH7B
#if (PROBE_MASK >> 8) & 1
    PH8
    xcd_barrier(bar);
#endif
    PH8
}

}

extern "C" void kernel_launch(void* const* d_in, const int* in_sizes, int n_in, void* d_out,
                              int out_size, void* d_ws, size_t ws_size, hipStream_t stream) {
    (void)in_sizes; (void)n_in; (void)out_size; (void)ws_size;
    Params p{};
    p.x_prompt = (const float*)d_in[0];
    p.x_sample = (const float*)d_in[1];
    p.cache_cmp = (const float*)d_in[2];
    p.cache_slc = (const float*)d_in[3];
    p.cache_win = (const float*)d_in[4];
    p.state = (const float*)d_in[5];
    p.page_table = (const int*)d_in[6];
    p.g_norm = (const float*)d_in[7];
    p.w_in = (const float*)d_in[8];
    p.w_out = (const float*)d_in[9];
    p.g_q = (const float*)d_in[10];
    p.g_k_slc = (const float*)d_in[11];
    p.g_k_win = (const float*)d_in[12];
    p.g_k_cmp = (const float*)d_in[13];
    p.w_cmp_k = (const float*)d_in[14];
    p.w_cmp_v = (const float*)d_in[15];
    p.pe_k = (const float*)d_in[16];
    p.pe_v = (const float*)d_in[17];
    p.rel_bias = (const float*)d_in[18];
    p.lb_logits = (const float*)d_in[19];
    p.g_o = (const float*)d_in[20];
    p.out = (float*)d_out;
    float* ws = (float*)d_ws;
    size_t off = 0;
    auto take = [&](size_t nfloats) { float* r = ws + off; off += (nfloats + 63) & ~(size_t)63; return r; };
    p.bar = (unsigned*)take(XCD_BAR_WORDS + 128);
    p.ctr = p.bar + XCD_BAR_WORDS;
    p.Hb = (bf16_t*)take((size_t)M * D / 2);
    p.Wt_in = (bf16_t*)take((size_t)LDP * D / 2);
    p.Wt_out = (bf16_t*)take((size_t)D * 2048 / 2);
    p.MIXb = (bf16_t*)take((size_t)M * 2048 / 2);
    p.Wc_t = (bf16_t*)take((size_t)2 * 256 * 2048 / 2);
    p.PEB = take(64 * 128);
    p.Qb = (bf16_t*)take((size_t)M * 1024 / 2);
    p.KVb = (bf16_t*)take((size_t)2 * 2 * 4 * 2 * 2048 * 128 / 2);
    p.PF = take((size_t)M * NPF);
    p.PH = (bf16_t*)take((size_t)M * LDH / 2);
    p.KCb = (bf16_t*)take((size_t)NSEQ * 2 * 128 * 128 / 2);
    p.VCb = (bf16_t*)take((size_t)NSEQ * 2 * 128 * 128 / 2);
    p.OC = (bf16_t*)take((size_t)M * 1024 / 2);
    p.OS = (bf16_t*)take((size_t)M * 1024 / 2);
    p.OW = (bf16_t*)take((size_t)M * 1024 / 2);
    p.OH = take((size_t)M * 1024);
    p.GATE = take((size_t)M * 24);
    p.SEL = (unsigned long long*)take((size_t)M * 2 * 2);

    static int grid = 0;
    if (!grid) {
        int dev = 0, cus = 0;
        (void)hipGetDevice(&dev);
        (void)hipDeviceGetAttribute(&cus, hipDeviceAttributeMultiprocessorCount, dev);
        (void)hipFuncSetAttribute((const void*)k_mega, hipFuncAttributeMaxDynamicSharedMemorySize, LDS_BYTES);
        grid = cus > 0 ? cus : 256;
    }
    (void)hipMemsetAsync(p.bar, 0, (XCD_BAR_WORDS + 128) * sizeof(unsigned), stream);
    hipLaunchKernelGGL(k_mega, dim3(grid), dim3(NT), LDS_BYTES, stream, p);
}
```

```cpp
#include <hip/hip_runtime.h>
#include <stdint.h>
#include <stdio.h>

#define XB_TMO      128
#define XB_XCNT(j)  (256  + 64 * (j))
#define XB_XSUB(j)  (1280 + 64 * (j))
#define XB_XGEN(j)  (2304 + 64 * (j))
#define XB_TOP      3328
#define XB_TOPGEN   3392
#define XCD_BAR_WORDS 3456
#define XB_SPIN_CAP (1u << 18)
#define LAS __attribute__((address_space(3)))

__device__ __forceinline__ unsigned xb_ld(unsigned* p)              { return __hip_atomic_load(p, __ATOMIC_RELAXED, __HIP_MEMORY_SCOPE_AGENT); }
__device__ __forceinline__ unsigned xb_add(unsigned* p, unsigned v) { return __hip_atomic_fetch_add(p, v, __ATOMIC_RELAXED, __HIP_MEMORY_SCOPE_AGENT); }
__device__ __forceinline__ unsigned xb_xcc_id() { return (unsigned)__builtin_amdgcn_s_getreg((3 << 11) | 20) & 0xFu; }
#define XB_SPIN(cond, bar) do { unsigned _sp = 0; while (cond) { __builtin_amdgcn_s_sleep(1); \
    if ((++_sp & 255u) == 0u) { if (xb_ld(&(bar)[XB_TMO])) break; if (_sp > XB_SPIN_CAP) { atomicAdd(&(bar)[XB_TMO], 1u); break; } } } } while (0)

struct XcdBarrier {
    unsigned* bar; unsigned x;
    volatile LAS unsigned* st;
};

__device__ __forceinline__ XcdBarrier xcd_barrier_post(unsigned* bar, volatile LAS unsigned* st) {
    XcdBarrier b; b.bar = bar; b.x = xb_xcc_id(); b.st = st;
    if (threadIdx.x == 0) (void)xb_add(&bar[XB_XCNT(b.x)], 1u);
    return b;
}
__device__ __forceinline__ void xcd_barrier_complete(unsigned* bar, unsigned x, unsigned& nloc, unsigned& nx) {
    const unsigned G = gridDim.x * gridDim.y * gridDim.z;
    unsigned sum, cnt, mine, sp = 0u;
    for (;;) {
        sum = 0u; cnt = 0u; mine = 0u;
#pragma unroll
        for (unsigned j = 0; j < 16; ++j) { const unsigned c = xb_ld(&bar[XB_XCNT(j)]); sum += c; cnt += (c > 0u) ? 1u : 0u; mine = (j == x) ? c : mine; }
        if (sum == G) break;
        __builtin_amdgcn_s_sleep(1);
        if ((++sp & 255u) == 0u) { if (xb_ld(&bar[XB_TMO])) break; if (sp > XB_SPIN_CAP) { atomicAdd(&bar[XB_TMO], 1u); break; } }
    }
    nloc = mine > 0u ? mine : 1u; nx = cnt > 0u ? cnt : 1u;
}
__device__ __forceinline__ void xcd_barrier(const XcdBarrier& b) {
    asm volatile("s_waitcnt vmcnt(0)" ::: "memory");
    __syncthreads();
    if (threadIdx.x == 0) {
        unsigned* bar = b.bar;
        __builtin_amdgcn_s_waitcnt(0);
        unsigned nloc = b.st[0], nx = b.st[1];
        if (nloc == 0u) { xcd_barrier_complete(bar, b.x, nloc, nx); b.st[0] = nloc; b.st[1] = nx; }
        const unsigned old = xb_add(&bar[XB_XSUB(b.x)], 1u);
        const unsigned gen = old / nloc;
        if (old + 1u == (gen + 1u) * nloc) {
            __builtin_amdgcn_fence(__ATOMIC_RELEASE, "agent");
            asm volatile("s_waitcnt vmcnt(0)" ::: "memory");
            const unsigned og = xb_add(&bar[XB_TOP], 1u);
            const unsigned tg = og / nx;
            if (og + 1u == (tg + 1u) * nx) xb_add(&bar[XB_TOPGEN], 1u);
            else XB_SPIN(xb_ld(&bar[XB_TOPGEN]) == tg, bar);
            __builtin_amdgcn_fence(__ATOMIC_ACQUIRE, "agent");
            xb_add(&bar[XB_XGEN(b.x)], 1u);
            asm volatile("s_waitcnt vmcnt(0)" ::: "memory");
        } else {
            XB_SPIN(xb_ld(&bar[XB_XGEN(b.x)]) == gen, bar);
            __builtin_amdgcn_fence(__ATOMIC_ACQUIRE, "agent");
            asm volatile("s_waitcnt vmcnt(0)" ::: "memory");
        }
    }
    __syncthreads();
}


namespace pg8 {
#define PG8_LAS __attribute__((address_space(3)))
typedef unsigned short bf16_t;
typedef short bf16x8 __attribute__((ext_vector_type(8)));
typedef float f32x4 __attribute__((ext_vector_type(4)));
typedef unsigned u32x4 __attribute__((ext_vector_type(4)));
constexpr int BM = 256, BK = 64, HALF = 128, HTB = HALF * BK * 2, STAGE_BYTES = 8 * HTB, NXCD = 8, WGM = 8;

__host__ __device__ __forceinline__ int lds_byte(int r, int c) { const int st = (r >> 4) * 2 + (c >> 5), rr = r & 15, cc = c & 31, ob = rr * 64 + cc * 2; return st * 1024 + (ob ^ (((ob >> 9) & 1) << 5)); }
__host__ __device__ __forceinline__ void stage_rc(int b, int& R, int& C) { const int st = b / 1024, sb = b % 1024, swz = sb ^ (((sb >> 9) & 1) << 5); R = (st >> 1) * 16 + swz / 64; C = (st & 1) * 32 + (swz % 64) / 2; }
__host__ __device__ __forceinline__ int perm32(int rho) { const int n = rho >> 4, i = rho & 15; return 8 * (i >> 2) + 4 * n + (i & 3); }

struct Unit { int pm, pn; };
struct Gemm { const bf16_t* A; const bf16_t* Bt; int M, N, K; };

struct StaticOrder {
    int nM, nN, nwg, G, c;
    __host__ __device__ void init(int M, int N, int G_, int c_) { nM = M / BM; nN = N / BM; nwg = nM * nN; G = G_; c = c_; }
    __host__ __device__ bool next(int i, Unit& u) const {
        const long L = (long)i * G + c; if (L >= nwg) return false;
        int wgid = (int)L; { const int q = nwg / NXCD, r = nwg % NXCD, xcd = wgid % NXCD, off = wgid / NXCD; wgid = (xcd < r ? xcd * (q + 1) : r * (q + 1) + (xcd - r) * q) + off; }
        const int nig = WGM * nN, gid = wgid / nig, fm = gid * WGM, gsz = (nM - fm) < WGM ? (nM - fm) : WGM;
        u.pm = fm + ((wgid % nig) % gsz); u.pn = (wgid % nig) / gsz; return true;
    }
    __device__ __forceinline__ void a_ready(const Unit&) const {}
    __device__ __forceinline__ void done(const Unit&) const {}
};

__device__ __forceinline__ unsigned cvt_pk_bf16(float lo, float hi) { unsigned r; asm volatile("v_cvt_pk_bf16_f32 %0, %1, %2" : "=v"(r) : "v"(lo), "v"(hi)); return r; }

struct EpiF32 {
    static constexpr bool PERM = false, AFTER_DRAIN = false;
    float* C; int ldc;
    __device__ __forceinline__ void operator()(const f32x4 (&acc)[2][2][4][2], const Unit& u, int wr, int wc, int fr, int fq) const {
        const int row0 = u.pm * BM + wr * 64 + fr, col0 = u.pn * BM + wc * 32 + 4 * fq;
#pragma unroll
        for (int ai = 0; ai < 2; ++ai)
#pragma unroll
            for (int m = 0; m < 4; ++m) { float* rowp = C + (size_t)(row0 + ai * HALF + m * 16) * ldc + col0;
#pragma unroll
                for (int bj = 0; bj < 2; ++bj)
#pragma unroll
                    for (int n = 0; n < 2; ++n) *(f32x4*)(rowp + bj * HALF + n * 16) = acc[ai][bj][m][n]; }
    }
};
struct EpiMix {
    static constexpr bool PERM = true, AFTER_DRAIN = false;
    float* F; bf16_t* H; int ldh;
    __device__ __forceinline__ void operator()(const f32x4 (&acc)[2][2][4][2], const Unit& u, int wr, int wc, int fr, int fq) const {
        const int row0 = u.pm * BM + wr * 64 + fr;
        if (u.pn < 12) {
            const int col0 = u.pn * BM + wc * 32 + 8 * fq;
#pragma unroll
            for (int ai = 0; ai < 2; ++ai)
#pragma unroll
                for (int m = 0; m < 4; ++m) { float* rowp = F + (size_t)(row0 + ai * HALF + m * 16) * 3072 + col0;
#pragma unroll
                    for (int bj = 0; bj < 2; ++bj) { *(f32x4*)(rowp + bj * HALF) = acc[ai][bj][m][0]; *(f32x4*)(rowp + bj * HALF + 4) = acc[ai][bj][m][1]; } }
        } else {
            const int col0 = (u.pn - 12) * BM + wc * 32 + 8 * fq;
#pragma unroll
            for (int ai = 0; ai < 2; ++ai)
#pragma unroll
                for (int m = 0; m < 4; ++m) { bf16_t* rowp = H + (size_t)(row0 + ai * HALF + m * 16) * ldh + col0;
#pragma unroll
                    for (int bj = 0; bj < 2; ++bj) { const f32x4 v0 = acc[ai][bj][m][0], v1 = acc[ai][bj][m][1];
                        u32x4 w; w.x = cvt_pk_bf16(v0[0], v0[1]); w.y = cvt_pk_bf16(v0[2], v0[3]); w.z = cvt_pk_bf16(v1[0], v1[1]); w.w = cvt_pk_bf16(v1[2], v1[3]);
                        *(u32x4*)(rowp + bj * HALF) = w; } }
        }
    }
};
#define PG8_RES_LD(q, dst, XROW) { const int ai_ = (q) >> 2, m_ = (q) & 3; const int r_ = row0 + ai_ * HALF + m_ * 16; const float* xr_ = (XROW) + col0; \
        dst[0] = *(const f32x4*)(xr_); dst[1] = *(const f32x4*)(xr_ + 16); dst[2] = *(const f32x4*)(xr_ + HALF); dst[3] = *(const f32x4*)(xr_ + HALF + 16); }
#define PG8_RES_ST(q, src) { const int ai_ = (q) >> 2, m_ = (q) & 3; const int r_ = row0 + ai_ * HALF + m_ * 16; float* rowp_ = C + (size_t)r_ * 2048 + col0; \
        *(f32x4*)(rowp_) = acc[ai_][0][m_][0] + src[0]; *(f32x4*)(rowp_ + 16) = acc[ai_][0][m_][1] + src[1]; \
        *(f32x4*)(rowp_ + HALF) = acc[ai_][1][m_][0] + src[2]; *(f32x4*)(rowp_ + HALF + 16) = acc[ai_][1][m_][1] + src[3]; }
#define PG8_RES_BODY(XROWF) \
        f32x4 xa0[4], xa1[4], xb0[4], xb1[4]; \
        PG8_RES_LD(0, xa0, XROWF(r_)) PG8_RES_LD(1, xa1, XROWF(r_)) PG8_RES_LD(2, xb0, XROWF(r_)) PG8_RES_LD(3, xb1, XROWF(r_)) \
        PG8_RES_ST(0, xa0) PG8_RES_ST(1, xa1) \
        PG8_RES_LD(4, xa0, XROWF(r_)) PG8_RES_LD(5, xa1, XROWF(r_)) \
        PG8_RES_ST(2, xb0) PG8_RES_ST(3, xb1) \
        PG8_RES_LD(6, xb0, XROWF(r_)) PG8_RES_LD(7, xb1, XROWF(r_)) \
        PG8_RES_ST(4, xa0) PG8_RES_ST(5, xa1) PG8_RES_ST(6, xb0) PG8_RES_ST(7, xb1)
struct EpiResF32 {
    static constexpr bool PERM = false, AFTER_DRAIN = false;
    float* C; const float* xp; const float* xs;
    __device__ __forceinline__ void operator()(const f32x4 (&acc)[2][2][4][2], const Unit& u, int wr, int wc, int fr, int fq) const {
        const int row0 = u.pm * BM + wr * 64 + fr, col0 = u.pn * BM + wc * 32 + 4 * fq;
#define PG8_XROW_A(r) ((r) < 8192 ? xp + (size_t)(r) * 2048 : xs + (size_t)((r) - 8192) * 2048)
        PG8_RES_BODY(PG8_XROW_A)
#undef PG8_XROW_A
    }
};

struct EpiResF32S {
    static constexpr bool PERM = false, AFTER_DRAIN = false;
    float* C; const float* x;
    __device__ __forceinline__ void operator()(const f32x4 (&acc)[2][2][4][2], const Unit& u, int wr, int wc, int fr, int fq) const {
        const int row0 = u.pm * BM + wr * 64 + fr, col0 = u.pn * BM + wc * 32 + 4 * fq;
#define PG8_XROW_S(r) (x + (size_t)(r) * 2048)
        PG8_RES_BODY(PG8_XROW_S)
#undef PG8_XROW_S
    }
};
#undef PG8_RES_BODY
#undef PG8_RES_ST
#undef PG8_RES_LD

template <class Epi, class Sched>
__device__ __forceinline__ void gemm_phase(PG8_LAS unsigned char* lds, const Gemm g, const Sched& S, const Epi& E) {
    const int tid = threadIdx.x, wid = __builtin_amdgcn_readfirstlane(tid >> 6), lane = tid & 63, wr = wid >> 2, wc = wid & 3, fr = lane & 15, fq = lane >> 4;
    const int K = g.K, nt = K / BK;
    unsigned voffA[2], voffB[2];
#pragma unroll
    for (int i = 0; i < 2; ++i) { int R, C; stage_rc(tid * 16 + i * 8192, R, C); const int Rb = Epi::PERM ? ((R & ~31) + perm32(R & 31)) : R;
        voffA[i] = (unsigned)(R * K + C) * 2u; voffB[i] = (unsigned)(Rb * K + C) * 2u; }
    const size_t kstep = (size_t)(BK * 2);
    const size_t hstep = (size_t)HALF * K * 2;
    const size_t tstep = 2 * hstep;
    const unsigned ldsw = (unsigned)wid * 1024u;
    const int aoff = lds_byte(wr * 64 + fr, fq * 8), boff = lds_byte(wc * 32 + fr, fq * 8);
#define PG8_SA(b, h) (((b) * 2 + (h)) * HTB)
#define PG8_SB(b, h) ((4 + (b) * 2 + (h)) * HTB)
#define PG8_STAGE(bufoff, gbase, voff) do { _Pragma("unroll") for (int _i = 0; _i < 2; ++_i) \
        __builtin_amdgcn_global_load_lds((const unsigned*)((const char*)(gbase) + (voff)[_i]), (PG8_LAS unsigned*)(lds + (bufoff) + ldsw + _i * 8192), 16, 0, 0); } while (0)
#define PG8_LDA(dst, b, h) do { _Pragma("unroll") for (int m = 0; m < 4; ++m) _Pragma("unroll") for (int k = 0; k < 2; ++k) dst[m][k] = *(const PG8_LAS bf16x8*)(lds + PG8_SA(b, h) + aoff + m * 2048 + k * 1024); } while (0)
#define PG8_LDB(dst, b, h) do { _Pragma("unroll") for (int n = 0; n < 2; ++n) _Pragma("unroll") for (int k = 0; k < 2; ++k) dst[n][k] = *(const PG8_LAS bf16x8*)(lds + PG8_SB(b, h) + boff + n * 2048 + k * 1024); } while (0)
#define PG8_MMA(ai, bj, At, Bt) do { __builtin_amdgcn_s_setprio(1); _Pragma("unroll") for (int m = 0; m < 4; ++m) _Pragma("unroll") for (int n = 0; n < 2; ++n) _Pragma("unroll") for (int k = 0; k < 2; ++k) \
        acc[ai][bj][m][n] = __builtin_amdgcn_mfma_f32_16x16x32_bf16(Bt[n][k], At[m][k], acc[ai][bj][m][n], 0, 0, 0); __builtin_amdgcn_s_setprio(0); } while (0)
#define PG8_WAIT_V(n) asm volatile("s_waitcnt vmcnt(" #n ")" ::: "memory")
#define PG8_WAIT_L(n) asm volatile("s_waitcnt lgkmcnt(" #n ")" ::: "memory")
#define PG8_BAR __builtin_amdgcn_s_barrier()
#define PG8_SCHED __builtin_amdgcn_sched_barrier(0)
    Unit cur, nxt; int ui = 0;
    if (!S.next(0, cur)) return;
    f32x4 acc[2][2][4][2];
#pragma unroll
    for (int a = 0; a < 2; ++a)
#pragma unroll
        for (int b = 0; b < 2; ++b)
#pragma unroll
            for (int m = 0; m < 4; ++m)
#pragma unroll
                for (int n = 0; n < 2; ++n) acc[a][b][m][n] = (f32x4){0.f, 0.f, 0.f, 0.f};
    bf16x8 At[4][2], B0[2][2], B1[2][2];
    const char* cA = (const char*)g.A + (size_t)cur.pm * tstep; const char* cB = (const char*)g.Bt + (size_t)cur.pn * tstep;
    S.a_ready(cur);
    PG8_STAGE(PG8_SB(0, 0), cB, voffB); PG8_STAGE(PG8_SA(0, 0), cA, voffA); PG8_STAGE(PG8_SB(0, 1), cB + hstep, voffB); PG8_STAGE(PG8_SA(0, 1), cA + hstep, voffA);
    if (wr == 1) PG8_BAR;
    PG8_WAIT_V(4); PG8_BAR;
    PG8_STAGE(PG8_SB(1, 0), cB + kstep, voffB); PG8_STAGE(PG8_SA(1, 0), cA + kstep, voffA); PG8_STAGE(PG8_SB(1, 1), cB + hstep + kstep, voffB);
    PG8_WAIT_V(6); PG8_BAR;
    for (;;) {
        const bool has_next = S.next(ui + 1, nxt);
        const char* nA = has_next ? (const char*)g.A + (size_t)nxt.pm * tstep : cA; const char* nB = has_next ? (const char*)g.Bt + (size_t)nxt.pn * tstep : cB;
        for (int t = 0; t < nt; t += 2) {
            const bool last = (t == nt - 2);
            const char* a1 = cA + (size_t)(t + 1) * kstep;
            const char* a2 = last ? nA : cA + (size_t)(t + 2) * kstep; const char* b2 = last ? nB : cB + (size_t)(t + 2) * kstep;
            const char* a3 = a2 + kstep; const char* b3 = b2 + kstep;
            if (last && has_next) S.a_ready(nxt);
            PG8_LDB(B0, 0, 0); PG8_SCHED; PG8_LDA(At, 0, 0); PG8_STAGE(PG8_SA(1, 1), a1 + hstep, voffA);
            PG8_WAIT_L(8); PG8_BAR; PG8_WAIT_L(0); PG8_MMA(0, 0, At, B0); PG8_BAR; PG8_SCHED;
            PG8_LDB(B1, 0, 1); PG8_STAGE(PG8_SB(0, 0), b2, voffB);
            PG8_BAR; PG8_WAIT_L(0); PG8_MMA(0, 1, At, B1); PG8_BAR;
            PG8_LDA(At, 0, 1); PG8_STAGE(PG8_SA(0, 0), a2, voffA);
            PG8_BAR; PG8_WAIT_L(0); PG8_MMA(1, 0, At, B0); PG8_BAR; PG8_SCHED;
            PG8_STAGE(PG8_SB(0, 1), b2 + hstep, voffB);
            PG8_WAIT_V(6); PG8_BAR; PG8_MMA(1, 1, At, B1); PG8_BAR;
            PG8_LDB(B0, 1, 0); PG8_SCHED; PG8_LDA(At, 1, 0); PG8_STAGE(PG8_SA(0, 1), a2 + hstep, voffA);
            PG8_WAIT_L(8); PG8_BAR; PG8_WAIT_L(0); PG8_MMA(0, 0, At, B0); PG8_BAR; PG8_SCHED;
            PG8_LDB(B1, 1, 1); PG8_STAGE(PG8_SB(1, 0), b3, voffB);
            PG8_BAR; PG8_WAIT_L(0); PG8_MMA(0, 1, At, B1); PG8_BAR;
            PG8_LDA(At, 1, 1); PG8_STAGE(PG8_SA(1, 0), a3, voffA);
            PG8_BAR; PG8_WAIT_L(0); PG8_MMA(1, 0, At, B0); PG8_BAR; PG8_SCHED;
            PG8_STAGE(PG8_SB(1, 1), b3 + hstep, voffB);
            PG8_WAIT_V(6); PG8_BAR; PG8_MMA(1, 1, At, B1); PG8_BAR;
        }
        E(acc, cur, wr, wc, fr, fq); S.done(cur);
        if (!has_next) break;
#pragma unroll
        for (int a = 0; a < 2; ++a)
#pragma unroll
            for (int b = 0; b < 2; ++b)
#pragma unroll
                for (int m = 0; m < 4; ++m)
#pragma unroll
                    for (int n = 0; n < 2; ++n) acc[a][b][m][n] = (f32x4){0.f, 0.f, 0.f, 0.f};
        cur = nxt; cA = nA; cB = nB; ++ui;
    }
    PG8_WAIT_V(0);
    if (wr == 0) PG8_BAR;
    PG8_BAR;
#undef PG8_SA
#undef PG8_SB
#undef PG8_STAGE
#undef PG8_LDA
#undef PG8_LDB
#undef PG8_MMA
#undef PG8_WAIT_V
#undef PG8_WAIT_L
#undef PG8_BAR
#undef PG8_SCHED
}
}

#ifndef P1_MAXU
#define P1_MAXU 4
#endif
#ifndef PROBE_MASK
#define PROBE_MASK 0
#endif

namespace {

typedef unsigned short bf16_t;
constexpr int NT = 512;
constexpr int D = 2048;
constexpr int MP = 4 * 2048;
constexpr int MS = 128 * 8;
constexpr int M = MP + MS;
constexpr int NIN = 7704;
constexpr int LDP = 7936;
constexpr int NPF = 3072, LDH = LDP - NPF;
constexpr int C_QB = 0, C_FB = 1024, C_IB = 2048;
constexpr int C_QA = 0, C_KV = 1024, C_GATE = 2560, C_ZA = 2584, C_ZB = 3608;
constexpr int NCMP = 127;
constexpr int NSEQ = 132;
constexpr float EPS = 1e-6f;
constexpr int LDS_STAGE = 139264;
constexpr int LDS_BYTES = LDS_STAGE + 256;

constexpr size_t O_YP = 0;
constexpr size_t O_YS = O_YP + 16777216;
constexpr size_t O_CMP_P = O_YS + 2097152;
constexpr size_t O_SLC_P = O_CMP_P + 4194304;
constexpr size_t O_WIN_P = O_SLC_P + 4194304;
constexpr size_t O_ST_P = O_WIN_P + 1048576;
constexpr size_t O_CMP_S = O_ST_P + 524288;
constexpr size_t O_SLC_S = O_CMP_S + 524288;
constexpr size_t O_WIN_S = O_SLC_S + 524288;
constexpr size_t O_ST_S = O_WIN_S + 33554432;

struct Params {
    const float *x_prompt, *x_sample, *cache_cmp, *cache_slc, *cache_win, *state;
    const int* page_table;
    const float *g_norm, *w_in, *w_out, *g_q, *g_k_slc, *g_k_win, *g_k_cmp, *w_cmp_k, *w_cmp_v,
        *pe_k, *pe_v, *rel_bias, *lb_logits, *g_o;
    float* out;
    bf16_t *Hb, *Wt_in, *Wt_out, *MIXb, *Wc_t, *Qb, *KVb, *KCb, *VCb;
    float* PEB;
    float* PF; bf16_t* PH;
    float* GATE;
    bf16_t *OC, *OS, *OW;
    float* OH;
    unsigned long long* SEL;
    unsigned* bar;
    unsigned* ctr;
};

__device__ __forceinline__ const float* xrow(const Params& p, int m) {
    return m < MP ? p.x_prompt + (size_t)m * D : p.x_sample + (size_t)(m - MP) * D;
}

__device__ __forceinline__ int rel_bucket(int dist) {
    int n = dist < 0 ? 0 : dist;
    if (n < 16) return n;
    int b = 16;
    b += (n >= 19) + (n >= 21) + (n >= 24) + (n >= 27) + (n >= 31) + (n >= 35) + (n >= 40) +
         (n >= 46) + (n >= 52) + (n >= 59) + (n >= 67) + (n >= 77) + (n >= 87) + (n >= 99) +
         (n >= 113);
    return b;
}

__device__ __forceinline__ float wave_sum(float v) {
#pragma unroll
    for (int o = 32; o >= 1; o >>= 1) v += __shfl_xor(v, o, 64);
    return v;
}
__device__ __forceinline__ float wave_max(float v) {
#pragma unroll
    for (int o = 32; o >= 1; o >>= 1) v = fmaxf(v, __shfl_xor(v, o, 64));
    return v;
}
__device__ __forceinline__ float half_sum(float v) {
#pragma unroll
    for (int o = 16; o >= 1; o >>= 1) v += __shfl_xor(v, o, 64);
    return v;
}
__device__ __forceinline__ float sigmoidf_(float x) { return __builtin_amdgcn_rcpf(1.0f + __expf(-x)); }
__device__ __forceinline__ float siluf_(float x) { return x * __builtin_amdgcn_rcpf(1.0f + __expf(-x)); }
__device__ __forceinline__ unsigned pk2(float lo, float hi) { return pg8::cvt_pk_bf16(lo, hi); }
__device__ __forceinline__ float bflo(unsigned u) { return __uint_as_float(u << 16); }
__device__ __forceinline__ float bfhi(unsigned u) { return __uint_as_float(u & 0xffff0000u); }
__device__ __forceinline__ float4 bf4(uint2 u) { return make_float4(bflo(u.x), bfhi(u.x), bflo(u.y), bfhi(u.y)); }

__device__ __forceinline__ void tok_info(int m, int& n, int& qpos) {
    if (m < MP) { n = m >> 11; qpos = m & 2047; }
    else { int j = m - MP; n = 4 + (j >> 3); qpos = 2048 + (j & 7); }
}

__device__ __forceinline__ int q_next(unsigned* qctr, int cur, int bid, int nb, unsigned char* smem) {
    if (!qctr) return cur < 0 ? bid : cur + nb;
    volatile int* s_q = (volatile int*)(smem + LDS_STAGE + 48);
    __syncthreads();
    if (threadIdx.x == 0) *s_q = (int)__hip_atomic_fetch_add(qctr, 1u, __ATOMIC_RELAXED, __HIP_MEMORY_SCOPE_AGENT);
    __syncthreads();
    return *s_q;
}

__device__ __forceinline__ void tr_item(const float* W, int K, int N, bf16_t* WT, float* scr, int item, int lane, bool perm_in = false) {
    const int nblk = (N + 31) / 32, kb = item / nblk, nbk = item % nblk, k0 = 64 * kb, n0 = 32 * nbk;
    const int nn = n0 + (lane & 31);
    float wv[32];
#pragma unroll
    for (int i = 0; i < 32; ++i) wv[i] = nn < N ? W[(size_t)(k0 + 2 * i + (lane >> 5)) * N + nn] : 0.f;
#pragma unroll
    for (int i = 0; i < 32; ++i) scr[(2 * i + (lane >> 5)) * 33 + (lane & 31)] = wv[i];
    asm volatile("s_waitcnt lgkmcnt(0)" ::: "memory");
    const int c = lane & 7;
#pragma unroll
    for (int j = 0; j < 4; ++j) {
        const int n = (lane >> 3) + 8 * j;
        const float* s = scr + (8 * c) * 33 + n;
        uint4 o;
        o.x = pk2(s[0 * 33], s[1 * 33]); o.y = pk2(s[2 * 33], s[3 * 33]);
        o.z = pk2(s[4 * 33], s[5 * 33]); o.w = pk2(s[6 * 33], s[7 * 33]);
        int nr = n0 + n;
        if (perm_in) nr = nr < 3608 ? nr + NPF : (nr < 6680 ? nr - 3608 : nr);
        if (n0 + n < N) *(uint4*)(WT + (size_t)nr * K + k0 + 8 * c) = o;
    }
    asm volatile("s_waitcnt lgkmcnt(0)" ::: "memory");
}

__device__ __forceinline__ void ph_prologue(const Params& p, int bid, int nb, float* lds) {
    const int tid = threadIdx.x, lane = tid & 63, wave = tid >> 6;
    for (int r = (bid + nb - 64 % nb) % nb; r < 64; r += nb) {
        const int kvsel = r >> 5, l = r & 31;
        const float* W = (kvsel ? p.w_cmp_v : p.w_cmp_k) + (size_t)l * 128 * 128;
        const float* pe = (kvsel ? p.pe_v : p.pe_k) + l * 128;
        const int dsub = lane >> 5, e4 = lane & 31;
        pg8::f32x4 wv4[8]; float pv[8];
#pragma unroll
        for (int i = 0; i < 8; ++i) { const int d = 16 * wave + 2 * i + dsub; wv4[i] = *(const pg8::f32x4*)(W + d * 128 + 4 * e4); pv[i] = pe[d]; }
        pg8::f32x4 a4 = {0.f, 0.f, 0.f, 0.f};
#pragma unroll
        for (int i = 0; i < 8; ++i) a4 += wv4[i] * pv[i];
#pragma unroll
        for (int c = 0; c < 4; ++c) a4[c] += __shfl_xor(a4[c], 32, 64);
        if (lane < 32) *(pg8::f32x4*)(lds + wave * 128 + 4 * e4) = a4;
        __syncthreads();
        if (tid < 128) {
            float sum = 0.f;
#pragma unroll
            for (int w = 0; w < 8; ++w) sum += lds[w * 128 + tid];
            p.PEB[r * 128 + tid] = sum;
        }
        __syncthreads();
    }
    {
        float* scr = lds + wave * (64 * 33 + 16);
        const int gw = bid * 8 + wave, ngw = nb * 8;
        const int I_IN = 32 * ((NIN + 31) / 32), I_OUT = 32 * 64, I_C = 4 * 128;
        for (int it = gw; it < I_IN + I_OUT + I_C; it += ngw) {
            if (it < I_IN) tr_item(p.w_in, D, NIN, p.Wt_in, scr, it, lane, true);
            else if (it < I_IN + I_OUT) tr_item(p.w_out, 2048, D, p.Wt_out, scr, it - I_IN, lane);
            else {
                const int r = it - I_IN - I_OUT, q = r >> 7, kvsel = q >> 1, hh = q & 1;
                const float* W = (kvsel ? p.w_cmp_v : p.w_cmp_k) + (size_t)hh * 2048 * 128;
                tr_item(W, 2048, 128, p.Wc_t + ((size_t)kvsel * 256 + hh * 128) * 2048, scr, r & 127, lane);
            }
        }
    }
    __syncthreads();
    {
        const int gw = bid * 8 + wave, ngw = nb * 8;
        float4 gn[8];
#pragma unroll
        for (int j = 0; j < 8; ++j) gn[j] = ((const float4*)p.g_norm)[lane + 64 * j];
        for (int m = gw; m < M; m += 2 * ngw) {
            const int m1 = m + ngw;
            const bool has1 = m1 < M;
            const float4* x0 = (const float4*)xrow(p, m);
            const float4* x1 = (const float4*)xrow(p, has1 ? m1 : m);
            float4 v0[8], v1[8];
#pragma unroll
            for (int j = 0; j < 8; ++j) { v0[j] = x0[lane + 64 * j]; v1[j] = x1[lane + 64 * j]; }
            float s0 = 0.f, s1 = 0.f;
#pragma unroll
            for (int j = 0; j < 8; ++j) {
                s0 += v0[j].x * v0[j].x + v0[j].y * v0[j].y + v0[j].z * v0[j].z + v0[j].w * v0[j].w;
                s1 += v1[j].x * v1[j].x + v1[j].y * v1[j].y + v1[j].z * v1[j].z + v1[j].w * v1[j].w;
            }
            s0 = wave_sum(s0); s1 = wave_sum(s1);
            const float r0 = rsqrtf(s0 * (1.0f / D) + EPS), r1 = rsqrtf(s1 * (1.0f / D) + EPS);
            uint2* o0 = (uint2*)(p.Hb + (size_t)m * D);
            uint2* o1 = (uint2*)(p.Hb + (size_t)m1 * D);
#pragma unroll
            for (int j = 0; j < 8; ++j) {
                const float4 g = gn[j];
                o0[lane + 64 * j] = make_uint2(pk2(v0[j].x * r0 * g.x, v0[j].y * r0 * g.y), pk2(v0[j].z * r0 * g.z, v0[j].w * r0 * g.w));
                if (has1) o1[lane + 64 * j] = make_uint2(pk2(v1[j].x * r1 * g.x, v1[j].y * r1 * g.y), pk2(v1[j].z * r1 * g.z, v1[j].w * r1 * g.w));
            }
        }
    }
}

__device__ __forceinline__ void ph_wincopy(const Params& p, int bid, int nb, unsigned char* smem = nullptr, unsigned* qctr = nullptr) {
    const int tid = threadIdx.x;
    {
        const float4* srcw = (const float4*)(p.cache_win + 8 * 512);
        float4* dstw = (float4*)(p.out + O_WIN_S);
#define WC_IDX(j) ({ const unsigned i_ = (unsigned)ck * 4096u + (unsigned)(j) * 512u + (unsigned)tid; const unsigned sq_ = i_ / 64512u; sq_ * 65536u + (i_ - sq_ * 64512u); })
        for (int ck = q_next(qctr, -1, bid, nb, smem); ck < 2016; ck = q_next(qctr, ck, bid, nb, smem)) {
            const unsigned i0 = WC_IDX(0), i1 = WC_IDX(1), i2 = WC_IDX(2), i3 = WC_IDX(3), i4 = WC_IDX(4), i5 = WC_IDX(5), i6 = WC_IDX(6), i7 = WC_IDX(7);
            typedef pg8::f32x4 f4;
            const f4* sw_ = (const f4*)srcw; f4* dw_ = (f4*)dstw;
            const f4 w0 = __builtin_nontemporal_load(sw_ + i0), w1 = __builtin_nontemporal_load(sw_ + i1), w2 = __builtin_nontemporal_load(sw_ + i2), w3 = __builtin_nontemporal_load(sw_ + i3),
                     w4 = __builtin_nontemporal_load(sw_ + i4), w5 = __builtin_nontemporal_load(sw_ + i5), w6 = __builtin_nontemporal_load(sw_ + i6), w7 = __builtin_nontemporal_load(sw_ + i7);
            __builtin_nontemporal_store(w0, dw_ + i0); __builtin_nontemporal_store(w1, dw_ + i1); __builtin_nontemporal_store(w2, dw_ + i2); __builtin_nontemporal_store(w3, dw_ + i3);
            __builtin_nontemporal_store(w4, dw_ + i4); __builtin_nontemporal_store(w5, dw_ + i5); __builtin_nontemporal_store(w6, dw_ + i6); __builtin_nontemporal_store(w7, dw_ + i7);
        }
#undef WC_IDX
    }
}

__device__ __forceinline__ void post_token(const Params& p, const int m, const float2 (&v)[20], const float gt, const int lane, const int l2,
                                           const float2 gq, const float2 gs, const float2 gwn) {
        float ss[20];
#pragma unroll
        for (int ch = 0; ch < 20; ++ch) ss[ch] = v[ch].x * v[ch].x + v[ch].y * v[ch].y;
#pragma unroll
        for (int o = 32; o >= 1; o >>= 1) {
#pragma unroll
            for (int ch = 0; ch < 20; ++ch) ss[ch] += __shfl_xor(ss[ch], o, 64);
        }
#pragma unroll
        for (int ch = 0; ch < 8; ++ch) {
            const float r = rsqrtf(ss[ch] * (1.0f / 128) + EPS) * 0.08838834764831845f;
            *(unsigned*)&p.Qb[(size_t)m * 1024 + ch * 128 + l2] = pk2(v[ch].x * r * gq.x, v[ch].y * r * gq.y);
        }
#pragma unroll
        for (int c = 0; c < 12; ++c) {
            const int br = c >> 2, kv = (c >> 1) & 1, gg = c & 1;
            float2 w = v[8 + c];
            if (br >= 1 && kv == 0) {
                const float r = rsqrtf(ss[8 + c] * (1.0f / 128) + EPS);
                const float2 gk = (br == 1) ? gs : gwn;
                w.x *= r * gk.x; w.y *= r * gk.y;
            }
            const int sub = (c & 3) * 128 + l2;
            if (m < MP) {
                const int b = m >> 11, t = m & 2047;
                if (br >= 1)
                    *(unsigned*)&p.KVb[((((size_t)((br - 1) * 2 + kv) * 4 + b) * 2 + gg) * 2048 + t) * 128 + l2] = pk2(w.x, w.y);
                if (br == 0) *(float2*)&p.out[O_CMP_P + (size_t)m * 512 + sub] = w;
                else if (br == 1) *(float2*)&p.out[O_SLC_P + (size_t)m * 512 + sub] = w;
                else if (t >= 1536) *(float2*)&p.out[O_WIN_P + ((size_t)b * 512 + (t - 1536)) * 512 + sub] = w;
            } else {
                const int j = m - MP;
                if (br == 0) *(float2*)&p.out[O_CMP_S + (size_t)j * 512 + sub] = w;
                else if (br == 1) *(float2*)&p.out[O_SLC_S + (size_t)j * 512 + sub] = w;
                else *(float2*)&p.out[O_WIN_S + ((size_t)(j >> 3) * 512 + 504 + (j & 7)) * 512 + sub] = w;
            }
        }
        if (lane < 24) p.GATE[(size_t)m * 24 + lane] = sigmoidf_(gt);
}

__device__ __forceinline__ void ph_post(const Params& p, int bid, int nb) {
    const int lane = threadIdx.x & 63, wave = threadIdx.x >> 6;
    const int gw = bid * 8 + wave, ngw = nb * 8;
    const int l2 = lane * 2;
    const float2 gq = *(const float2*)&p.g_q[l2], gs = *(const float2*)&p.g_k_slc[l2], gwn = *(const float2*)&p.g_k_win[l2];
    for (int m = gw; m < M; m += 2 * ngw) {
        const int m1 = m + ngw;
        const bool has1 = m1 < M;
        const bf16_t* row0 = p.PH + (size_t)m * LDH;
        const bf16_t* row1 = p.PH + (size_t)(has1 ? m1 : m) * LDH;
        float2 v0[20], v1[20];
#pragma unroll
        for (int ch = 0; ch < 20; ++ch) {
            const int col = (ch < 8 ? C_QA + ch * 128 : C_KV + (ch - 8) * 128) + l2;
            const unsigned u0 = *(const unsigned*)&row0[col], u1 = *(const unsigned*)&row1[col];
            v0[ch] = make_float2(bflo(u0), bfhi(u0)); v1[ch] = make_float2(bflo(u1), bfhi(u1));
        }
        const float gt0 = (lane < 24) ? bflo((unsigned)row0[C_GATE + lane]) : 0.f, gt1 = (lane < 24) ? bflo((unsigned)row1[C_GATE + lane]) : 0.f;
        post_token(p, m, v0, gt0, lane, l2, gq, gs, gwn);
        if (has1) post_token(p, m1, v1, gt1, lane, l2, gq, gs, gwn);
    }
}

__device__ __forceinline__ void ph_cmp_mfma(const Params& p, int limit, bool early_stop, unsigned char* smem, int maxu = 1 << 30) {
    typedef pg8::bf16x8 bf16x8;
    typedef pg8::f32x4 f32x4;
    const int tid = threadIdx.x, lane = tid & 63, wid = tid >> 6, wm = wid >> 2, wn = wid & 3, fr = lane & 15, fq = lane >> 4;
    const int arow0 = tid >> 5, apc = tid & 31;
    const int brow0 = tid >> 4, bpc = tid & 15;
    float* Cs = (float*)smem;
    unsigned char* bufA = smem;
    unsigned char* bufB = smem + 32768;
    volatile int* s_u = (volatile int*)(smem + LDS_STAGE + 32);
    for (int nu = 0;; ++nu) {
        __syncthreads();
        if (tid == 0) {
            int uu = limit;
            if (nu < maxu && !(early_stop && __hip_atomic_load(&p.ctr[64], __ATOMIC_RELAXED, __HIP_MEMORY_SCOPE_AGENT) != 0u)) {
                uu = (int)__hip_atomic_fetch_add(&p.ctr[0], 1u, __ATOMIC_RELAXED, __HIP_MEMORY_SCOPE_AGENT);
                if (uu >= limit && limit < NSEQ * 4) {
                    (void)__hip_atomic_fetch_sub(&p.ctr[0], 1u, __ATOMIC_RELAXED, __HIP_MEMORY_SCOPE_AGENT);
                    uu = limit;
                }
            }
            *s_u = uu;
        }
        __syncthreads();
        const int u = *s_u;
        if (u >= limit) break;
        const int n = (u < 512) ? 4 + (u >> 2) : ((u - 512) >> 2);
        const int g = (u >> 1) & 1, kvsel = u & 1;
        const float* abase[8]; size_t lstride;
        if (n >= 4) {
            lstride = 512;
#pragma unroll
            for (int j = 0; j < 8; ++j) {
                const int ar = arow0 + 16 * j;
                const int page = p.page_table[(n - 4) * 16 + (ar >> 3)];
                abase[j] = p.cache_cmp + ((((size_t)page * 128 + 16 * (ar & 7)) * 2 + kvsel) * 2 + g) * 128 + apc * 4;
            }
        } else {
            lstride = LDH / 2;
#pragma unroll
            for (int j = 0; j < 8; ++j)
                abase[j] = (const float*)(p.PH + ((size_t)n * 2048 + 16 * (arow0 + 16 * j)) * LDH + C_KV + kvsel * 256 + g * 128 + (apc & ~1) * 4);
        }
        const bool a16 = (n < 4);
        const bf16_t* bbase = p.Wc_t + ((size_t)kvsel * 256 + brow0) * 2048 + bpc * 8;
        f32x4 acc[4][4];
#pragma unroll
        for (int m = 0; m < 4; ++m)
#pragma unroll
            for (int q = 0; q < 4; ++q) acc[m][q] = (f32x4){0.f, 0.f, 0.f, 0.f};
        f32x4 ra[8]; pg8::u32x4 rb[8];
#pragma unroll
        for (int j = 0; j < 8; ++j) {
            ra[j] = __builtin_nontemporal_load((const f32x4*)abase[j]);
            rb[j] = *(const pg8::u32x4*)(bbase + (size_t)32 * j * 2048);
        }
        for (int ss = 0; ss < 16; ++ss) {
#pragma unroll
            for (int j = 0; j < 8; ++j) {
                const int ar = arow0 + 16 * j, br = brow0 + 32 * j;
                if (a16) { if (!(apc & 1)) *(f32x4*)(bufA + ar * 256 + ((((unsigned)apc >> 1) ^ (unsigned)(ar & 15)) << 4)) = ra[j]; }
                else *(uint2*)(bufA + ar * 256 + ((((unsigned)apc >> 1) ^ (unsigned)(ar & 15)) << 4) + 8 * (apc & 1)) =
                    make_uint2(pk2(ra[j][0], ra[j][1]), pk2(ra[j][2], ra[j][3]));
                *(pg8::u32x4*)(bufB + br * 256 + (((unsigned)bpc ^ (unsigned)(br & 15)) << 4)) = rb[j];
            }
            __syncthreads();
            if (ss + 1 < 16) {
#pragma unroll
                for (int j = 0; j < 8; ++j) {
                    ra[j] = __builtin_nontemporal_load((const f32x4*)(abase[j] + (size_t)(ss + 1) * lstride));
                    rb[j] = *(const pg8::u32x4*)(bbase + (size_t)32 * j * 2048 + (ss + 1) * 128);
                }
            }
#pragma unroll
            for (int sub = 0; sub < 4; ++sub) {
                bf16x8 Af[4], Bf[4];
#pragma unroll
                for (int m = 0; m < 4; ++m) {
                    const int r = wm * 64 + 16 * m + fr;
                    Af[m] = *(const bf16x8*)(bufA + r * 256 + (((unsigned)(4 * sub + fq) ^ (unsigned)(r & 15)) << 4));
                }
#pragma unroll
                for (int q = 0; q < 4; ++q) {
                    const int r = wn * 64 + 16 * q + fr;
                    Bf[q] = *(const bf16x8*)(bufB + r * 256 + (((unsigned)(4 * sub + fq) ^ (unsigned)(r & 15)) << 4));
                }
#pragma unroll
                for (int m = 0; m < 4; ++m)
#pragma unroll
                    for (int q = 0; q < 4; ++q)
                        acc[m][q] = __builtin_amdgcn_mfma_f32_16x16x32_bf16(Bf[q], Af[m], acc[m][q], 0, 0, 0);
            }
            __syncthreads();
        }
        __syncthreads();
#pragma unroll
        for (int m = 0; m < 4; ++m)
#pragma unroll
            for (int q = 0; q < 4; ++q)
                *(f32x4*)(Cs + (wm * 64 + 16 * m + fr) * 260 + wn * 64 + 16 * q + 4 * fq) = acc[m][q];
        __syncthreads();
        {
            float pb0 = 0.f, pb1 = 0.f;
            for (int l = 0; l < 32; ++l) {
                pb0 += p.PEB[(kvsel * 32 + l) * 128 + lane];
                pb1 += p.PEB[(kvsel * 32 + l) * 128 + lane + 64];
            }
            bf16_t* dst = (kvsel ? p.VCb : p.KCb) + ((size_t)(n * 2 + g) * 128) * 128;
            const float g0 = p.g_k_cmp[lane], g1 = p.g_k_cmp[lane + 64];
            for (int c = wid; c < 128; c += 8) {
                float v0 = 0.f, v1 = 0.f;
                if (c < NCMP) {
                    v0 = Cs[c * 260 + lane] + Cs[(c + 1) * 260 + 128 + lane] + pb0;
                    v1 = Cs[c * 260 + lane + 64] + Cs[(c + 1) * 260 + 192 + lane] + pb1;
                    if (kvsel == 0) {
                        const float ss = wave_sum(v0 * v0 + v1 * v1);
                        const float rr = rsqrtf(ss * (1.0f / 128) + EPS);
                        v0 *= rr * g0; v1 *= rr * g1;
                    }
                }
                const unsigned pk = pk2(v0, v1);
                dst[c * 128 + lane] = (bf16_t)(pk & 0xffffu);
                dst[c * 128 + lane + 64] = (bf16_t)(pk >> 16);
            }
        }
        __syncthreads();
    }
}

__device__ __forceinline__ unsigned fvsw(int row) { return (unsigned)(((row & 3) << 2) | (((row >> 2) & 1) << 1) | ((row >> 3) & 1)); }

__device__ __forceinline__ void ph_cmp_attn_mfma(const Params& p, int bid, int nb, unsigned char* smem) {
    typedef pg8::bf16x8 bf16x8;
    typedef pg8::f32x4 f32x4;
    typedef short s16x4 __attribute__((ext_vector_type(4)));
    const int tid = threadIdx.x, lane = tid & 63, wid = tid >> 6, fr = lane & 15, fq = lane >> 4, hl = fr & 3;
    unsigned char* Kb = smem;
    unsigned char* Vb = smem + 32768;
    float* bt = (float*)(smem + 65536);
    float* sA = (float*)(smem + 65536 + 2048);
    float* sB = sA + 1024;
    float* skey = sB + 1024;
    unsigned long long* smask = (unsigned long long*)(skey + 32 * 36);
    for (int it = bid; it < 512 + 256; it += nb) {
        int n, g, m0, qpos0, ntok;
        if (it < 512) { const int bg = it >> 6; n = bg >> 1; g = bg & 1; const int qt = it & 63; m0 = n * 2048 + qt * 32; qpos0 = qt * 32; ntok = 32; }
        else { const int j = it - 512; const int sq = j >> 1; g = j & 1; n = 4 + sq; m0 = MP + sq * 8; qpos0 = 2048; ntok = 8; }
        const int tl = (ntok == 32) ? 4 * wid + (fr >> 2) : 4 * (wid & 1) + (fr >> 2);
        const bool wr = (ntok == 32) || (wid < 2);
        const int m = m0 + tl, tq = qpos0 + tl;
        __syncthreads();
        bf16x8 Qf[4];
        {
            const int row = tid >> 2;
            const bf16_t* kc = p.KCb + ((size_t)(n * 2 + g) * 128 + row) * 128;
            const bf16_t* vc = p.VCb + ((size_t)(n * 2 + g) * 128 + row) * 128;
            pg8::u32x4 kk[4], vk[4];
#pragma unroll
            for (int jj = 0; jj < 4; ++jj) {
                const unsigned ch = (unsigned)((tid & 3) * 4 + jj);
                kk[jj] = *(const pg8::u32x4*)(kc + ch * 8);
                vk[jj] = *(const pg8::u32x4*)(vc + ch * 8);
            }
            const float btv = p.rel_bias[rel_bucket(tid & 127) * 8 + g * 4 + (tid >> 7)];
            const bf16_t* qp = p.Qb + (size_t)m * 1024 + (g * 4 + hl) * 128 + 8 * fq;
#pragma unroll
            for (int sx = 0; sx < 4; ++sx) Qf[sx] = *(const bf16x8*)(qp + 32 * sx);
            asm volatile("" : "+v"(kk[0]), "+v"(kk[1]), "+v"(kk[2]), "+v"(kk[3]), "+v"(vk[0]), "+v"(vk[1]), "+v"(vk[2]), "+v"(vk[3]) :: "memory");
            bt[tid] = btv;
            if (tid < 32) smask[tid] = 0ull;
#pragma unroll
            for (int jj = 0; jj < 4; ++jj) {
                const unsigned ch = (unsigned)((tid & 3) * 4 + jj);
                *(pg8::u32x4*)(Kb + row * 256 + ((ch ^ (unsigned)(row & 15)) << 4)) = kk[jj];
                *(pg8::u32x4*)(Vb + row * 256 + ((ch ^ fvsw(row)) << 4)) = vk[jj];
            }
        }
        __syncthreads();
        f32x4 S[8];
#pragma unroll
        for (int nt = 0; nt < 8; ++nt) {
            const int r = 16 * nt + fr;
            S[nt] = (f32x4){0.f, 0.f, 0.f, 0.f};
#pragma unroll
            for (int sx = 0; sx < 4; ++sx) {
                const bf16x8 Kf = *(const bf16x8*)(Kb + r * 256 + (((unsigned)(4 * sx + fq) ^ (unsigned)(r & 15)) << 4));
                S[nt] = __builtin_amdgcn_mfma_f32_16x16x32_bf16(Kf, Qf[sx], S[nt], 0, 0, 0);
            }
        }
        float tmax = -INFINITY;
#pragma unroll
        for (int nt = 0; nt < 8; ++nt)
#pragma unroll
            for (int i = 0; i < 4; ++i) {
                const int c = 16 * nt + 4 * fq + i;
                const int dist = tq - (16 * c + 31);
                const bool valid = dist >= 0 && c < NCMP;
                const float bias = bt[hl * 128 + (dist < 0 ? 0 : (dist > 127 ? 127 : dist))];
                const float sv = valid ? S[nt][i] + bias : -INFINITY;
                S[nt][i] = sv;
                tmax = fmaxf(tmax, sv);
            }
        tmax = fmaxf(tmax, __shfl_xor(tmax, 16, 64));
        tmax = fmaxf(tmax, __shfl_xor(tmax, 32, 64));
        const bool dead = (tmax == -INFINITY);
        float psum = 0.f;
#pragma unroll
        for (int nt = 0; nt < 8; ++nt)
#pragma unroll
            for (int i = 0; i < 4; ++i) {
                const float pv = dead ? 0.f : __expf(S[nt][i] - tmax);
                S[nt][i] = pv;
                psum += pv;
            }
        psum += __shfl_xor(psum, 16, 64);
        psum += __shfl_xor(psum, 32, 64);
        const float inv = psum > 0.f ? 1.0f / psum : 0.f;
#pragma unroll
        for (int nt = 0; nt < 8; ++nt) { S[nt][0] *= inv; S[nt][1] *= inv; S[nt][2] *= inv; S[nt][3] *= inv; }
#pragma unroll
        for (int nt = 0; nt < 8; ++nt) {
            float av = 2.f * (S[nt][0] + S[nt][1] + S[nt][2]) + S[nt][3];
            float bv = S[nt][3];
            av += __shfl_xor(av, 1, 64); av += __shfl_xor(av, 2, 64);
            bv += __shfl_xor(bv, 1, 64); bv += __shfl_xor(bv, 2, 64);
            if (hl == 0 && wr) { sA[tl * 32 + 4 * nt + fq] = av; sB[tl * 32 + 4 * nt + fq] = bv; }
        }
        f32x4 O[8];
#pragma unroll
        for (int c = 0; c < 8; ++c) O[c] = (f32x4){0.f, 0.f, 0.f, 0.f};
#pragma unroll
        for (int ks = 0; ks < 4; ++ks) {
            union { unsigned u[4]; bf16x8 v; } cv;
            cv.u[0] = pk2(S[2 * ks][0], S[2 * ks][1]); cv.u[1] = pk2(S[2 * ks][2], S[2 * ks][3]);
            cv.u[2] = pk2(S[2 * ks + 1][0], S[2 * ks + 1][1]); cv.u[3] = pk2(S[2 * ks + 1][2], S[2 * ks + 1][3]);
            const bf16x8 Pf = cv.v;
#pragma unroll
            for (int c = 0; c < 8; ++c) {
                const int r0 = 32 * ks + 4 * fq + (fr >> 2), r1 = r0 + 16;
                const unsigned ch = (unsigned)(2 * c + ((fr & 3) >> 1));
                const s16x4 a0 = __builtin_amdgcn_ds_read_tr16_b64_v4i16((__attribute__((address_space(3))) s16x4*)(Vb + r0 * 256 + ((ch ^ fvsw(r0)) << 4) + 8 * (fr & 1)));
                const s16x4 a1 = __builtin_amdgcn_ds_read_tr16_b64_v4i16((__attribute__((address_space(3))) s16x4*)(Vb + r1 * 256 + ((ch ^ fvsw(r1)) << 4) + 8 * (fr & 1)));
                const bf16x8 Vf = {a0[0], a0[1], a0[2], a0[3], a1[0], a1[1], a1[2], a1[3]};
                O[c] = __builtin_amdgcn_mfma_f32_16x16x32_bf16(Vf, Pf, O[c], 0, 0, 0);
            }
        }
        if (wr) {
            bf16_t* op = p.OC + (size_t)m * 1024 + (g * 4 + hl) * 128 + 4 * fq;
#pragma unroll
            for (int c = 0; c < 8; ++c) *(uint2*)(op + 16 * c) = make_uint2(pk2(O[c][0], O[c][1]), pk2(O[c][2], O[c][3]));
        }
        __syncthreads();
        const int tokl = tid >> 4, jb = 2 * (tid & 15);
        const bool active = tokl < ntok;
        const int cur = (qpos0 + tokl) >> 6;
#pragma unroll
        for (int e = 0; e < 2; ++e) {
            const int j = jb + e;
            const float scv = sA[tokl * 32 + j] + (j > 0 ? sB[tokl * 32 + j - 1] : 0.f);
            const bool valid = j <= cur;
            const bool forced = (j == 0) || (j == cur) || (j == cur - 1);
            skey[tokl * 36 + j] = (active && valid) ? (forced ? INFINITY : scv) : -INFINITY;
        }
        if ((tid & 15) == 0) skey[tokl * 36 + 32] = (ntok == 8) ? INFINITY : -INFINITY;
        __syncthreads();
        const int nslc = (ntok == 32) ? 32 : 33;
#pragma unroll
        for (int e = 0; e < 2; ++e) {
            const int j = jb + e;
            const float key = skey[tokl * 36 + j];
            int rank = 0;
            for (int j2 = 0; j2 < nslc; ++j2) {
                const float k2 = skey[tokl * 36 + j2];
                rank += (k2 > key) || (k2 == key && j2 < j);
            }
            if (active && rank < 16 && j <= cur) atomicOr(&smask[tokl], 1ull << j);
        }
        if (ntok == 8 && active && (tid & 15) == 0) atomicOr(&smask[tokl], 1ull << 32);
        __syncthreads();
        if (tid < ntok) p.SEL[(m0 + tid) * 2 + g] = smask[tid];
    }
}


template <int BR>
__device__ __forceinline__ void ph_attn_prompt(const Params& p, int bid, int nb, unsigned char* smem, unsigned* qctr = nullptr) {
    typedef pg8::bf16x8 bf16x8;
    typedef pg8::f32x4 f32x4;
    typedef short s16x4 __attribute__((ext_vector_type(4)));
    const int tid = threadIdx.x, lane = tid & 63, wid = tid >> 6, fr = lane & 15, fq = lane >> 4, hl = fr & 3;
    float* bt = (float*)(smem + 65536);
    const int srow = tid >> 4, spc = tid & 15;
    const unsigned ksw = (unsigned)(srow & 15), vsw = fvsw(srow);
    for (int pi = q_next(qctr, -1, bid, nb, smem); pi < 256; pi = q_next(qctr, pi, bid, nb, smem)) {
        const int bg = pi >> 5, b = bg >> 1, g = bg & 1, a = pi & 31;
        __syncthreads();
        bt[tid] = p.rel_bias[rel_bucket(tid & 127) * 8 + g * 4 + (tid >> 7)];
        float b31 = p.rel_bias[31 * 8 + g * 4 + hl];
        const bf16_t* Kg = p.KVb + ((((size_t)(BR * 2 + 0) * 4 + b) * 2 + g) * 2048) * 128;
        const bf16_t* Vg = p.KVb + ((((size_t)(BR * 2 + 1) * 4 + b) * 2 + g) * 2048) * 128;
        bf16_t* Og = (BR == 0) ? p.OS : p.OW;
        for (int half = 0; half < 2; ++half) {
            const int qt = half ? 63 - a : a, t0 = qt * 32;
            const int tq = t0 + 4 * wid + (fr >> 2);
            const int m = b * 2048 + tq;
            bf16x8 Qf[4];
            {
                const bf16_t* qp = p.Qb + (size_t)m * 1024 + (g * 4 + hl) * 128 + 8 * fq;
#pragma unroll
                for (int sx = 0; sx < 4; ++sx) Qf[sx] = *(const bf16x8*)(qp + 32 * sx);
            }
            unsigned selmask = (BR == 0) ? (unsigned)p.SEL[m * 2 + g] : 0u;
            const int jhi = (t0 + 31) >> 6;
            const int jlo = (BR == 0) ? 0 : ((t0 - 512) > 0 ? ((t0 - 512) >> 6) : 0);
            f32x4 O[8];
#pragma unroll
            for (int c = 0; c < 8; ++c) O[c] = (f32x4){0.f, 0.f, 0.f, 0.f};
            float mrun = -INFINITY, lrun = 0.f;
            typedef pg8::u32x4 u32x4;
            u32x4 kr[2][2], vr[2][2];
#pragma unroll
            for (int par = 0; par < 2; ++par) {
                {
                    const int jl = (jlo + par <= jhi) ? jlo + par : jhi;
                    const bf16_t* kp = Kg + ((size_t)jl * 64 + srow) * 128 + spc * 8;
                    const bf16_t* vp = Vg + ((size_t)jl * 64 + srow) * 128 + spc * 8;
                    kr[par][0] = *(const u32x4*)kp; kr[par][1] = *(const u32x4*)(kp + 32 * 128);
                    vr[par][0] = *(const u32x4*)vp; vr[par][1] = *(const u32x4*)(vp + 32 * 128);
                }
            }
            asm volatile("" : "+v"(Qf[0]), "+v"(Qf[1]), "+v"(Qf[2]), "+v"(Qf[3]), "+v"(b31), "+v"(selmask) :: "memory");
            __syncthreads();
            for (int jj = jlo; jj <= jhi; jj += 2) {
#pragma unroll
              for (int par = 0; par < 2; ++par) {
                const int j = jj + par;
                if (j > jhi) break;
                unsigned char* Kb = smem + par * 32768;
                unsigned char* Vb = Kb + 16384;
                *(u32x4*)(Kb + srow * 256 + (((unsigned)spc ^ ksw) << 4)) = kr[par][0];
                *(u32x4*)(Kb + (srow + 32) * 256 + (((unsigned)spc ^ ksw) << 4)) = kr[par][1];
                *(u32x4*)(Vb + srow * 256 + (((unsigned)spc ^ vsw) << 4)) = vr[par][0];
                *(u32x4*)(Vb + (srow + 32) * 256 + (((unsigned)spc ^ vsw) << 4)) = vr[par][1];
                __syncthreads();
                {
                    const int jn = (j + 2 <= jhi) ? j + 2 : jhi;
                    const bf16_t* kp = Kg + ((size_t)jn * 64 + srow) * 128 + spc * 8;
                    const bf16_t* vp = Vg + ((size_t)jn * 64 + srow) * 128 + spc * 8;
                    kr[par][0] = *(const u32x4*)kp; kr[par][1] = *(const u32x4*)(kp + 32 * 128);
                    vr[par][0] = *(const u32x4*)vp; vr[par][1] = *(const u32x4*)(vp + 32 * 128);
                }
                const int kbase = j * 64;
                f32x4 S[4];
#pragma unroll
                for (int nt = 0; nt < 4; ++nt) {
                    const int r = 16 * nt + fr;
                    S[nt] = (f32x4){0.f, 0.f, 0.f, 0.f};
#pragma unroll
                    for (int sx = 0; sx < 4; ++sx) {
                        const bf16x8 Kf = *(const bf16x8*)(Kb + r * 256 + (((unsigned)(4 * sx + fq) ^ (unsigned)(r & 15)) << 4));
                        S[nt] = __builtin_amdgcn_mfma_f32_16x16x32_bf16(Kf, Qf[sx], S[nt], 0, 0, 0);
                    }
                }
                const bool far = (t0 - (kbase + 63)) >= 113;
                const bool selok = (BR == 0) ? (((selmask >> j) & 1u) != 0u) : true;
                float tmax = -INFINITY;
                if (far && (BR == 0 || (t0 + 31 - kbase) <= 512)) {
                    const float add = selok ? b31 : -INFINITY;
#pragma unroll
                    for (int nt = 0; nt < 4; ++nt)
#pragma unroll
                        for (int i = 0; i < 4; ++i) { const float sv = S[nt][i] + add; S[nt][i] = sv; tmax = fmaxf(tmax, sv); }
                } else {
#pragma unroll
                for (int nt = 0; nt < 4; ++nt)
#pragma unroll
                    for (int i = 0; i < 4; ++i) {
                        const int dist = tq - (kbase + 16 * nt + 4 * fq + i);
                        bool valid = selok && dist >= 0;
                        if (BR == 1) valid = valid && dist <= 512;
                        const float bias = far ? b31 : bt[hl * 128 + (dist < 0 ? 0 : (dist > 127 ? 127 : dist))];
                        const float sv = valid ? S[nt][i] + bias : -INFINITY;
                        S[nt][i] = sv;
                        tmax = fmaxf(tmax, sv);
                    }
                }
                tmax = fmaxf(tmax, __shfl_xor(tmax, 16, 64));
                tmax = fmaxf(tmax, __shfl_xor(tmax, 32, 64));
                const float mnew = fmaxf(mrun, tmax);
                const bool dead = (mnew == -INFINITY);
                const float scale = (mrun == -INFINITY) ? 0.f : __expf(mrun - mnew);
                float psum = 0.f;
#pragma unroll
                for (int nt = 0; nt < 4; ++nt)
#pragma unroll
                    for (int i = 0; i < 4; ++i) {
                        const float pv = dead ? 0.f : __expf(S[nt][i] - mnew);
                        S[nt][i] = pv;
                        psum += pv;
                    }
                lrun = lrun * scale + psum;
                mrun = mnew;
#pragma unroll
                for (int c = 0; c < 8; ++c) { O[c][0] *= scale; O[c][1] *= scale; O[c][2] *= scale; O[c][3] *= scale; }
                bf16x8 Pf[2];
#pragma unroll
                for (int ks = 0; ks < 2; ++ks) {
                    union { unsigned u[4]; bf16x8 v; } cv;
                    cv.u[0] = pk2(S[2 * ks][0], S[2 * ks][1]); cv.u[1] = pk2(S[2 * ks][2], S[2 * ks][3]);
                    cv.u[2] = pk2(S[2 * ks + 1][0], S[2 * ks + 1][1]); cv.u[3] = pk2(S[2 * ks + 1][2], S[2 * ks + 1][3]);
                    Pf[ks] = cv.v;
                }
#pragma unroll
                for (int c = 0; c < 8; ++c)
#pragma unroll
                    for (int ks = 0; ks < 2; ++ks) {
                        const int r0 = 32 * ks + 4 * fq + (fr >> 2), r1 = r0 + 16;
                        const unsigned ch = (unsigned)(2 * c + ((fr & 3) >> 1));
                        const s16x4 v0 = __builtin_amdgcn_ds_read_tr16_b64_v4i16((__attribute__((address_space(3))) s16x4*)(Vb + r0 * 256 + ((ch ^ fvsw(r0)) << 4) + 8 * (fr & 1)));
                        const s16x4 v1 = __builtin_amdgcn_ds_read_tr16_b64_v4i16((__attribute__((address_space(3))) s16x4*)(Vb + r1 * 256 + ((ch ^ fvsw(r1)) << 4) + 8 * (fr & 1)));
                        const bf16x8 Vf = {v0[0], v0[1], v0[2], v0[3], v1[0], v1[1], v1[2], v1[3]};
                        O[c] = __builtin_amdgcn_mfma_f32_16x16x32_bf16(Vf, Pf[ks], O[c], 0, 0, 0);
                    }
              }
            }
            float l = lrun + __shfl_xor(lrun, 16, 64);
            l += __shfl_xor(l, 32, 64);
            const float inv = l > 0.f ? 1.0f / l : 0.f;
            bf16_t* op = Og + (size_t)m * 1024 + (g * 4 + hl) * 128 + 4 * fq;
#pragma unroll
            for (int c = 0; c < 8; ++c)
                *(uint2*)(op + 16 * c) = make_uint2(pk2(O[c][0] * inv, O[c][1] * inv), pk2(O[c][2] * inv, O[c][3] * inv));
        }
    }
}


template <int BR>
__device__ __forceinline__ void ph_attn_sample(const Params& p, int bid, int nb, unsigned char* smem, unsigned* qctr = nullptr) {
    typedef pg8::bf16x8 bf16x8;
    typedef pg8::f32x4 f32x4;
    typedef short s16x4 __attribute__((ext_vector_type(4)));
    const int tid = threadIdx.x, lane = tid & 63, wid = tid >> 6, fr = lane & 15, fq = lane >> 4, hl = fr & 3;
    const int mt = wid & 1, kh = (wid >> 1) & 1, dh = wid >> 2;
    float* bt = (float*)(smem + 65536);
    float* mrg = (float*)(smem + 65536 + 2048);
    int* pgs = (int*)(smem + 65536 + 2048 + 36864);
    const int srow = tid >> 5, spc = tid & 31;
    const unsigned ksw = (unsigned)(srow & 15), vsw = fvsw(srow);
    for (int it = q_next(qctr, -1, bid, nb, smem); it < 256; it = q_next(qctr, it, bid, nb, smem)) {
        const int s = __builtin_amdgcn_readfirstlane(it >> 1), g = __builtin_amdgcn_readfirstlane(it & 1);
        __syncthreads();
        bt[tid] = p.rel_bias[rel_bucket(tid & 127) * 8 + g * 4 + (tid >> 7)];
        if (BR == 0) { if (tid < 16) pgs[tid] = p.page_table[s * 16 + tid]; __syncthreads(); }
        float b31 = p.rel_bias[31 * 8 + g * 4 + hl];
        const int ti = 4 * mt + (fr >> 2);
        const int m = MP + s * 8 + ti;
        const int tq = (BR == 0) ? 2048 + ti : 512 + ti;
        bf16x8 Qf[4];
        {
            const bf16_t* qp = p.Qb + (size_t)m * 1024 + (g * 4 + hl) * 128 + 8 * fq;
#pragma unroll
            for (int sx = 0; sx < 4; ++sx) Qf[sx] = *(const bf16x8*)(qp + 32 * sx);
        }
        unsigned long long selmask = 0ull, tmask;
        if (BR == 0) {
            selmask = p.SEL[m * 2 + g];
            unsigned long long om = p.SEL[(MP + s * 8 + (lane & 7)) * 2 + g];
            om |= __shfl_xor(om, 1, 64); om |= __shfl_xor(om, 2, 64); om |= __shfl_xor(om, 4, 64);
            tmask = om;
        } else tmask = 0x1ffull;
        asm volatile("" : "+v"(Qf[0]), "+v"(Qf[1]), "+v"(Qf[2]), "+v"(Qf[3]), "+v"(b31), "+v"(selmask) :: "memory");
        auto rowptr = [&](int j, int jj) -> const float* {
            const int r = 64 * j + srow + 16 * jj;
            if (BR == 0) {
                if (r < 2048) {
                    const int page = pgs[j >> 1];
                    return p.cache_slc + (((size_t)page * 128 + (r & 127)) * 4 + g) * 128;
                }
                if (r < 2056) return p.out + O_SLC_S + ((size_t)s * 8 + (r - 2048)) * 512 + g * 128;
                return nullptr;
            } else {
                if (r < 512) return p.cache_win + (((size_t)s * 512 + r) * 4 + g) * 128;
                if (r < 520) return p.out + O_WIN_S + ((size_t)s * 512 + 504 + (r - 512)) * 512 + g * 128;
                return nullptr;
            }
        };
        f32x4 O[4];
#pragma unroll
        for (int c = 0; c < 4; ++c) O[c] = (f32x4){0.f, 0.f, 0.f, 0.f};
        float mrun = -INFINITY, lrun = 0.f;
        f32x4 kx[2][4], vx[2][4];
        int jt[2];
        unsigned rowok[2];
#define GLD_NT(dst, ptr) asm volatile("global_load_dwordx4 %0, %1, off nt" : "=v"(dst) : "v"(ptr) : "memory")
#define LOAD_ROWS(j, par) do { rowok[par] = 0u; _Pragma("unroll") for (int jj_ = 0; jj_ < 4; ++jj_) { const float* rp_ = rowptr(j, jj_); \
            if (rp_) rowok[par] |= 1u << jj_; else rp_ = p.cache_win; \
            GLD_NT(kx[par][jj_], rp_ + spc * 4); GLD_NT(vx[par][jj_], rp_ + 256 + spc * 4); } } while (0)
#pragma unroll
        for (int par = 0; par < 2; ++par) {
            jt[par] = __builtin_amdgcn_readfirstlane(tmask ? (int)__builtin_ctzll(tmask) : -1);
            tmask &= tmask - 1;
            rowok[par] = 0u;
            if (jt[par] >= 0) LOAD_ROWS(jt[par], par);
            else {
#pragma unroll
                for (int jj_ = 0; jj_ < 4; ++jj_) { kx[par][jj_] = (f32x4){0.f, 0.f, 0.f, 0.f}; vx[par][jj_] = (f32x4){0.f, 0.f, 0.f, 0.f}; }
            }
        }
        __syncthreads();
        bool more = true;
        while (more) {
#pragma unroll
          for (int par = 0; par < 2; ++par) {
            const int j = jt[par];
            if (j < 0) { more = false; break; }
            unsigned char* Kb = smem + par * 32768;
            unsigned char* Vb = Kb + 16384;
            if (jt[par ^ 1] >= 0) asm volatile("s_waitcnt vmcnt(8)" ::: "memory"); else asm volatile("s_waitcnt vmcnt(0)" ::: "memory");
            asm volatile("" : "+v"(kx[par][0]), "+v"(kx[par][1]), "+v"(kx[par][2]), "+v"(kx[par][3]), "+v"(vx[par][0]), "+v"(vx[par][1]), "+v"(vx[par][2]), "+v"(vx[par][3]) :: "memory");
            {
                const unsigned kof = ((((unsigned)spc >> 1) ^ ksw) << 4) + 8u * ((unsigned)spc & 1u);
                const unsigned vof = ((((unsigned)spc >> 1) ^ vsw) << 4) + 8u * ((unsigned)spc & 1u);
#pragma unroll
                for (int jj_ = 0; jj_ < 4; ++jj_) {
                    const bool ok = (rowok[par] >> jj_) & 1u;
                    const uint2 kw = ok ? make_uint2(pk2(kx[par][jj_][0], kx[par][jj_][1]), pk2(kx[par][jj_][2], kx[par][jj_][3])) : make_uint2(0u, 0u);
                    const uint2 vw = ok ? make_uint2(pk2(vx[par][jj_][0], vx[par][jj_][1]), pk2(vx[par][jj_][2], vx[par][jj_][3])) : make_uint2(0u, 0u);
                    *(uint2*)(Kb + (srow + 16 * jj_) * 256 + kof) = kw;
                    *(uint2*)(Vb + (srow + 16 * jj_) * 256 + vof) = vw;
                }
            }
            __syncthreads();
            jt[par] = __builtin_amdgcn_readfirstlane(tmask ? (int)__builtin_ctzll(tmask) : -1);
            tmask &= tmask - 1;
            if (jt[par] >= 0) LOAD_ROWS(jt[par], par);
            const int kbase = j * 64 + 32 * kh;
            f32x4 S[2];
#pragma unroll
            for (int nt = 0; nt < 2; ++nt) {
                const int r = 32 * kh + 16 * nt + fr;
                S[nt] = (f32x4){0.f, 0.f, 0.f, 0.f};
#pragma unroll
                for (int sx = 0; sx < 4; ++sx) {
                    const bf16x8 Kf = *(const bf16x8*)(Kb + r * 256 + (((unsigned)(4 * sx + fq) ^ (unsigned)(r & 15)) << 4));
                    S[nt] = __builtin_amdgcn_mfma_f32_16x16x32_bf16(Kf, Qf[sx], S[nt], 0, 0, 0);
                }
            }
            const int q0 = (BR == 0) ? 2048 : 512;
            const bool far = (q0 - (j * 64 + 63)) >= 113;
            const bool selok = (BR == 0) ? (((selmask >> j) & 1ull) != 0ull) : true;
            float tmax = -INFINITY;
#pragma unroll
            for (int nt = 0; nt < 2; ++nt)
#pragma unroll
                for (int i = 0; i < 4; ++i) {
                    const int dist = tq - (kbase + 16 * nt + 4 * fq + i);
                    bool valid = selok && dist >= 0;
                    if (BR == 1) valid = valid && dist <= 512;
                    const float bias = far ? b31 : bt[hl * 128 + (dist < 0 ? 0 : (dist > 127 ? 127 : dist))];
                    const float sv = valid ? S[nt][i] + bias : -INFINITY;
                    S[nt][i] = sv;
                    tmax = fmaxf(tmax, sv);
                }
            tmax = fmaxf(tmax, __shfl_xor(tmax, 16, 64));
            tmax = fmaxf(tmax, __shfl_xor(tmax, 32, 64));
            const float mnew = fmaxf(mrun, tmax);
            const bool dead = (mnew == -INFINITY);
            const float scale = (mrun == -INFINITY) ? 0.f : __expf(mrun - mnew);
            float psum = 0.f;
#pragma unroll
            for (int nt = 0; nt < 2; ++nt)
#pragma unroll
                for (int i = 0; i < 4; ++i) {
                    const float pv = dead ? 0.f : __expf(S[nt][i] - mnew);
                    S[nt][i] = pv;
                    psum += pv;
                }
            lrun = lrun * scale + psum;
            mrun = mnew;
#pragma unroll
            for (int c = 0; c < 4; ++c) { O[c][0] *= scale; O[c][1] *= scale; O[c][2] *= scale; O[c][3] *= scale; }
            bf16x8 Pf;
            {
                union { unsigned u[4]; bf16x8 v; } cv;
                cv.u[0] = pk2(S[0][0], S[0][1]); cv.u[1] = pk2(S[0][2], S[0][3]);
                cv.u[2] = pk2(S[1][0], S[1][1]); cv.u[3] = pk2(S[1][2], S[1][3]);
                Pf = cv.v;
            }
#pragma unroll
            for (int c = 0; c < 4; ++c) {
                const int r0 = 32 * kh + 4 * fq + (fr >> 2), r1 = r0 + 16;
                const unsigned ch = (unsigned)(2 * (4 * dh + c) + ((fr & 3) >> 1));
                const s16x4 a0 = __builtin_amdgcn_ds_read_tr16_b64_v4i16((__attribute__((address_space(3))) s16x4*)(Vb + r0 * 256 + ((ch ^ fvsw(r0)) << 4) + 8 * (fr & 1)));
                const s16x4 a1 = __builtin_amdgcn_ds_read_tr16_b64_v4i16((__attribute__((address_space(3))) s16x4*)(Vb + r1 * 256 + ((ch ^ fvsw(r1)) << 4) + 8 * (fr & 1)));
                const bf16x8 Vf = {a0[0], a0[1], a0[2], a0[3], a1[0], a1[1], a1[2], a1[3]};
                O[c] = __builtin_amdgcn_mfma_f32_16x16x32_bf16(Vf, Pf, O[c], 0, 0, 0);
            }
          }
        }
#undef LOAD_ROWS
#undef GLD_NT
        float l = lrun + __shfl_xor(lrun, 16, 64);
        l += __shfl_xor(l, 32, 64);
#pragma unroll
        for (int c = 0; c < 4; ++c) *(f32x4*)(mrg + ((wid * 4 + c) * 64 + lane) * 4) = O[c];
        mrg[8192 + (wid * 64 + lane) * 2] = mrun;
        mrg[8192 + (wid * 64 + lane) * 2 + 1] = l;
        __syncthreads();
        if (kh == 0) {
            const int pw = wid + 2;
            const float m1 = mrg[8192 + (pw * 64 + lane) * 2], l1 = mrg[8192 + (pw * 64 + lane) * 2 + 1];
            const float mm = fmaxf(mrun, m1);
            float w0 = 0.f, w1 = 0.f;
            if (mm != -INFINITY) {
                w0 = (mrun == -INFINITY) ? 0.f : __expf(mrun - mm);
                w1 = (m1 == -INFINITY) ? 0.f : __expf(m1 - mm);
            }
            const float lt = l * w0 + l1 * w1;
            const float inv = lt > 0.f ? 1.0f / lt : 0.f;
            bf16_t* Og = (BR == 0) ? p.OS : p.OW;
            bf16_t* op = Og + (size_t)m * 1024 + (g * 4 + hl) * 128 + dh * 64 + 4 * fq;
#pragma unroll
            for (int c = 0; c < 4; ++c) {
                const f32x4 o1 = *(const f32x4*)(mrg + ((pw * 4 + c) * 64 + lane) * 4);
                *(uint2*)(op + 16 * c) = make_uint2(pk2((O[c][0] * w0 + o1[0] * w1) * inv, (O[c][1] * w0 + o1[1] * w1) * inv),
                                                    pk2((O[c][2] * w0 + o1[2] * w1) * inv, (O[c][3] * w0 + o1[3] * w1) * inv));
            }
        }
    }
}


__device__ __forceinline__ void ph_hgrn(const Params& p, int bid, int nb, float* lds, unsigned* qctr = nullptr) {
    const int tid = threadIdx.x, v = tid & 127, kq = tid >> 7;
    float* sq = lds;
    float* sf = lds + 2048;
    float* si = lds + 4096;
    float* so = lds + 6144;
    for (int j = q_next(qctr, -1, bid, nb, (unsigned char*)lds); j < 1024;) {
        const int h = j & 7;
        const size_t mbase = (size_t)MP + (size_t)(j >> 3) * 8;
        const float* s0 = p.state + (size_t)j * 16384;
        float* sout = p.out + O_ST_S + (size_t)j * 16384;
        float S[32];
#pragma unroll
        for (int k = 0; k < 32; ++k) S[k] = s0[(size_t)(kq * 32 + k) * 128 + v];
        const float l0 = p.lb_logits[h * 128 + v], l1 = p.lb_logits[1024 + h * 128 + v];
        const float* rowa = p.PF + (mbase + (tid >> 7)) * NPF + h * 128 + v;
        const float* rowb = rowa + (size_t)4 * NPF;
        const float qa = rowa[C_QB], fa = rowa[C_FB], ia = rowa[C_IB], qb = rowb[C_QB], fb = rowb[C_FB], ib = rowb[C_IB];
        const int jnext = q_next(qctr, j, bid, nb, (unsigned char*)lds);
        {
            const float lb = 1.0f / (1.0f + expf(l1 - l0));
            sq[tid] = qa; sf[tid] = lb + (1.0f - lb) * sigmoidf_(fa); si[tid] = ia;
            sq[tid + NT] = qb; sf[tid + NT] = lb + (1.0f - lb) * sigmoidf_(fb); si[tid + NT] = ib;
        }
        __syncthreads();
#pragma unroll
        for (int tt = 0; tt < 8; ++tt) {
            const float iv = si[tt * 128 + v];
            float o = 0.f;
#pragma unroll
            for (int k = 0; k < 32; ++k) {
                const float f = sf[tt * 128 + kq * 32 + k];
                const float q = sq[tt * 128 + kq * 32 + k];
                S[k] = f * S[k] + (1.0f - f) * iv;
                o += q * S[k];
            }
            so[(tt * 4 + kq) * 128 + v] = o;
        }
        __syncthreads();
#pragma unroll
        for (int r = 0; r < 2; ++r) {
            const int e = tid + r * NT, tt = e >> 7;
            const float* sp = so + tt * 512 + v;
            p.OH[(mbase + tt) * 1024 + h * 128 + v] = (sp[0] + sp[128]) + (sp[256] + sp[384]);
        }
#pragma unroll
        for (int k = 0; k < 32; ++k) sout[(size_t)(kq * 32 + k) * 128 + v] = S[k];
        j = jnext;
    }
}

template <int CTRL> __device__ __forceinline__ float dpp_f(float x) {
    return __int_as_float(__builtin_amdgcn_update_dpp(0, __float_as_int(x), CTRL, 0xf, 0xf, false));
}
__device__ __forceinline__ float row_prefix16(float x) {
    x += dpp_f<0x111>(x); x += dpp_f<0x112>(x); x += dpp_f<0x114>(x); x += dpp_f<0x118>(x);
    return x;
}
__device__ __forceinline__ float row_suffix16(float x) {
    x += dpp_f<0x101>(x); x += dpp_f<0x102>(x); x += dpp_f<0x104>(x); x += dpp_f<0x108>(x);
    return x;
}
__device__ __forceinline__ float fsig(float x) { return __builtin_amdgcn_rcpf(1.0f + __expf(-x)); }
__device__ __forceinline__ float flog2(float x) { return __builtin_amdgcn_logf(x); }
__device__ __forceinline__ float fexp2(float x) { return __builtin_amdgcn_exp2f(x); }
__device__ __forceinline__ float row_last16(float x) {
    return __int_as_float(__builtin_amdgcn_ds_swizzle(__float_as_int(x), 0x1F0));
}

struct ChainCtx {
    size_t mbase; int h, st, kg, sk4, wid, fr, fq; float4 lb4;
};

__device__ __forceinline__ void chain_step(const Params& p, unsigned char* smem, const ChainCtx& c, const int step,
                                           float4& rq, float4& rfraw, float4& ri, pg8::f32x4 (&Sacc)[8]) {
    typedef pg8::bf16x8 bf16x8;
    typedef pg8::f32x4 f32x4;
    typedef short s16x4 __attribute__((ext_vector_type(4)));
    constexpr int BUF = 17408;
    unsigned char* B = smem + (step & 1) * BUF;
    unsigned char* QD = B;
    unsigned char* KH = B + 4096;
    bf16_t* KET = (bf16_t*)(B + 8192);
    bf16_t* VT = (bf16_t*)(B + 12288);
    float* DEND = (float*)(B + 16384);
    const int st = c.st, kg = c.kg, sk4 = c.sk4, wid = c.wid, fr = c.fr, fq = c.fq;
    {
        const float fx = c.lb4.x + (1.0f - c.lb4.x) * fsig(rfraw.x), fy = c.lb4.y + (1.0f - c.lb4.y) * fsig(rfraw.y);
        const float fz = c.lb4.z + (1.0f - c.lb4.z) * fsig(rfraw.z), fw = c.lb4.w + (1.0f - c.lb4.w) * fsig(rfraw.w);
        const float lx = flog2(fx), ly = flog2(fy), lz = flog2(fz), lw = flog2(fw);
        const float bsx = row_prefix16(lx), bsy = row_prefix16(ly), bsz = row_prefix16(lz), bsw = row_prefix16(lw);
        const float ex = row_last16(bsx) - bsx, ey = row_last16(bsy) - bsy, ez = row_last16(bsz) - bsz, ew = row_last16(bsw) - bsw;
        const float kx = 1.0f - fx, ky = 1.0f - fy, kz = 1.0f - fz, kw = 1.0f - fw;
        const unsigned v01 = pk2(ri.x, ri.y), v23 = pk2(ri.z, ri.w);
        VT[(sk4 + 0) * 16 + st] = (bf16_t)(v01 & 0xffffu); VT[(sk4 + 1) * 16 + st] = (bf16_t)(v01 >> 16);
        VT[(sk4 + 2) * 16 + st] = (bf16_t)(v23 & 0xffffu); VT[(sk4 + 3) * 16 + st] = (bf16_t)(v23 >> 16);
        const float dx = fexp2(bsx), dy = fexp2(bsy), dz = fexp2(bsz), dw = fexp2(bsw);
        const unsigned qd0 = pk2(rq.x * dx, rq.y * dy), qd1 = pk2(rq.z * dz, rq.w * dw);
        const unsigned kh0 = pk2(kx * fexp2(fminf(-bsx, 115.4f)), ky * fexp2(fminf(-bsy, 115.4f)));
        const unsigned kh1 = pk2(kz * fexp2(fminf(-bsz, 115.4f)), kw * fexp2(fminf(-bsw, 115.4f)));
        const unsigned ke0 = pk2(kx * fexp2(ex), ky * fexp2(ey));
        const unsigned ke1 = pk2(kz * fexp2(ez), kw * fexp2(ew));
        const unsigned off = (unsigned)st * 256u + ((((unsigned)kg >> 1) ^ (unsigned)st) << 4) + 8u * ((unsigned)kg & 1u);
        *(uint2*)(QD + off) = make_uint2(qd0, qd1);
        *(uint2*)(KH + off) = make_uint2(kh0, kh1);
        KET[(sk4 + 0) * 16 + st] = (bf16_t)(ke0 & 0xffffu); KET[(sk4 + 1) * 16 + st] = (bf16_t)(ke0 >> 16);
        KET[(sk4 + 2) * 16 + st] = (bf16_t)(ke1 & 0xffffu); KET[(sk4 + 3) * 16 + st] = (bf16_t)(ke1 >> 16);
        if (st == 15) *(float4*)(DEND + sk4) = make_float4(dx, dy, dz, dw);
    }
    __syncthreads();
    if (step + 2 < 128) {
        const float* row = p.PF + (c.mbase + (size_t)(step + 2) * 16 + st) * NPF + c.h * 128 + sk4;
        rq = *(const float4*)(row + C_QB); rfraw = *(const float4*)(row + C_FB); ri = *(const float4*)(row + C_IB);
    }
    const s16x4 vv = *(const s16x4*)(VT + (16 * wid + fr) * 16 + 4 * fq);
    s16x4 Kef[8];
    f32x4 d4[8];
#pragma unroll
    for (int kt = 0; kt < 8; ++kt) {
        Kef[kt] = *(const s16x4*)(KET + (16 * kt + fr) * 16 + 4 * fq);
        d4[kt] = *(const f32x4*)(DEND + 16 * kt + 4 * fq);
    }
    f32x4 oacc = (f32x4){0.f, 0.f, 0.f, 0.f};
#pragma unroll
    for (int ks = 0; ks < 4; ++ks) {
        const unsigned c0 = (unsigned)(4 * ks + (fq >> 1)), c1 = c0 + 2u;
        const s16x4 qa = *(const s16x4*)(QD + fr * 256 + ((c0 ^ (unsigned)fr) << 4) + 8 * (fq & 1));
        const s16x4 qb = *(const s16x4*)(QD + fr * 256 + ((c1 ^ (unsigned)fr) << 4) + 8 * (fq & 1));
        const bf16x8 Qp = {qa[0], qa[1], qa[2], qa[3], qb[0], qb[1], qb[2], qb[3]};
        union { unsigned u[4]; bf16x8 v; } sv;
        sv.u[0] = pk2(Sacc[2 * ks][0], Sacc[2 * ks][1]); sv.u[1] = pk2(Sacc[2 * ks][2], Sacc[2 * ks][3]);
        sv.u[2] = pk2(Sacc[2 * ks + 1][0], Sacc[2 * ks + 1][1]); sv.u[3] = pk2(Sacc[2 * ks + 1][2], Sacc[2 * ks + 1][3]);
        oacc = __builtin_amdgcn_mfma_f32_16x16x32_bf16(Qp, sv.v, oacc, 0, 0, 0);
    }
    f32x4 A = (f32x4){0.f, 0.f, 0.f, 0.f};
#pragma unroll
    for (int ks = 0; ks < 4; ++ks) {
        const unsigned o16 = (unsigned)fr * 256u + ((((unsigned)(4 * ks + fq)) ^ (unsigned)fr) << 4);
        const bf16x8 Khf = *(const bf16x8*)(KH + o16);
        const bf16x8 Qdf = *(const bf16x8*)(QD + o16);
        A = __builtin_amdgcn_mfma_f32_16x16x32_bf16(Khf, Qdf, A, 0, 0, 0);
    }
    {
        union { unsigned u[2]; s16x4 v; } av;
        av.u[0] = pk2((4 * fq + 0 <= fr) ? A[0] : 0.f, (4 * fq + 1 <= fr) ? A[1] : 0.f);
        av.u[1] = pk2((4 * fq + 2 <= fr) ? A[2] : 0.f, (4 * fq + 3 <= fr) ? A[3] : 0.f);
        oacc = __builtin_amdgcn_mfma_f32_16x16x16bf16_1k(av.v, vv, oacc, 0, 0, 0);
    }
    {
        float* op = p.OH + (c.mbase + (size_t)step * 16 + 4 * fq) * 1024 + c.h * 128 + 16 * wid + fr;
        op[0] = oacc[0]; op[1024] = oacc[1]; op[2048] = oacc[2]; op[3072] = oacc[3];
    }
#pragma unroll
    for (int kt = 0; kt < 8; ++kt) {
        Sacc[kt] = Sacc[kt] * d4[kt];
        Sacc[kt] = __builtin_amdgcn_mfma_f32_16x16x16bf16_1k(Kef[kt], vv, Sacc[kt], 0, 0, 0);
    }
}

__device__ __forceinline__ void ph_hgrn_chain(const Params& p, int item, unsigned char* smem) {
    typedef pg8::f32x4 f32x4;
    const int tid = threadIdx.x, lane = tid & 63;
    ChainCtx c;
    c.wid = tid >> 6; c.fr = lane & 15; c.fq = lane >> 4;
    const int n = item >> 3;
    c.h = item & 7;
    c.mbase = (size_t)n * 2048;
    c.st = tid & 15; c.kg = tid >> 4; c.sk4 = c.kg * 4;
    {
        const float4 l0 = *(const float4*)&p.lb_logits[c.h * 128 + c.sk4], l1 = *(const float4*)&p.lb_logits[1024 + c.h * 128 + c.sk4];
        c.lb4 = make_float4(1.0f / (1.0f + expf(l1.x - l0.x)), 1.0f / (1.0f + expf(l1.y - l0.y)), 1.0f / (1.0f + expf(l1.z - l0.z)), 1.0f / (1.0f + expf(l1.w - l0.w)));
    }
    f32x4 Sacc[8];
#pragma unroll
    for (int kt = 0; kt < 8; ++kt) Sacc[kt] = (f32x4){0.f, 0.f, 0.f, 0.f};
    float4 q0, f0, i0, q1, f1, i1;
    {
        const float* row = p.PF + (c.mbase + c.st) * NPF + c.h * 128 + c.sk4;
        q0 = *(const float4*)(row + C_QB); f0 = *(const float4*)(row + C_FB); i0 = *(const float4*)(row + C_IB);
        row += (size_t)16 * NPF;
        q1 = *(const float4*)(row + C_QB); f1 = *(const float4*)(row + C_FB); i1 = *(const float4*)(row + C_IB);
    }
    __syncthreads();
    for (int s2 = 0; s2 < 128; s2 += 2) {
        chain_step(p, smem, c, s2, q0, f0, i0, Sacc);
        chain_step(p, smem, c, s2 + 1, q1, f1, i1, Sacc);
    }
    float* so = p.out + O_ST_P + (size_t)item * 16384;
#pragma unroll
    for (int kt = 0; kt < 8; ++kt)
#pragma unroll
        for (int i = 0; i < 4; ++i) so[(size_t)(16 * kt + 4 * c.fq + i) * 128 + 16 * c.wid + c.fr] = Sacc[kt][i];
    __syncthreads();
}

__device__ __forceinline__ void ph_combine(const Params& p, int bid, int nb, int m_begin, int m_end) {
    const int lane = threadIdx.x & 63, wave = threadIdx.x >> 6;
    const int gw = bid * 8 + wave, ngw = nb * 8;
    const int c0 = lane * 16, hd = lane >> 3;
    float4 gov[4];
#pragma unroll
    for (int j = 0; j < 4; ++j) gov[j] = *(const float4*)&p.g_o[(c0 & 127) + 4 * j];
    for (int m = m_begin + gw; m < m_end; m += ngw) {
        const bf16_t* row = p.PH + (size_t)m * LDH;
        float4 oc[4], os[4], ow[4], oh[4], za[4], zb[4];
#pragma unroll
        for (int j = 0; j < 4; ++j) {
            const uint2 c2 = *(const uint2*)&p.OC[(size_t)m * 1024 + c0 + 4 * j], s2 = *(const uint2*)&p.OS[(size_t)m * 1024 + c0 + 4 * j];
            const uint2 w2 = *(const uint2*)&p.OW[(size_t)m * 1024 + c0 + 4 * j];
            oc[j] = make_float4(__uint_as_float(c2.x << 16), __uint_as_float(c2.x & 0xffff0000u), __uint_as_float(c2.y << 16), __uint_as_float(c2.y & 0xffff0000u));
            os[j] = make_float4(__uint_as_float(s2.x << 16), __uint_as_float(s2.x & 0xffff0000u), __uint_as_float(s2.y << 16), __uint_as_float(s2.y & 0xffff0000u));
            ow[j] = make_float4(__uint_as_float(w2.x << 16), __uint_as_float(w2.x & 0xffff0000u), __uint_as_float(w2.y << 16), __uint_as_float(w2.y & 0xffff0000u));
            oh[j] = *(const float4*)&p.OH[(size_t)m * 1024 + c0 + 4 * j];
            za[j] = bf4(*(const uint2*)&row[C_ZA + c0 + 4 * j]);
            zb[j] = bf4(*(const uint2*)&row[C_ZB + c0 + 4 * j]);
        }
        const float gc = p.GATE[(size_t)m * 24 + hd], gs = p.GATE[(size_t)m * 24 + 8 + hd], gw_ = p.GATE[(size_t)m * 24 + 16 + hd];
        float ss = 0.f;
#pragma unroll
        for (int j = 0; j < 4; ++j) ss += oh[j].x * oh[j].x + oh[j].y * oh[j].y + oh[j].z * oh[j].z + oh[j].w * oh[j].w;
        ss += __shfl_xor(ss, 1, 64); ss += __shfl_xor(ss, 2, 64); ss += __shfl_xor(ss, 4, 64);
        const float rr = rsqrtf(ss * (1.0f / 128) + EPS);
        uint2 a[4], bq[4];
#pragma unroll
        for (int j = 0; j < 4; ++j) {
            const float4 go = gov[j];
            a[j].x = pk2((gc * oc[j].x + gs * os[j].x + gw_ * ow[j].x) * siluf_(za[j].x), (gc * oc[j].y + gs * os[j].y + gw_ * ow[j].y) * siluf_(za[j].y));
            a[j].y = pk2((gc * oc[j].z + gs * os[j].z + gw_ * ow[j].z) * siluf_(za[j].z), (gc * oc[j].w + gs * os[j].w + gw_ * ow[j].w) * siluf_(za[j].w));
            bq[j].x = pk2(oh[j].x * rr * go.x * siluf_(zb[j].x), oh[j].y * rr * go.y * siluf_(zb[j].y));
            bq[j].y = pk2(oh[j].z * rr * go.z * siluf_(zb[j].z), oh[j].w * rr * go.w * siluf_(zb[j].w));
        }
        uint4* oa = (uint4*)&p.MIXb[(size_t)m * 2048 + c0];
        uint4* ob = (uint4*)&p.MIXb[(size_t)m * 2048 + 1024 + c0];
        oa[0] = make_uint4(a[0].x, a[0].y, a[1].x, a[1].y); oa[1] = make_uint4(a[2].x, a[2].y, a[3].x, a[3].y);
        ob[0] = make_uint4(bq[0].x, bq[0].y, bq[1].x, bq[1].y); ob[1] = make_uint4(bq[2].x, bq[2].y, bq[3].x, bq[3].y);
    }
}

__global__ void __launch_bounds__(NT, 2) k_mega(Params p) {
    extern __shared__ __attribute__((aligned(16))) unsigned char smem[];
    float* lds = (float*)smem;
    volatile LAS unsigned* misc = (volatile LAS unsigned*)(smem + LDS_STAGE);
    if (threadIdx.x == 0) { misc[0] = 0u; misc[1] = 0u; }
    __syncthreads();
    XcdBarrier bar = xcd_barrier_post(p.bar, misc);
    const int bid = blockIdx.x, nb = gridDim.x;
#define PH0 { ph_prologue(p, bid, nb, lds); xcd_barrier(bar); }
#define PH1 { if (bid < nb - 32 || nb <= 64) { const int gg = (nb > 64) ? nb - 32 : nb; \
                pg8::Gemm g{p.Hb, p.Wt_in, M, LDP, D}; pg8::StaticOrder S; S.init(M, LDP, gg, bid); pg8::EpiMix E{p.PF, p.PH, LDH}; \
                pg8::gemm_phase<pg8::EpiMix, pg8::StaticOrder>((PG8_LAS unsigned char*)smem, g, S, E); \
                if (threadIdx.x == 0) (void)__hip_atomic_fetch_add(&p.ctr[64], 1u, __ATOMIC_RELAXED, __HIP_MEMORY_SCOPE_AGENT); } \
              else { ph_cmp_mfma(p, 512, true, smem, P1_MAXU); } \
              xcd_barrier(bar); }
#define PH2 { ph_post(p, bid, nb); xcd_barrier(bar); }
#define PH3 { if (bid < 32 && nb > 64) { ph_hgrn_chain(p, bid, smem); } \
              else if (nb <= 64) { for (int it = bid; it < 32; it += nb) ph_hgrn_chain(p, it, smem); } \
                \
              ph_cmp_mfma(p, NSEQ * 4, false, smem); __syncthreads(); \
              ph_attn_prompt<1>(p, bid, nb, smem, p.ctr + 1); __syncthreads(); \
              ph_attn_sample<1>(p, bid, nb, smem, p.ctr + 2); __syncthreads(); \
              ph_hgrn(p, bid, nb, lds, p.ctr + 3); \
              xcd_barrier(bar); }
#define PH5 { ph_cmp_attn_mfma(p, bid, nb, smem); xcd_barrier(bar); }
#define PH6 {   \
              if (bid & 1) { ph_attn_prompt<0>(p, bid, nb, smem); __syncthreads(); ph_attn_sample<0>(p, bid, nb, smem); } \
              else { ph_attn_sample<0>(p, bid, nb, smem); __syncthreads(); ph_attn_prompt<0>(p, bid, nb, smem); } \
              xcd_barrier(bar); }
#define PH7A { ph_combine(p, bid, nb, MP, M); xcd_barrier(bar); }
#define PH7B { if (bid < 32 && nb > 64) {   \
                 pg8::Gemm g{p.MIXb + (size_t)MP * 2048, p.Wt_out, MS, D, 2048}; pg8::StaticOrder S; S.init(MS, D, 32, bid); \
                 pg8::EpiResF32S E{p.out + O_YS, p.x_sample}; \
                 pg8::gemm_phase<pg8::EpiResF32S, pg8::StaticOrder>((PG8_LAS unsigned char*)smem, g, S, E); } \
               else { const int rb = (nb > 64) ? bid - 32 : bid, rnb = (nb > 64) ? nb - 32 : nb; \
                 ph_combine(p, rb, rnb, 0, MP); } \
               __syncthreads(); ph_wincopy(p, bid, nb, smem, p.ctr + 4);   \
               xcd_barrier(bar); }
#define PH8 { if (nb > 64) { pg8::Gemm g{p.MIXb, p.Wt_out, MP, D, 2048}; pg8::StaticOrder S; S.init(MP, D, nb, bid); pg8::EpiResF32 E{p.out, p.x_prompt, p.x_sample}; \
                pg8::gemm_phase<pg8::EpiResF32, pg8::StaticOrder>((PG8_LAS unsigned char*)smem, g, S, E); } \
              else { pg8::Gemm g{p.MIXb, p.Wt_out, M, D, 2048}; pg8::StaticOrder S; S.init(M, D, nb, bid); pg8::EpiResF32 E{p.out, p.x_prompt, p.x_sample}; \
                pg8::gemm_phase<pg8::EpiResF32, pg8::StaticOrder>((PG8_LAS unsigned char*)smem, g, S, E); } }
    PH0
#if (PROBE_MASK >> 0) & 1
    PH0
#endif
    PH1
#if (PROBE_MASK >> 1) & 1
    PH1
#endif
    PH2
#if (PROBE_MASK >> 2) & 1
    PH2
#endif
    PH3
#if (PROBE_MASK >> 3) & 1
    PH3
#endif
    PH5
#if (PROBE_MASK >> 5) & 1
    PH5
#endif
    PH6
#if (PROBE_MASK >> 6) & 1
    PH6
#endif
    PH7A
    PH7B
#if (PROBE_MASK >> 8) & 1
    PH8
    xcd_barrier(bar);
#endif
    PH8
}

}

extern "C" void kernel_launch(void* const* d_in, const int* in_sizes, int n_in, void* d_out,
                              int out_size, void* d_ws, size_t ws_size, hipStream_t stream) {
    (void)in_sizes; (void)n_in; (void)out_size; (void)ws_size;
    Params p{};
    p.x_prompt = (const float*)d_in[0];
    p.x_sample = (const float*)d_in[1];
    p.cache_cmp = (const float*)d_in[2];
    p.cache_slc = (const float*)d_in[3];
    p.cache_win = (const float*)d_in[4];
    p.state = (const float*)d_in[5];
    p.page_table = (const int*)d_in[6];
    p.g_norm = (const float*)d_in[7];
    p.w_in = (const float*)d_in[8];
    p.w_out = (const float*)d_in[9];
    p.g_q = (const float*)d_in[10];
    p.g_k_slc = (const float*)d_in[11];
    p.g_k_win = (const float*)d_in[12];
    p.g_k_cmp = (const float*)d_in[13];
    p.w_cmp_k = (const float*)d_in[14];
    p.w_cmp_v = (const float*)d_in[15];
    p.pe_k = (const float*)d_in[16];
    p.pe_v = (const float*)d_in[17];
    p.rel_bias = (const float*)d_in[18];
    p.lb_logits = (const float*)d_in[19];
    p.g_o = (const float*)d_in[20];
    p.out = (float*)d_out;
    float* ws = (float*)d_ws;
    size_t off = 0;
    auto take = [&](size_t nfloats) { float* r = ws + off; off += (nfloats + 63) & ~(size_t)63; return r; };
    p.bar = (unsigned*)take(XCD_BAR_WORDS + 128);
    p.ctr = p.bar + XCD_BAR_WORDS;
    p.Hb = (bf16_t*)take((size_t)M * D / 2);
    p.Wt_in = (bf16_t*)take((size_t)LDP * D / 2);
    p.Wt_out = (bf16_t*)take((size_t)D * 2048 / 2);
    p.MIXb = (bf16_t*)take((size_t)M * 2048 / 2);
    p.Wc_t = (bf16_t*)take((size_t)2 * 256 * 2048 / 2);
    p.PEB = take(64 * 128);
    p.Qb = (bf16_t*)take((size_t)M * 1024 / 2);
    p.KVb = (bf16_t*)take((size_t)2 * 2 * 4 * 2 * 2048 * 128 / 2);
    p.PF = take((size_t)M * NPF);
    p.PH = (bf16_t*)take((size_t)M * LDH / 2);
    p.KCb = (bf16_t*)take((size_t)NSEQ * 2 * 128 * 128 / 2);
    p.VCb = (bf16_t*)take((size_t)NSEQ * 2 * 128 * 128 / 2);
    p.OC = (bf16_t*)take((size_t)M * 1024 / 2);
    p.OS = (bf16_t*)take((size_t)M * 1024 / 2);
    p.OW = (bf16_t*)take((size_t)M * 1024 / 2);
    p.OH = take((size_t)M * 1024);
    p.GATE = take((size_t)M * 24);
    p.SEL = (unsigned long long*)take((size_t)M * 2 * 2);

    static int grid = 0;
    if (!grid) {
        int dev = 0, cus = 0;
        (void)hipGetDevice(&dev);
        (void)hipDeviceGetAttribute(&cus, hipDeviceAttributeMultiprocessorCount, dev);
        (void)hipFuncSetAttribute((const void*)k_mega, hipFuncAttributeMaxDynamicSharedMemorySize, LDS_BYTES);
        grid = cus > 0 ? cus : 256;
    }
    (void)hipMemsetAsync(p.bar, 0, (XCD_BAR_WORDS + 128) * sizeof(unsigned), stream);
    hipLaunchKernelGGL(k_mega, dim3(grid), dim3(NT), LDS_BYTES, stream, p);
}
```

```cpp
#include <hip/hip_runtime.h>
#include <stdint.h>
#include <stdio.h>

#define XB_TMO      128
#define XB_XCNT(j)  (256  + 64 * (j))
#define XB_XSUB(j)  (1280 + 64 * (j))
#define XB_XGEN(j)  (2304 + 64 * (j))
#define XB_TOP      3328
#define XB_TOPGEN   3392
#define XCD_BAR_WORDS 3456
#define XB_SPIN_CAP (1u << 18)
#define LAS __attribute__((address_space(3)))

__device__ __forceinline__ unsigned xb_ld(unsigned* p)              { return __hip_atomic_load(p, __ATOMIC_RELAXED, __HIP_MEMORY_SCOPE_AGENT); }
__device__ __forceinline__ unsigned xb_add(unsigned* p, unsigned v) { return __hip_atomic_fetch_add(p, v, __ATOMIC_RELAXED, __HIP_MEMORY_SCOPE_AGENT); }
__device__ __forceinline__ unsigned xb_xcc_id() { return (unsigned)__builtin_amdgcn_s_getreg((3 << 11) | 20) & 0xFu; }
#define XB_SPIN(cond, bar) do { unsigned _sp = 0; while (cond) { __builtin_amdgcn_s_sleep(1); \
    if ((++_sp & 255u) == 0u) { if (xb_ld(&(bar)[XB_TMO])) break; if (_sp > XB_SPIN_CAP) { atomicAdd(&(bar)[XB_TMO], 1u); break; } } } } while (0)

struct XcdBarrier {
    unsigned* bar; unsigned x;
    volatile LAS unsigned* st;
};

__device__ __forceinline__ XcdBarrier xcd_barrier_post(unsigned* bar, volatile LAS unsigned* st) {
    XcdBarrier b; b.bar = bar; b.x = xb_xcc_id(); b.st = st;
    if (threadIdx.x == 0) (void)xb_add(&bar[XB_XCNT(b.x)], 1u);
    return b;
}
__device__ __forceinline__ void xcd_barrier_complete(unsigned* bar, unsigned x, unsigned& nloc, unsigned& nx) {
    const unsigned G = gridDim.x * gridDim.y * gridDim.z;
    unsigned sum, cnt, mine, sp = 0u;
    for (;;) {
        sum = 0u; cnt = 0u; mine = 0u;
#pragma unroll
        for (unsigned j = 0; j < 16; ++j) { const unsigned c = xb_ld(&bar[XB_XCNT(j)]); sum += c; cnt += (c > 0u) ? 1u : 0u; mine = (j == x) ? c : mine; }
        if (sum == G) break;
        __builtin_amdgcn_s_sleep(1);
        if ((++sp & 255u) == 0u) { if (xb_ld(&bar[XB_TMO])) break; if (sp > XB_SPIN_CAP) { atomicAdd(&bar[XB_TMO], 1u); break; } }
    }
    nloc = mine > 0u ? mine : 1u; nx = cnt > 0u ? cnt : 1u;
}
__device__ __forceinline__ void xcd_barrier(const XcdBarrier& b) {
    asm volatile("s_waitcnt vmcnt(0)" ::: "memory");
    __syncthreads();
    if (threadIdx.x == 0) {
        unsigned* bar = b.bar;
        __builtin_amdgcn_s_waitcnt(0);
        unsigned nloc = b.st[0], nx = b.st[1];
        if (nloc == 0u) { xcd_barrier_complete(bar, b.x, nloc, nx); b.st[0] = nloc; b.st[1] = nx; }
        const unsigned old = xb_add(&bar[XB_XSUB(b.x)], 1u);
        const unsigned gen = old / nloc;
        if (old + 1u == (gen + 1u) * nloc) {
            __builtin_amdgcn_fence(__ATOMIC_RELEASE, "agent");
            asm volatile("s_waitcnt vmcnt(0)" ::: "memory");
            const unsigned og = xb_add(&bar[XB_TOP], 1u);
            const unsigned tg = og / nx;
            if (og + 1u == (tg + 1u) * nx) xb_add(&bar[XB_TOPGEN], 1u);
            else XB_SPIN(xb_ld(&bar[XB_TOPGEN]) == tg, bar);
            __builtin_amdgcn_fence(__ATOMIC_ACQUIRE, "agent");
            xb_add(&bar[XB_XGEN(b.x)], 1u);
            asm volatile("s_waitcnt vmcnt(0)" ::: "memory");
        } else {
            XB_SPIN(xb_ld(&bar[XB_XGEN(b.x)]) == gen, bar);
            __builtin_amdgcn_fence(__ATOMIC_ACQUIRE, "agent");
            asm volatile("s_waitcnt vmcnt(0)" ::: "memory");
        }
    }
    __syncthreads();
}


namespace pg8 {
#define PG8_LAS __attribute__((address_space(3)))
typedef unsigned short bf16_t;
typedef short bf16x8 __attribute__((ext_vector_type(8)));
typedef float f32x4 __attribute__((ext_vector_type(4)));
typedef unsigned u32x4 __attribute__((ext_vector_type(4)));
constexpr int BM = 256, BK = 64, HALF = 128, HTB = HALF * BK * 2, STAGE_BYTES = 8 * HTB, NXCD = 8, WGM = 4;

__host__ __device__ __forceinline__ int lds_byte(int r, int c) { const int st = (r >> 4) * 2 + (c >> 5), rr = r & 15, cc = c & 31, ob = rr * 64 + cc * 2; return st * 1024 + (ob ^ (((ob >> 9) & 1) << 5)); }
__host__ __device__ __forceinline__ void stage_rc(int b, int& R, int& C) { const int st = b / 1024, sb = b % 1024, swz = sb ^ (((sb >> 9) & 1) << 5); R = (st >> 1) * 16 + swz / 64; C = (st & 1) * 32 + (swz % 64) / 2; }
__host__ __device__ __forceinline__ int perm32(int rho) { const int n = rho >> 4, i = rho & 15; return 8 * (i >> 2) + 4 * n + (i & 3); }

struct Unit { int pm, pn; };
struct Gemm { const bf16_t* A; const bf16_t* Bt; int M, N, K; };

struct StaticOrder {
    int nM, nN, nwg, G, c;
    __host__ __device__ void init(int M, int N, int G_, int c_) { nM = M / BM; nN = N / BM; nwg = nM * nN; G = G_; c = c_; }
    __host__ __device__ bool next(int i, Unit& u) const {
        const long L = (long)i * G + c; if (L >= nwg) return false;
        int wgid = (int)L; { const int q = nwg / NXCD, r = nwg % NXCD, xcd = wgid % NXCD, off = wgid / NXCD; wgid = (xcd < r ? xcd * (q + 1) : r * (q + 1) + (xcd - r) * q) + off; }
        const int nig = WGM * nN, gid = wgid / nig, fm = gid * WGM, gsz = (nM - fm) < WGM ? (nM - fm) : WGM;
        u.pm = fm + ((wgid % nig) % gsz); u.pn = (wgid % nig) / gsz; return true;
    }
    __device__ __forceinline__ void a_ready(const Unit&) const {}
    __device__ __forceinline__ void done(const Unit&) const {}
};

__device__ __forceinline__ unsigned cvt_pk_bf16(float lo, float hi) { unsigned r; asm volatile("v_cvt_pk_bf16_f32 %0, %1, %2" : "=v"(r) : "v"(lo), "v"(hi)); return r; }

struct EpiF32 {
    static constexpr bool PERM = false, AFTER_DRAIN = false;
    float* C; int ldc;
    __device__ __forceinline__ void operator()(const f32x4 (&acc)[2][2][4][2], const Unit& u, int wr, int wc, int fr, int fq) const {
        const int row0 = u.pm * BM + wr * 64 + fr, col0 = u.pn * BM + wc * 32 + 4 * fq;
#pragma unroll
        for (int ai = 0; ai < 2; ++ai)
#pragma unroll
            for (int m = 0; m < 4; ++m) { float* rowp = C + (size_t)(row0 + ai * HALF + m * 16) * ldc + col0;
#pragma unroll
                for (int bj = 0; bj < 2; ++bj)
#pragma unroll
                    for (int n = 0; n < 2; ++n) *(f32x4*)(rowp + bj * HALF + n * 16) = acc[ai][bj][m][n]; }
    }
};
struct EpiMix {
    static constexpr bool PERM = true, AFTER_DRAIN = false;
    float* F; bf16_t* H; int ldh;
    __device__ __forceinline__ void operator()(const f32x4 (&acc)[2][2][4][2], const Unit& u, int wr, int wc, int fr, int fq) const {
        const int row0 = u.pm * BM + wr * 64 + fr;
        if (u.pn < 12) {
            const int col0 = u.pn * BM + wc * 32 + 8 * fq;
#pragma unroll
            for (int ai = 0; ai < 2; ++ai)
#pragma unroll
                for (int m = 0; m < 4; ++m) { float* rowp = F + (size_t)(row0 + ai * HALF + m * 16) * 3072 + col0;
#pragma unroll
                    for (int bj = 0; bj < 2; ++bj) { *(f32x4*)(rowp + bj * HALF) = acc[ai][bj][m][0]; *(f32x4*)(rowp + bj * HALF + 4) = acc[ai][bj][m][1]; } }
        } else {
            const int col0 = (u.pn - 12) * BM + wc * 32 + 8 * fq;
#pragma unroll
            for (int ai = 0; ai < 2; ++ai)
#pragma unroll
                for (int m = 0; m < 4; ++m) { bf16_t* rowp = H + (size_t)(row0 + ai * HALF + m * 16) * ldh + col0;
#pragma unroll
                    for (int bj = 0; bj < 2; ++bj) { const f32x4 v0 = acc[ai][bj][m][0], v1 = acc[ai][bj][m][1];
                        u32x4 w; w.x = cvt_pk_bf16(v0[0], v0[1]); w.y = cvt_pk_bf16(v0[2], v0[3]); w.z = cvt_pk_bf16(v1[0], v1[1]); w.w = cvt_pk_bf16(v1[2], v1[3]);
                        *(u32x4*)(rowp + bj * HALF) = w; } }
        }
    }
};
#define PG8_RES_LD(q, dst, XROW) { const int ai_ = (q) >> 2, m_ = (q) & 3; const int r_ = row0 + ai_ * HALF + m_ * 16; const float* xr_ = (XROW) + col0; \
        dst[0] = *(const f32x4*)(xr_); dst[1] = *(const f32x4*)(xr_ + 16); dst[2] = *(const f32x4*)(xr_ + HALF); dst[3] = *(const f32x4*)(xr_ + HALF + 16); }
#define PG8_RES_ST(q, src) { const int ai_ = (q) >> 2, m_ = (q) & 3; const int r_ = row0 + ai_ * HALF + m_ * 16; float* rowp_ = C + (size_t)r_ * 2048 + col0; \
        *(f32x4*)(rowp_) = acc[ai_][0][m_][0] + src[0]; *(f32x4*)(rowp_ + 16) = acc[ai_][0][m_][1] + src[1]; \
        *(f32x4*)(rowp_ + HALF) = acc[ai_][1][m_][0] + src[2]; *(f32x4*)(rowp_ + HALF + 16) = acc[ai_][1][m_][1] + src[3]; }
#define PG8_RES_BODY(XROWF) \
        f32x4 xa0[4], xa1[4], xb0[4], xb1[4]; \
        PG8_RES_LD(0, xa0, XROWF(r_)) PG8_RES_LD(1, xa1, XROWF(r_)) PG8_RES_LD(2, xb0, XROWF(r_)) PG8_RES_LD(3, xb1, XROWF(r_)) \
        PG8_RES_ST(0, xa0) PG8_RES_ST(1, xa1) \
        PG8_RES_LD(4, xa0, XROWF(r_)) PG8_RES_LD(5, xa1, XROWF(r_)) \
        PG8_RES_ST(2, xb0) PG8_RES_ST(3, xb1) \
        PG8_RES_LD(6, xb0, XROWF(r_)) PG8_RES_LD(7, xb1, XROWF(r_)) \
        PG8_RES_ST(4, xa0) PG8_RES_ST(5, xa1) PG8_RES_ST(6, xb0) PG8_RES_ST(7, xb1)
struct EpiResF32 {
    static constexpr bool PERM = false, AFTER_DRAIN = false;
    float* C; const float* xp; const float* xs;
    __device__ __forceinline__ void operator()(const f32x4 (&acc)[2][2][4][2], const Unit& u, int wr, int wc, int fr, int fq) const {
        const int row0 = u.pm * BM + wr * 64 + fr, col0 = u.pn * BM + wc * 32 + 4 * fq;
#define PG8_XROW_A(r) ((r) < 8192 ? xp + (size_t)(r) * 2048 : xs + (size_t)((r) - 8192) * 2048)
        PG8_RES_BODY(PG8_XROW_A)
#undef PG8_XROW_A
    }
};

struct EpiResF32S {
    static constexpr bool PERM = false, AFTER_DRAIN = false;
    float* C; const float* x;
    __device__ __forceinline__ void operator()(const f32x4 (&acc)[2][2][4][2], const Unit& u, int wr, int wc, int fr, int fq) const {
        const int row0 = u.pm * BM + wr * 64 + fr, col0 = u.pn * BM + wc * 32 + 4 * fq;
#define PG8_XROW_S(r) (x + (size_t)(r) * 2048)
        PG8_RES_BODY(PG8_XROW_S)
#undef PG8_XROW_S
    }
};
#undef PG8_RES_BODY
#undef PG8_RES_ST
#undef PG8_RES_LD

template <class Epi, class Sched>
__device__ __forceinline__ void gemm_phase(PG8_LAS unsigned char* lds, const Gemm g, const Sched& S, const Epi& E) {
    const int tid = threadIdx.x, wid = __builtin_amdgcn_readfirstlane(tid >> 6), lane = tid & 63, wr = wid >> 2, wc = wid & 3, fr = lane & 15, fq = lane >> 4;
    const int K = g.K, nt = K / BK;
    unsigned voffA[2], voffB[2];
#pragma unroll
    for (int i = 0; i < 2; ++i) { int R, C; stage_rc(tid * 16 + i * 8192, R, C); const int Rb = Epi::PERM ? ((R & ~31) + perm32(R & 31)) : R;
        voffA[i] = (unsigned)(R * K + C) * 2u; voffB[i] = (unsigned)(Rb * K + C) * 2u; }
    const size_t kstep = (size_t)(BK * 2);
    const size_t hstep = (size_t)HALF * K * 2;
    const size_t tstep = 2 * hstep;
    const unsigned ldsw = (unsigned)wid * 1024u;
    const int aoff = lds_byte(wr * 64 + fr, fq * 8), boff = lds_byte(wc * 32 + fr, fq * 8);
#define PG8_SA(b, h) (((b) * 2 + (h)) * HTB)
#define PG8_SB(b, h) ((4 + (b) * 2 + (h)) * HTB)
#define PG8_STAGE(bufoff, gbase, voff) do { _Pragma("unroll") for (int _i = 0; _i < 2; ++_i) \
        __builtin_amdgcn_global_load_lds((const unsigned*)((const char*)(gbase) + (voff)[_i]), (PG8_LAS unsigned*)(lds + (bufoff) + ldsw + _i * 8192), 16, 0, 0); } while (0)
#define PG8_LDA(dst, b, h) do { _Pragma("unroll") for (int m = 0; m < 4; ++m) _Pragma("unroll") for (int k = 0; k < 2; ++k) dst[m][k] = *(const PG8_LAS bf16x8*)(lds + PG8_SA(b, h) + aoff + m * 2048 + k * 1024); } while (0)
#define PG8_LDB(dst, b, h) do { _Pragma("unroll") for (int n = 0; n < 2; ++n) _Pragma("unroll") for (int k = 0; k < 2; ++k) dst[n][k] = *(const PG8_LAS bf16x8*)(lds + PG8_SB(b, h) + boff + n * 2048 + k * 1024); } while (0)
#define PG8_MMA(ai, bj, At, Bt) do { __builtin_amdgcn_s_setprio(1); _Pragma("unroll") for (int m = 0; m < 4; ++m) _Pragma("unroll") for (int n = 0; n < 2; ++n) _Pragma("unroll") for (int k = 0; k < 2; ++k) \
        acc[ai][bj][m][n] = __builtin_amdgcn_mfma_f32_16x16x32_bf16(Bt[n][k], At[m][k], acc[ai][bj][m][n], 0, 0, 0); __builtin_amdgcn_s_setprio(0); } while (0)
#define PG8_WAIT_V(n) asm volatile("s_waitcnt vmcnt(" #n ")" ::: "memory")
#define PG8_WAIT_L(n) asm volatile("s_waitcnt lgkmcnt(" #n ")" ::: "memory")
#define PG8_BAR __builtin_amdgcn_s_barrier()
#define PG8_SCHED __builtin_amdgcn_sched_barrier(0)
    Unit cur, nxt; int ui = 0;
    if (!S.next(0, cur)) return;
    f32x4 acc[2][2][4][2];
#pragma unroll
    for (int a = 0; a < 2; ++a)
#pragma unroll
        for (int b = 0; b < 2; ++b)
#pragma unroll
            for (int m = 0; m < 4; ++m)
#pragma unroll
                for (int n = 0; n < 2; ++n) acc[a][b][m][n] = (f32x4){0.f, 0.f, 0.f, 0.f};
    bf16x8 At[4][2], B0[2][2], B1[2][2];
    const char* cA = (const char*)g.A + (size_t)cur.pm * tstep; const char* cB = (const char*)g.Bt + (size_t)cur.pn * tstep;
    S.a_ready(cur);
    PG8_STAGE(PG8_SB(0, 0), cB, voffB); PG8_STAGE(PG8_SA(0, 0), cA, voffA); PG8_STAGE(PG8_SB(0, 1), cB + hstep, voffB); PG8_STAGE(PG8_SA(0, 1), cA + hstep, voffA);
    if (wr == 1) PG8_BAR;
    PG8_WAIT_V(4); PG8_BAR;
    PG8_STAGE(PG8_SB(1, 0), cB + kstep, voffB); PG8_STAGE(PG8_SA(1, 0), cA + kstep, voffA); PG8_STAGE(PG8_SB(1, 1), cB + hstep + kstep, voffB);
    PG8_WAIT_V(6); PG8_BAR;
    for (;;) {
        const bool has_next = S.next(ui + 1, nxt);
        const char* nA = has_next ? (const char*)g.A + (size_t)nxt.pm * tstep : cA; const char* nB = has_next ? (const char*)g.Bt + (size_t)nxt.pn * tstep : cB;
        for (int t = 0; t < nt; t += 2) {
            const bool last = (t == nt - 2);
            const char* a1 = cA + (size_t)(t + 1) * kstep;
            const char* a2 = last ? nA : cA + (size_t)(t + 2) * kstep; const char* b2 = last ? nB : cB + (size_t)(t + 2) * kstep;
            const char* a3 = a2 + kstep; const char* b3 = b2 + kstep;
            if (last && has_next) S.a_ready(nxt);
            PG8_LDB(B0, 0, 0); PG8_SCHED; PG8_LDA(At, 0, 0); PG8_STAGE(PG8_SA(1, 1), a1 + hstep, voffA);
            PG8_WAIT_L(8); PG8_BAR; PG8_WAIT_L(0); PG8_MMA(0, 0, At, B0); PG8_BAR; PG8_SCHED;
            PG8_LDB(B1, 0, 1); PG8_STAGE(PG8_SB(0, 0), b2, voffB);
            PG8_BAR; PG8_WAIT_L(0); PG8_MMA(0, 1, At, B1); PG8_BAR;
            PG8_LDA(At, 0, 1); PG8_STAGE(PG8_SA(0, 0), a2, voffA);
            PG8_BAR; PG8_WAIT_L(0); PG8_MMA(1, 0, At, B0); PG8_BAR; PG8_SCHED;
            PG8_STAGE(PG8_SB(0, 1), b2 + hstep, voffB);
            PG8_WAIT_V(6); PG8_BAR; PG8_MMA(1, 1, At, B1); PG8_BAR;
            PG8_LDB(B0, 1, 0); PG8_SCHED; PG8_LDA(At, 1, 0); PG8_STAGE(PG8_SA(0, 1), a2 + hstep, voffA);
            PG8_WAIT_L(8); PG8_BAR; PG8_WAIT_L(0); PG8_MMA(0, 0, At, B0); PG8_BAR; PG8_SCHED;
            PG8_LDB(B1, 1, 1); PG8_STAGE(PG8_SB(1, 0), b3, voffB);
            PG8_BAR; PG8_WAIT_L(0); PG8_MMA(0, 1, At, B1); PG8_BAR;
            PG8_LDA(At, 1, 1); PG8_STAGE(PG8_SA(1, 0), a3, voffA);
            PG8_BAR; PG8_WAIT_L(0); PG8_MMA(1, 0, At, B0); PG8_BAR; PG8_SCHED;
            PG8_STAGE(PG8_SB(1, 1), b3 + hstep, voffB);
            PG8_WAIT_V(6); PG8_BAR; PG8_MMA(1, 1, At, B1); PG8_BAR;
        }
        E(acc, cur, wr, wc, fr, fq); S.done(cur);
        if (!has_next) break;
#pragma unroll
        for (int a = 0; a < 2; ++a)
#pragma unroll
            for (int b = 0; b < 2; ++b)
#pragma unroll
                for (int m = 0; m < 4; ++m)
#pragma unroll
                    for (int n = 0; n < 2; ++n) acc[a][b][m][n] = (f32x4){0.f, 0.f, 0.f, 0.f};
        cur = nxt; cA = nA; cB = nB; ++ui;
    }
    PG8_WAIT_V(0);
    if (wr == 0) PG8_BAR;
    PG8_BAR;
#undef PG8_SA
#undef PG8_SB
#undef PG8_STAGE
#undef PG8_LDA
#undef PG8_LDB
#undef PG8_MMA
#undef PG8_WAIT_V
#undef PG8_WAIT_L
#undef PG8_BAR
#undef PG8_SCHED
}
}

#ifndef P1_MAXU
#define P1_MAXU 4
#endif
#ifndef PROBE_MASK
#define PROBE_MASK 0
#endif

namespace {

typedef unsigned short bf16_t;
constexpr int NT = 512;
constexpr int D = 2048;
constexpr int MP = 4 * 2048;
constexpr int MS = 128 * 8;
constexpr int M = MP + MS;
constexpr int NIN = 7704;
constexpr int LDP = 7936;
constexpr int NPF = 3072, LDH = LDP - NPF;
constexpr int C_QB = 0, C_FB = 1024, C_IB = 2048;
constexpr int C_QA = 0, C_KV = 1024, C_GATE = 2560, C_ZA = 2584, C_ZB = 3608;
constexpr int NCMP = 127;
constexpr int NSEQ = 132;
constexpr float EPS = 1e-6f;
constexpr int LDS_STAGE = 139264;
constexpr int LDS_BYTES = LDS_STAGE + 256;

constexpr size_t O_YP = 0;
constexpr size_t O_YS = O_YP + 16777216;
constexpr size_t O_CMP_P = O_YS + 2097152;
constexpr size_t O_SLC_P = O_CMP_P + 4194304;
constexpr size_t O_WIN_P = O_SLC_P + 4194304;
constexpr size_t O_ST_P = O_WIN_P + 1048576;
constexpr size_t O_CMP_S = O_ST_P + 524288;
constexpr size_t O_SLC_S = O_CMP_S + 524288;
constexpr size_t O_WIN_S = O_SLC_S + 524288;
constexpr size_t O_ST_S = O_WIN_S + 33554432;

struct Params {
    const float *x_prompt, *x_sample, *cache_cmp, *cache_slc, *cache_win, *state;
    const int* page_table;
    const float *g_norm, *w_in, *w_out, *g_q, *g_k_slc, *g_k_win, *g_k_cmp, *w_cmp_k, *w_cmp_v,
        *pe_k, *pe_v, *rel_bias, *lb_logits, *g_o;
    float* out;
    bf16_t *Hb, *Wt_in, *Wt_out, *MIXb, *Wc_t, *Qb, *KVb, *KCb, *VCb;
    float* PEB;
    float* PF; bf16_t* PH;
    float* GATE;
    bf16_t *OC, *OS, *OW;
    float* OH;
    unsigned long long* SEL;
    unsigned* bar;
    unsigned* ctr;
};

__device__ __forceinline__ const float* xrow(const Params& p, int m) {
    return m < MP ? p.x_prompt + (size_t)m * D : p.x_sample + (size_t)(m - MP) * D;
}

__device__ __forceinline__ int rel_bucket(int dist) {
    int n = dist < 0 ? 0 : dist;
    if (n < 16) return n;
    int b = 16;
    b += (n >= 19) + (n >= 21) + (n >= 24) + (n >= 27) + (n >= 31) + (n >= 35) + (n >= 40) +
         (n >= 46) + (n >= 52) + (n >= 59) + (n >= 67) + (n >= 77) + (n >= 87) + (n >= 99) +
         (n >= 113);
    return b;
}

__device__ __forceinline__ float wave_sum(float v) {
#pragma unroll
    for (int o = 32; o >= 1; o >>= 1) v += __shfl_xor(v, o, 64);
    return v;
}
__device__ __forceinline__ float wave_max(float v) {
#pragma unroll
    for (int o = 32; o >= 1; o >>= 1) v = fmaxf(v, __shfl_xor(v, o, 64));
    return v;
}
__device__ __forceinline__ float half_sum(float v) {
#pragma unroll
    for (int o = 16; o >= 1; o >>= 1) v += __shfl_xor(v, o, 64);
    return v;
}
__device__ __forceinline__ float sigmoidf_(float x) { return __builtin_amdgcn_rcpf(1.0f + __expf(-x)); }
__device__ __forceinline__ float siluf_(float x) { return x * __builtin_amdgcn_rcpf(1.0f + __expf(-x)); }
__device__ __forceinline__ unsigned pk2(float lo, float hi) { return pg8::cvt_pk_bf16(lo, hi); }
__device__ __forceinline__ float bflo(unsigned u) { return __uint_as_float(u << 16); }
__device__ __forceinline__ float bfhi(unsigned u) { return __uint_as_float(u & 0xffff0000u); }
__device__ __forceinline__ float4 bf4(uint2 u) { return make_float4(bflo(u.x), bfhi(u.x), bflo(u.y), bfhi(u.y)); }

__device__ __forceinline__ void tok_info(int m, int& n, int& qpos) {
    if (m < MP) { n = m >> 11; qpos = m & 2047; }
    else { int j = m - MP; n = 4 + (j >> 3); qpos = 2048 + (j & 7); }
}

__device__ __forceinline__ int q_next(unsigned* qctr, int cur, int bid, int nb, unsigned char* smem) {
    if (!qctr) return cur < 0 ? bid : cur + nb;
    volatile int* s_q = (volatile int*)(smem + LDS_STAGE + 48);
    __syncthreads();
    if (threadIdx.x == 0) *s_q = (int)__hip_atomic_fetch_add(qctr, 1u, __ATOMIC_RELAXED, __HIP_MEMORY_SCOPE_AGENT);
    __syncthreads();
    return *s_q;
}

__device__ __forceinline__ void tr_item(const float* W, int K, int N, bf16_t* WT, float* scr, int item, int lane, bool perm_in = false) {
    const int nblk = (N + 31) / 32, kb = item / nblk, nbk = item % nblk, k0 = 64 * kb, n0 = 32 * nbk;
    const int nn = n0 + (lane & 31);
    float wv[32];
#pragma unroll
    for (int i = 0; i < 32; ++i) wv[i] = nn < N ? W[(size_t)(k0 + 2 * i + (lane >> 5)) * N + nn] : 0.f;
#pragma unroll
    for (int i = 0; i < 32; ++i) scr[(2 * i + (lane >> 5)) * 33 + (lane & 31)] = wv[i];
    asm volatile("s_waitcnt lgkmcnt(0)" ::: "memory");
    const int c = lane & 7;
#pragma unroll
    for (int j = 0; j < 4; ++j) {
        const int n = (lane >> 3) + 8 * j;
        const float* s = scr + (8 * c) * 33 + n;
        uint4 o;
        o.x = pk2(s[0 * 33], s[1 * 33]); o.y = pk2(s[2 * 33], s[3 * 33]);
        o.z = pk2(s[4 * 33], s[5 * 33]); o.w = pk2(s[6 * 33], s[7 * 33]);
        int nr = n0 + n;
        if (perm_in) nr = nr < 3608 ? nr + NPF : (nr < 6680 ? nr - 3608 : nr);
        if (n0 + n < N) *(uint4*)(WT + (size_t)nr * K + k0 + 8 * c) = o;
    }
    asm volatile("s_waitcnt lgkmcnt(0)" ::: "memory");
}

__device__ __forceinline__ void ph_prologue(const Params& p, int bid, int nb, float* lds) {
    const int tid = threadIdx.x, lane = tid & 63, wave = tid >> 6;
    for (int r = (bid + nb - 64 % nb) % nb; r < 64; r += nb) {
        const int kvsel = r >> 5, l = r & 31;
        const float* W = (kvsel ? p.w_cmp_v : p.w_cmp_k) + (size_t)l * 128 * 128;
        const float* pe = (kvsel ? p.pe_v : p.pe_k) + l * 128;
        const int dsub = lane >> 5, e4 = lane & 31;
        pg8::f32x4 wv4[8]; float pv[8];
#pragma unroll
        for (int i = 0; i < 8; ++i) { const int d = 16 * wave + 2 * i + dsub; wv4[i] = *(const pg8::f32x4*)(W + d * 128 + 4 * e4); pv[i] = pe[d]; }
        pg8::f32x4 a4 = {0.f, 0.f, 0.f, 0.f};
#pragma unroll
        for (int i = 0; i < 8; ++i) a4 += wv4[i] * pv[i];
#pragma unroll
        for (int c = 0; c < 4; ++c) a4[c] += __shfl_xor(a4[c], 32, 64);
        if (lane < 32) *(pg8::f32x4*)(lds + wave * 128 + 4 * e4) = a4;
        __syncthreads();
        if (tid < 128) {
            float sum = 0.f;
#pragma unroll
            for (int w = 0; w < 8; ++w) sum += lds[w * 128 + tid];
            p.PEB[r * 128 + tid] = sum;
        }
        __syncthreads();
    }
    {
        float* scr = lds + wave * (64 * 33 + 16);
        const int gw = bid * 8 + wave, ngw = nb * 8;
        const int I_IN = 32 * ((NIN + 31) / 32), I_OUT = 32 * 64, I_C = 4 * 128;
        for (int it = gw; it < I_IN + I_OUT + I_C; it += ngw) {
            if (it < I_IN) tr_item(p.w_in, D, NIN, p.Wt_in, scr, it, lane, true);
            else if (it < I_IN + I_OUT) tr_item(p.w_out, 2048, D, p.Wt_out, scr, it - I_IN, lane);
            else {
                const int r = it - I_IN - I_OUT, q = r >> 7, kvsel = q >> 1, hh = q & 1;
                const float* W = (kvsel ? p.w_cmp_v : p.w_cmp_k) + (size_t)hh * 2048 * 128;
                tr_item(W, 2048, 128, p.Wc_t + ((size_t)kvsel * 256 + hh * 128) * 2048, scr, r & 127, lane);
            }
        }
    }
    __syncthreads();
    {
        const int gw = bid * 8 + wave, ngw = nb * 8;
        float4 gn[8];
#pragma unroll
        for (int j = 0; j < 8; ++j) gn[j] = ((const float4*)p.g_norm)[lane + 64 * j];
        for (int m = gw; m < M; m += 2 * ngw) {
            const int m1 = m + ngw;
            const bool has1 = m1 < M;
            const float4* x0 = (const float4*)xrow(p, m);
            const float4* x1 = (const float4*)xrow(p, has1 ? m1 : m);
            float4 v0[8], v1[8];
#pragma unroll
            for (int j = 0; j < 8; ++j) { v0[j] = x0[lane + 64 * j]; v1[j] = x1[lane + 64 * j]; }
            float s0 = 0.f, s1 = 0.f;
#pragma unroll
            for (int j = 0; j < 8; ++j) {
                s0 += v0[j].x * v0[j].x + v0[j].y * v0[j].y + v0[j].z * v0[j].z + v0[j].w * v0[j].w;
                s1 += v1[j].x * v1[j].x + v1[j].y * v1[j].y + v1[j].z * v1[j].z + v1[j].w * v1[j].w;
            }
            s0 = wave_sum(s0); s1 = wave_sum(s1);
            const float r0 = rsqrtf(s0 * (1.0f / D) + EPS), r1 = rsqrtf(s1 * (1.0f / D) + EPS);
            uint2* o0 = (uint2*)(p.Hb + (size_t)m * D);
            uint2* o1 = (uint2*)(p.Hb + (size_t)m1 * D);
#pragma unroll
            for (int j = 0; j < 8; ++j) {
                const float4 g = gn[j];
                o0[lane + 64 * j] = make_uint2(pk2(v0[j].x * r0 * g.x, v0[j].y * r0 * g.y), pk2(v0[j].z * r0 * g.z, v0[j].w * r0 * g.w));
                if (has1) o1[lane + 64 * j] = make_uint2(pk2(v1[j].x * r1 * g.x, v1[j].y * r1 * g.y), pk2(v1[j].z * r1 * g.z, v1[j].w * r1 * g.w));
            }
        }
    }
}

__device__ __forceinline__ void ph_wincopy(const Params& p, int bid, int nb, unsigned char* smem = nullptr, unsigned* qctr = nullptr) {
    const int tid = threadIdx.x;
    {
        const float4* srcw = (const float4*)(p.cache_win + 8 * 512);
        float4* dstw = (float4*)(p.out + O_WIN_S);
#define WC_IDX(j) ({ const unsigned i_ = (unsigned)ck * 4096u + (unsigned)(j) * 512u + (unsigned)tid; const unsigned sq_ = i_ / 64512u; sq_ * 65536u + (i_ - sq_ * 64512u); })
        for (int ck = q_next(qctr, -1, bid, nb, smem); ck < 2016; ck = q_next(qctr, ck, bid, nb, smem)) {
            const unsigned i0 = WC_IDX(0), i1 = WC_IDX(1), i2 = WC_IDX(2), i3 = WC_IDX(3), i4 = WC_IDX(4), i5 = WC_IDX(5), i6 = WC_IDX(6), i7 = WC_IDX(7);
            typedef pg8::f32x4 f4;
            const f4* sw_ = (const f4*)srcw; f4* dw_ = (f4*)dstw;
            const f4 w0 = __builtin_nontemporal_load(sw_ + i0), w1 = __builtin_nontemporal_load(sw_ + i1), w2 = __builtin_nontemporal_load(sw_ + i2), w3 = __builtin_nontemporal_load(sw_ + i3),
                     w4 = __builtin_nontemporal_load(sw_ + i4), w5 = __builtin_nontemporal_load(sw_ + i5), w6 = __builtin_nontemporal_load(sw_ + i6), w7 = __builtin_nontemporal_load(sw_ + i7);
            __builtin_nontemporal_store(w0, dw_ + i0); __builtin_nontemporal_store(w1, dw_ + i1); __builtin_nontemporal_store(w2, dw_ + i2); __builtin_nontemporal_store(w3, dw_ + i3);
            __builtin_nontemporal_store(w4, dw_ + i4); __builtin_nontemporal_store(w5, dw_ + i5); __builtin_nontemporal_store(w6, dw_ + i6); __builtin_nontemporal_store(w7, dw_ + i7);
        }
#undef WC_IDX
    }
}

__device__ __forceinline__ void post_token(const Params& p, const int m, const float2 (&v)[20], const float gt, const int lane, const int l2,
                                           const float2 gq, const float2 gs, const float2 gwn) {
        float ss[20];
#pragma unroll
        for (int ch = 0; ch < 20; ++ch) ss[ch] = v[ch].x * v[ch].x + v[ch].y * v[ch].y;
#pragma unroll
        for (int o = 32; o >= 1; o >>= 1) {
#pragma unroll
            for (int ch = 0; ch < 20; ++ch) ss[ch] += __shfl_xor(ss[ch], o, 64);
        }
#pragma unroll
        for (int ch = 0; ch < 8; ++ch) {
            const float r = rsqrtf(ss[ch] * (1.0f / 128) + EPS) * 0.08838834764831845f;
            *(unsigned*)&p.Qb[(size_t)m * 1024 + ch * 128 + l2] = pk2(v[ch].x * r * gq.x, v[ch].y * r * gq.y);
        }
#pragma unroll
        for (int c = 0; c < 12; ++c) {
            const int br = c >> 2, kv = (c >> 1) & 1, gg = c & 1;
            float2 w = v[8 + c];
            if (br >= 1 && kv == 0) {
                const float r = rsqrtf(ss[8 + c] * (1.0f / 128) + EPS);
                const float2 gk = (br == 1) ? gs : gwn;
                w.x *= r * gk.x; w.y *= r * gk.y;
            }
            const int sub = (c & 3) * 128 + l2;
            if (m < MP) {
                const int b = m >> 11, t = m & 2047;
                if (br >= 1)
                    *(unsigned*)&p.KVb[((((size_t)((br - 1) * 2 + kv) * 4 + b) * 2 + gg) * 2048 + t) * 128 + l2] = pk2(w.x, w.y);
                if (br == 0) *(float2*)&p.out[O_CMP_P + (size_t)m * 512 + sub] = w;
                else if (br == 1) *(float2*)&p.out[O_SLC_P + (size_t)m * 512 + sub] = w;
                else if (t >= 1536) *(float2*)&p.out[O_WIN_P + ((size_t)b * 512 + (t - 1536)) * 512 + sub] = w;
            } else {
                const int j = m - MP;
                if (br == 0) *(float2*)&p.out[O_CMP_S + (size_t)j * 512 + sub] = w;
                else if (br == 1) *(float2*)&p.out[O_SLC_S + (size_t)j * 512 + sub] = w;
                else *(float2*)&p.out[O_WIN_S + ((size_t)(j >> 3) * 512 + 504 + (j & 7)) * 512 + sub] = w;
            }
        }
        if (lane < 24) p.GATE[(size_t)m * 24 + lane] = sigmoidf_(gt);
}

__device__ __forceinline__ void ph_post(const Params& p, int bid, int nb) {
    const int lane = threadIdx.x & 63, wave = threadIdx.x >> 6;
    const int gw = bid * 8 + wave, ngw = nb * 8;
    const int l2 = lane * 2;
    const float2 gq = *(const float2*)&p.g_q[l2], gs = *(const float2*)&p.g_k_slc[l2], gwn = *(const float2*)&p.g_k_win[l2];
    for (int m = gw; m < M; m += 2 * ngw) {
        const int m1 = m + ngw;
        const bool has1 = m1 < M;
        const bf16_t* row0 = p.PH + (size_t)m * LDH;
        const bf16_t* row1 = p.PH + (size_t)(has1 ? m1 : m) * LDH;
        float2 v0[20], v1[20];
#pragma unroll
        for (int ch = 0; ch < 20; ++ch) {
            const int col = (ch < 8 ? C_QA + ch * 128 : C_KV + (ch - 8) * 128) + l2;
            const unsigned u0 = *(const unsigned*)&row0[col], u1 = *(const unsigned*)&row1[col];
            v0[ch] = make_float2(bflo(u0), bfhi(u0)); v1[ch] = make_float2(bflo(u1), bfhi(u1));
        }
        const float gt0 = (lane < 24) ? bflo((unsigned)row0[C_GATE + lane]) : 0.f, gt1 = (lane < 24) ? bflo((unsigned)row1[C_GATE + lane]) : 0.f;
        post_token(p, m, v0, gt0, lane, l2, gq, gs, gwn);
        if (has1) post_token(p, m1, v1, gt1, lane, l2, gq, gs, gwn);
    }
}

__device__ __forceinline__ void ph_cmp_mfma(const Params& p, int limit, bool early_stop, unsigned char* smem, int maxu = 1 << 30) {
    typedef pg8::bf16x8 bf16x8;
    typedef pg8::f32x4 f32x4;
    const int tid = threadIdx.x, lane = tid & 63, wid = tid >> 6, wm = wid >> 2, wn = wid & 3, fr = lane & 15, fq = lane >> 4;
    const int arow0 = tid >> 5, apc = tid & 31;
    const int brow0 = tid >> 4, bpc = tid & 15;
    float* Cs = (float*)smem;
    unsigned char* bufA = smem;
    unsigned char* bufB = smem + 32768;
    volatile int* s_u = (volatile int*)(smem + LDS_STAGE + 32);
    float* pbs = (float*)(smem + 134144);
    if (tid < 256) {
        float a_ = 0.f;
#pragma unroll
        for (int l = 0; l < 32; ++l) a_ += p.PEB[((tid >> 7) * 32 + l) * 128 + (tid & 127)];
        pbs[tid] = a_;
    }
    const float g0 = p.g_k_cmp[lane], g1 = p.g_k_cmp[lane + 64];
#define CMP_TAKE(NU, tk_, uu_) { tk_ = false; uu_ = limit; \
        if (tid == 0 && (NU) < maxu && !(early_stop && __hip_atomic_load(&p.ctr[64], __ATOMIC_RELAXED, __HIP_MEMORY_SCOPE_AGENT) != 0u)) { \
            uu_ = (int)__hip_atomic_fetch_add(&p.ctr[0], 1u, __ATOMIC_RELAXED, __HIP_MEMORY_SCOPE_AGENT); tk_ = true; } }
#define CMP_PUBLISH(tk_, uu_) { if (tid == 0) { \
            if (tk_ && uu_ >= limit && limit < NSEQ * 4) {   \
                (void)__hip_atomic_fetch_sub(&p.ctr[0], 1u, __ATOMIC_RELAXED, __HIP_MEMORY_SCOPE_AGENT); uu_ = limit; } \
            *s_u = uu_; } }
    { bool tk0; int uu0; CMP_TAKE(0, tk0, uu0) CMP_PUBLISH(tk0, uu0) }
    for (int nu = 0;; ++nu) {
        __syncthreads();
        const int u = *s_u;
        if (u >= limit) break;
        const int n = (u < 512) ? 4 + (u >> 2) : ((u - 512) >> 2);
        const int g = (u >> 1) & 1, kvsel = u & 1;
        const float* abase[8]; size_t lstride;
        if (n >= 4) {
            lstride = 512;
#pragma unroll
            for (int j = 0; j < 8; ++j) {
                const int ar = arow0 + 16 * j;
                const int page = p.page_table[(n - 4) * 16 + (ar >> 3)];
                abase[j] = p.cache_cmp + ((((size_t)page * 128 + 16 * (ar & 7)) * 2 + kvsel) * 2 + g) * 128 + apc * 4;
            }
        } else {
            lstride = LDH / 2;
#pragma unroll
            for (int j = 0; j < 8; ++j)
                abase[j] = (const float*)(p.PH + ((size_t)n * 2048 + 16 * (arow0 + 16 * j)) * LDH + C_KV + kvsel * 256 + g * 128 + (apc & ~1) * 4);
        }
        const bool a16 = (n < 4);
        const bf16_t* bbase = p.Wc_t + ((size_t)kvsel * 256 + brow0) * 2048 + bpc * 8;
        f32x4 acc[4][4];
#pragma unroll
        for (int m = 0; m < 4; ++m)
#pragma unroll
            for (int q = 0; q < 4; ++q) acc[m][q] = (f32x4){0.f, 0.f, 0.f, 0.f};
        f32x4 ra[8]; pg8::u32x4 rb[8];
#pragma unroll
        for (int j = 0; j < 8; ++j) {
            ra[j] = __builtin_nontemporal_load((const f32x4*)abase[j]);
            rb[j] = *(const pg8::u32x4*)(bbase + (size_t)32 * j * 2048);
        }
        for (int ss = 0; ss < 16; ++ss) {
#pragma unroll
            for (int j = 0; j < 8; ++j) {
                const int ar = arow0 + 16 * j, br = brow0 + 32 * j;
                if (a16) { if (!(apc & 1)) *(f32x4*)(bufA + ar * 256 + ((((unsigned)apc >> 1) ^ (unsigned)(ar & 15)) << 4)) = ra[j]; }
                else *(uint2*)(bufA + ar * 256 + ((((unsigned)apc >> 1) ^ (unsigned)(ar & 15)) << 4) + 8 * (apc & 1)) =
                    make_uint2(pk2(ra[j][0], ra[j][1]), pk2(ra[j][2], ra[j][3]));
                *(pg8::u32x4*)(bufB + br * 256 + (((unsigned)bpc ^ (unsigned)(br & 15)) << 4)) = rb[j];
            }
            __syncthreads();
            if (ss + 1 < 16) {
#pragma unroll
                for (int j = 0; j < 8; ++j) {
                    ra[j] = __builtin_nontemporal_load((const f32x4*)(abase[j] + (size_t)(ss + 1) * lstride));
                    rb[j] = *(const pg8::u32x4*)(bbase + (size_t)32 * j * 2048 + (ss + 1) * 128);
                }
            }
#pragma unroll
            for (int sub = 0; sub < 4; ++sub) {
                bf16x8 Af[4], Bf[4];
#pragma unroll
                for (int m = 0; m < 4; ++m) {
                    const int r = wm * 64 + 16 * m + fr;
                    Af[m] = *(const bf16x8*)(bufA + r * 256 + (((unsigned)(4 * sub + fq) ^ (unsigned)(r & 15)) << 4));
                }
#pragma unroll
                for (int q = 0; q < 4; ++q) {
                    const int r = wn * 64 + 16 * q + fr;
                    Bf[q] = *(const bf16x8*)(bufB + r * 256 + (((unsigned)(4 * sub + fq) ^ (unsigned)(r & 15)) << 4));
                }
#pragma unroll
                for (int m = 0; m < 4; ++m)
#pragma unroll
                    for (int q = 0; q < 4; ++q)
                        acc[m][q] = __builtin_amdgcn_mfma_f32_16x16x32_bf16(Bf[q], Af[m], acc[m][q], 0, 0, 0);
            }
            __syncthreads();
        }
        __syncthreads();
        bool tkn; int uun;
        CMP_TAKE(nu + 1, tkn, uun)
#pragma unroll
        for (int m = 0; m < 4; ++m)
#pragma unroll
            for (int q = 0; q < 4; ++q)
                *(f32x4*)(Cs + (wm * 64 + 16 * m + fr) * 260 + wn * 64 + 16 * q + 4 * fq) = acc[m][q];
        __syncthreads();
        {
            const float pb0 = pbs[kvsel * 128 + lane], pb1 = pbs[kvsel * 128 + lane + 64];
            bf16_t* dst = (kvsel ? p.VCb : p.KCb) + ((size_t)(n * 2 + g) * 128) * 128;
            for (int c = wid; c < 128; c += 8) {
                float v0 = 0.f, v1 = 0.f;
                if (c < NCMP) {
                    v0 = Cs[c * 260 + lane] + Cs[(c + 1) * 260 + 128 + lane] + pb0;
                    v1 = Cs[c * 260 + lane + 64] + Cs[(c + 1) * 260 + 192 + lane] + pb1;
                    if (kvsel == 0) {
                        const float ss = wave_sum(v0 * v0 + v1 * v1);
                        const float rr = rsqrtf(ss * (1.0f / 128) + EPS);
                        v0 *= rr * g0; v1 *= rr * g1;
                    }
                }
                const unsigned pk = pk2(v0, v1);
                dst[c * 128 + lane] = (bf16_t)(pk & 0xffffu);
                dst[c * 128 + lane + 64] = (bf16_t)(pk >> 16);
            }
        }
        CMP_PUBLISH(tkn, uun)
        __syncthreads();
    }
#undef CMP_TAKE
#undef CMP_PUBLISH
}

__device__ __forceinline__ unsigned fvsw(int row) { return (unsigned)(((row & 3) << 2) | (((row >> 2) & 1) << 1) | ((row >> 3) & 1)); }

__device__ __forceinline__ void ph_cmp_attn_mfma(const Params& p, int bid, int nb, unsigned char* smem) {
    typedef pg8::bf16x8 bf16x8;
    typedef pg8::f32x4 f32x4;
    typedef short s16x4 __attribute__((ext_vector_type(4)));
    const int tid = threadIdx.x, lane = tid & 63, wid = tid >> 6, fr = lane & 15, fq = lane >> 4, hl = fr & 3;
    unsigned char* Kb = smem;
    unsigned char* Vb = smem + 32768;
    float* bt = (float*)(smem + 65536);
    float* sA = (float*)(smem + 65536 + 2048);
    float* sB = sA + 1024;
    float* skey = sB + 1024;
    unsigned long long* smask = (unsigned long long*)(skey + 32 * 36);
    for (int it = bid; it < 512 + 256; it += nb) {
        int n, g, m0, qpos0, ntok;
        if (it < 512) { const int bg = it >> 6; n = bg >> 1; g = bg & 1; const int qt = it & 63; m0 = n * 2048 + qt * 32; qpos0 = qt * 32; ntok = 32; }
        else { const int j = it - 512; const int sq = j >> 1; g = j & 1; n = 4 + sq; m0 = MP + sq * 8; qpos0 = 2048; ntok = 8; }
        const int tl = (ntok == 32) ? 4 * wid + (fr >> 2) : 4 * (wid & 1) + (fr >> 2);
        const bool wr = (ntok == 32) || (wid < 2);
        const int m = m0 + tl, tq = qpos0 + tl;
        __syncthreads();
        bf16x8 Qf[4];
        {
            const int row = tid >> 2;
            const bf16_t* kc = p.KCb + ((size_t)(n * 2 + g) * 128 + row) * 128;
            const bf16_t* vc = p.VCb + ((size_t)(n * 2 + g) * 128 + row) * 128;
            pg8::u32x4 kk[4], vk[4];
#pragma unroll
            for (int jj = 0; jj < 4; ++jj) {
                const unsigned ch = (unsigned)((tid & 3) * 4 + jj);
                kk[jj] = *(const pg8::u32x4*)(kc + ch * 8);
                vk[jj] = *(const pg8::u32x4*)(vc + ch * 8);
            }
            const float btv = p.rel_bias[rel_bucket(tid & 127) * 8 + g * 4 + (tid >> 7)];
            const bf16_t* qp = p.Qb + (size_t)m * 1024 + (g * 4 + hl) * 128 + 8 * fq;
#pragma unroll
            for (int sx = 0; sx < 4; ++sx) Qf[sx] = *(const bf16x8*)(qp + 32 * sx);
            asm volatile("" : "+v"(kk[0]), "+v"(kk[1]), "+v"(kk[2]), "+v"(kk[3]), "+v"(vk[0]), "+v"(vk[1]), "+v"(vk[2]), "+v"(vk[3]) :: "memory");
            bt[tid] = btv;
            if (tid < 32) smask[tid] = 0ull;
#pragma unroll
            for (int jj = 0; jj < 4; ++jj) {
                const unsigned ch = (unsigned)((tid & 3) * 4 + jj);
                *(pg8::u32x4*)(Kb + row * 256 + ((ch ^ (unsigned)(row & 15)) << 4)) = kk[jj];
                *(pg8::u32x4*)(Vb + row * 256 + ((ch ^ fvsw(row)) << 4)) = vk[jj];
            }
        }
        __syncthreads();
        f32x4 S[8];
#pragma unroll
        for (int nt = 0; nt < 8; ++nt) {
            const int r = 16 * nt + fr;
            S[nt] = (f32x4){0.f, 0.f, 0.f, 0.f};
#pragma unroll
            for (int sx = 0; sx < 4; ++sx) {
                const bf16x8 Kf = *(const bf16x8*)(Kb + r * 256 + (((unsigned)(4 * sx + fq) ^ (unsigned)(r & 15)) << 4));
                S[nt] = __builtin_amdgcn_mfma_f32_16x16x32_bf16(Kf, Qf[sx], S[nt], 0, 0, 0);
            }
        }
        float tmax = -INFINITY;
#pragma unroll
        for (int nt = 0; nt < 8; ++nt)
#pragma unroll
            for (int i = 0; i < 4; ++i) {
                const int c = 16 * nt + 4 * fq + i;
                const int dist = tq - (16 * c + 31);
                const bool valid = dist >= 0 && c < NCMP;
                const float bias = bt[hl * 128 + (dist < 0 ? 0 : (dist > 127 ? 127 : dist))];
                const float sv = valid ? S[nt][i] + bias : -INFINITY;
                S[nt][i] = sv;
                tmax = fmaxf(tmax, sv);
            }
        tmax = fmaxf(tmax, __shfl_xor(tmax, 16, 64));
        tmax = fmaxf(tmax, __shfl_xor(tmax, 32, 64));
        const bool dead = (tmax == -INFINITY);
        float psum = 0.f;
#pragma unroll
        for (int nt = 0; nt < 8; ++nt)
#pragma unroll
            for (int i = 0; i < 4; ++i) {
                const float pv = dead ? 0.f : __expf(S[nt][i] - tmax);
                S[nt][i] = pv;
                psum += pv;
            }
        psum += __shfl_xor(psum, 16, 64);
        psum += __shfl_xor(psum, 32, 64);
        const float inv = psum > 0.f ? 1.0f / psum : 0.f;
#pragma unroll
        for (int nt = 0; nt < 8; ++nt) { S[nt][0] *= inv; S[nt][1] *= inv; S[nt][2] *= inv; S[nt][3] *= inv; }
#pragma unroll
        for (int nt = 0; nt < 8; ++nt) {
            float av = 2.f * (S[nt][0] + S[nt][1] + S[nt][2]) + S[nt][3];
            float bv = S[nt][3];
            av += __shfl_xor(av, 1, 64); av += __shfl_xor(av, 2, 64);
            bv += __shfl_xor(bv, 1, 64); bv += __shfl_xor(bv, 2, 64);
            if (hl == 0 && wr) { sA[tl * 32 + 4 * nt + fq] = av; sB[tl * 32 + 4 * nt + fq] = bv; }
        }
        f32x4 O[8];
#pragma unroll
        for (int c = 0; c < 8; ++c) O[c] = (f32x4){0.f, 0.f, 0.f, 0.f};
#pragma unroll
        for (int ks = 0; ks < 4; ++ks) {
            union { unsigned u[4]; bf16x8 v; } cv;
            cv.u[0] = pk2(S[2 * ks][0], S[2 * ks][1]); cv.u[1] = pk2(S[2 * ks][2], S[2 * ks][3]);
            cv.u[2] = pk2(S[2 * ks + 1][0], S[2 * ks + 1][1]); cv.u[3] = pk2(S[2 * ks + 1][2], S[2 * ks + 1][3]);
            const bf16x8 Pf = cv.v;
#pragma unroll
            for (int c = 0; c < 8; ++c) {
                const int r0 = 32 * ks + 4 * fq + (fr >> 2), r1 = r0 + 16;
                const unsigned ch = (unsigned)(2 * c + ((fr & 3) >> 1));
                const s16x4 a0 = __builtin_amdgcn_ds_read_tr16_b64_v4i16((__attribute__((address_space(3))) s16x4*)(Vb + r0 * 256 + ((ch ^ fvsw(r0)) << 4) + 8 * (fr & 1)));
                const s16x4 a1 = __builtin_amdgcn_ds_read_tr16_b64_v4i16((__attribute__((address_space(3))) s16x4*)(Vb + r1 * 256 + ((ch ^ fvsw(r1)) << 4) + 8 * (fr & 1)));
                const bf16x8 Vf = {a0[0], a0[1], a0[2], a0[3], a1[0], a1[1], a1[2], a1[3]};
                O[c] = __builtin_amdgcn_mfma_f32_16x16x32_bf16(Vf, Pf, O[c], 0, 0, 0);
            }
        }
        if (wr) {
            bf16_t* op = p.OC + (size_t)m * 1024 + (g * 4 + hl) * 128 + 4 * fq;
#pragma unroll
            for (int c = 0; c < 8; ++c) *(uint2*)(op + 16 * c) = make_uint2(pk2(O[c][0], O[c][1]), pk2(O[c][2], O[c][3]));
        }
        __syncthreads();
        const int tokl = tid >> 4, jb = 2 * (tid & 15);
        const bool active = tokl < ntok;
        const int cur = (qpos0 + tokl) >> 6;
#pragma unroll
        for (int e = 0; e < 2; ++e) {
            const int j = jb + e;
            const float scv = sA[tokl * 32 + j] + (j > 0 ? sB[tokl * 32 + j - 1] : 0.f);
            const bool valid = j <= cur;
            const bool forced = (j == 0) || (j == cur) || (j == cur - 1);
            skey[tokl * 36 + j] = (active && valid) ? (forced ? INFINITY : scv) : -INFINITY;
        }
        if ((tid & 15) == 0) skey[tokl * 36 + 32] = (ntok == 8) ? INFINITY : -INFINITY;
        __syncthreads();
        const int nslc = (ntok == 32) ? 32 : 33;
#pragma unroll
        for (int e = 0; e < 2; ++e) {
            const int j = jb + e;
            const float key = skey[tokl * 36 + j];
            int rank = 0;
            for (int j2 = 0; j2 < nslc; ++j2) {
                const float k2 = skey[tokl * 36 + j2];
                rank += (k2 > key) || (k2 == key && j2 < j);
            }
            if (active && rank < 16 && j <= cur) atomicOr(&smask[tokl], 1ull << j);
        }
        if (ntok == 8 && active && (tid & 15) == 0) atomicOr(&smask[tokl], 1ull << 32);
        __syncthreads();
        if (tid < ntok) p.SEL[(m0 + tid) * 2 + g] = smask[tid];
    }
}


template <int BR>
__device__ __forceinline__ void ph_attn_prompt(const Params& p, int bid, int nb, unsigned char* smem, unsigned* qctr = nullptr) {
    typedef pg8::bf16x8 bf16x8;
    typedef pg8::f32x4 f32x4;
    typedef short s16x4 __attribute__((ext_vector_type(4)));
    const int tid = threadIdx.x, lane = tid & 63, wid = tid >> 6, fr = lane & 15, fq = lane >> 4, hl = fr & 3;
    float* bt = (float*)(smem + 65536);
    const int srow = tid >> 4, spc = tid & 15;
    const unsigned ksw = (unsigned)(srow & 15), vsw = fvsw(srow);
    constexpr int NITEM = (BR == 1) ? 512 : 256;
    for (int pq = q_next(qctr, -1, bid, nb, smem); pq < NITEM; pq = q_next(qctr, pq, bid, nb, smem)) {
        const int pi = (BR == 1) ? (pq >> 1) : pq;
        const int bg = pi >> 5, b = bg >> 1, g = bg & 1, a = pi & 31;
        __syncthreads();
        bt[tid] = p.rel_bias[rel_bucket(tid & 127) * 8 + g * 4 + (tid >> 7)];
        float b31 = p.rel_bias[31 * 8 + g * 4 + hl];
        const bf16_t* Kg = p.KVb + ((((size_t)(BR * 2 + 0) * 4 + b) * 2 + g) * 2048) * 128;
        const bf16_t* Vg = p.KVb + ((((size_t)(BR * 2 + 1) * 4 + b) * 2 + g) * 2048) * 128;
        bf16_t* Og = (BR == 0) ? p.OS : p.OW;
        for (int half = (BR == 1) ? (pq & 1) : 0; half < ((BR == 1) ? (pq & 1) + 1 : 2); ++half) {
            const int qt = half ? 63 - a : a, t0 = qt * 32;
            const int tq = t0 + 4 * wid + (fr >> 2);
            const int m = b * 2048 + tq;
            bf16x8 Qf[4];
            {
                const bf16_t* qp = p.Qb + (size_t)m * 1024 + (g * 4 + hl) * 128 + 8 * fq;
#pragma unroll
                for (int sx = 0; sx < 4; ++sx) Qf[sx] = *(const bf16x8*)(qp + 32 * sx);
            }
            unsigned selmask = (BR == 0) ? (unsigned)p.SEL[m * 2 + g] : 0u;
            const int jhi = (t0 + 31) >> 6;
            const int jlo = (BR == 0) ? 0 : ((t0 - 512) > 0 ? ((t0 - 512) >> 6) : 0);
            f32x4 O[8];
#pragma unroll
            for (int c = 0; c < 8; ++c) O[c] = (f32x4){0.f, 0.f, 0.f, 0.f};
            float mrun = -INFINITY, lrun = 0.f;
            typedef pg8::u32x4 u32x4;
            u32x4 kr[2][2], vr[2][2];
#pragma unroll
            for (int par = 0; par < 2; ++par) {
                {
                    const int jl = (jlo + par <= jhi) ? jlo + par : jhi;
                    const bf16_t* kp = Kg + ((size_t)jl * 64 + srow) * 128 + spc * 8;
                    const bf16_t* vp = Vg + ((size_t)jl * 64 + srow) * 128 + spc * 8;
                    kr[par][0] = *(const u32x4*)kp; kr[par][1] = *(const u32x4*)(kp + 32 * 128);
                    vr[par][0] = *(const u32x4*)vp; vr[par][1] = *(const u32x4*)(vp + 32 * 128);
                }
            }
            asm volatile("" : "+v"(Qf[0]), "+v"(Qf[1]), "+v"(Qf[2]), "+v"(Qf[3]), "+v"(b31), "+v"(selmask) :: "memory");
            __syncthreads();
            for (int jj = jlo; jj <= jhi; jj += 2) {
#pragma unroll
              for (int par = 0; par < 2; ++par) {
                const int j = jj + par;
                if (j > jhi) break;
                unsigned char* Kb = smem + par * 32768;
                unsigned char* Vb = Kb + 16384;
                *(u32x4*)(Kb + srow * 256 + (((unsigned)spc ^ ksw) << 4)) = kr[par][0];
                *(u32x4*)(Kb + (srow + 32) * 256 + (((unsigned)spc ^ ksw) << 4)) = kr[par][1];
                *(u32x4*)(Vb + srow * 256 + (((unsigned)spc ^ vsw) << 4)) = vr[par][0];
                *(u32x4*)(Vb + (srow + 32) * 256 + (((unsigned)spc ^ vsw) << 4)) = vr[par][1];
                __syncthreads();
                {
                    const int jn = (j + 2 <= jhi) ? j + 2 : jhi;
                    const bf16_t* kp = Kg + ((size_t)jn * 64 + srow) * 128 + spc * 8;
                    const bf16_t* vp = Vg + ((size_t)jn * 64 + srow) * 128 + spc * 8;
                    kr[par][0] = *(const u32x4*)kp; kr[par][1] = *(const u32x4*)(kp + 32 * 128);
                    vr[par][0] = *(const u32x4*)vp; vr[par][1] = *(const u32x4*)(vp + 32 * 128);
                }
                const int kbase = j * 64;
                f32x4 S[4];
#pragma unroll
                for (int nt = 0; nt < 4; ++nt) {
                    const int r = 16 * nt + fr;
                    S[nt] = (f32x4){0.f, 0.f, 0.f, 0.f};
#pragma unroll
                    for (int sx = 0; sx < 4; ++sx) {
                        const bf16x8 Kf = *(const bf16x8*)(Kb + r * 256 + (((unsigned)(4 * sx + fq) ^ (unsigned)(r & 15)) << 4));
                        S[nt] = __builtin_amdgcn_mfma_f32_16x16x32_bf16(Kf, Qf[sx], S[nt], 0, 0, 0);
                    }
                }
                const bool far = (t0 - (kbase + 63)) >= 113;
                const bool selok = (BR == 0) ? (((selmask >> j) & 1u) != 0u) : true;
                float tmax = -INFINITY;
                if (far && (BR == 0 || (t0 + 31 - kbase) <= 512)) {
                    const float add = selok ? b31 : -INFINITY;
#pragma unroll
                    for (int nt = 0; nt < 4; ++nt)
#pragma unroll
                        for (int i = 0; i < 4; ++i) { const float sv = S[nt][i] + add; S[nt][i] = sv; tmax = fmaxf(tmax, sv); }
                } else {
#pragma unroll
                for (int nt = 0; nt < 4; ++nt)
#pragma unroll
                    for (int i = 0; i < 4; ++i) {
                        const int dist = tq - (kbase + 16 * nt + 4 * fq + i);
                        bool valid = selok && dist >= 0;
                        if (BR == 1) valid = valid && dist <= 512;
                        const float bias = far ? b31 : bt[hl * 128 + (dist < 0 ? 0 : (dist > 127 ? 127 : dist))];
                        const float sv = valid ? S[nt][i] + bias : -INFINITY;
                        S[nt][i] = sv;
                        tmax = fmaxf(tmax, sv);
                    }
                }
                tmax = fmaxf(tmax, __shfl_xor(tmax, 16, 64));
                tmax = fmaxf(tmax, __shfl_xor(tmax, 32, 64));
                const float mnew = fmaxf(mrun, tmax);
                const bool dead = (mnew == -INFINITY);
                const float scale = (mrun == -INFINITY) ? 0.f : __expf(mrun - mnew);
                float psum = 0.f;
#pragma unroll
                for (int nt = 0; nt < 4; ++nt)
#pragma unroll
                    for (int i = 0; i < 4; ++i) {
                        const float pv = dead ? 0.f : __expf(S[nt][i] - mnew);
                        S[nt][i] = pv;
                        psum += pv;
                    }
                lrun = lrun * scale + psum;
                mrun = mnew;
#pragma unroll
                for (int c = 0; c < 8; ++c) { O[c][0] *= scale; O[c][1] *= scale; O[c][2] *= scale; O[c][3] *= scale; }
                bf16x8 Pf[2];
#pragma unroll
                for (int ks = 0; ks < 2; ++ks) {
                    union { unsigned u[4]; bf16x8 v; } cv;
                    cv.u[0] = pk2(S[2 * ks][0], S[2 * ks][1]); cv.u[1] = pk2(S[2 * ks][2], S[2 * ks][3]);
                    cv.u[2] = pk2(S[2 * ks + 1][0], S[2 * ks + 1][1]); cv.u[3] = pk2(S[2 * ks + 1][2], S[2 * ks + 1][3]);
                    Pf[ks] = cv.v;
                }
#pragma unroll
                for (int c = 0; c < 8; ++c)
#pragma unroll
                    for (int ks = 0; ks < 2; ++ks) {
                        const int r0 = 32 * ks + 4 * fq + (fr >> 2), r1 = r0 + 16;
                        const unsigned ch = (unsigned)(2 * c + ((fr & 3) >> 1));
                        const s16x4 v0 = __builtin_amdgcn_ds_read_tr16_b64_v4i16((__attribute__((address_space(3))) s16x4*)(Vb + r0 * 256 + ((ch ^ fvsw(r0)) << 4) + 8 * (fr & 1)));
                        const s16x4 v1 = __builtin_amdgcn_ds_read_tr16_b64_v4i16((__attribute__((address_space(3))) s16x4*)(Vb + r1 * 256 + ((ch ^ fvsw(r1)) << 4) + 8 * (fr & 1)));
                        const bf16x8 Vf = {v0[0], v0[1], v0[2], v0[3], v1[0], v1[1], v1[2], v1[3]};
                        O[c] = __builtin_amdgcn_mfma_f32_16x16x32_bf16(Vf, Pf[ks], O[c], 0, 0, 0);
                    }
              }
            }
            float l = lrun + __shfl_xor(lrun, 16, 64);
            l += __shfl_xor(l, 32, 64);
            const float inv = l > 0.f ? 1.0f / l : 0.f;
            bf16_t* op = Og + (size_t)m * 1024 + (g * 4 + hl) * 128 + 4 * fq;
#pragma unroll
            for (int c = 0; c < 8; ++c)
                *(uint2*)(op + 16 * c) = make_uint2(pk2(O[c][0] * inv, O[c][1] * inv), pk2(O[c][2] * inv, O[c][3] * inv));
        }
    }
}


template <int BR>
__device__ __forceinline__ void ph_attn_sample(const Params& p, int bid, int nb, unsigned char* smem, unsigned* qctr = nullptr) {
    typedef pg8::bf16x8 bf16x8;
    typedef pg8::f32x4 f32x4;
    typedef short s16x4 __attribute__((ext_vector_type(4)));
    const int tid = threadIdx.x, lane = tid & 63, wid = tid >> 6, fr = lane & 15, fq = lane >> 4, hl = fr & 3;
    const int mt = wid & 1, kh = (wid >> 1) & 1, dh = wid >> 2;
    float* bt = (float*)(smem + 65536);
    float* mrg = (float*)(smem + 65536 + 2048);
    int* pgs = (int*)(smem + 65536 + 2048 + 36864);
    const int srow = tid >> 5, spc = tid & 31;
    const unsigned ksw = (unsigned)(srow & 15), vsw = fvsw(srow);
    for (int it = q_next(qctr, -1, bid, nb, smem); it < 256; it = q_next(qctr, it, bid, nb, smem)) {
        const int s = __builtin_amdgcn_readfirstlane(it >> 1), g = __builtin_amdgcn_readfirstlane(it & 1);
        __syncthreads();
        const float btv = p.rel_bias[rel_bucket(tid & 127) * 8 + g * 4 + (tid >> 7)];
        const int pgv = (BR == 0) ? p.page_table[s * 16 + (tid & 15)] : 0;
        float b31 = p.rel_bias[31 * 8 + g * 4 + hl];
        const int ti = 4 * mt + (fr >> 2);
        const int m = MP + s * 8 + ti;
        const int tq = (BR == 0) ? 2048 + ti : 512 + ti;
        bf16x8 Qf[4];
        {
            const bf16_t* qp = p.Qb + (size_t)m * 1024 + (g * 4 + hl) * 128 + 8 * fq;
#pragma unroll
            for (int sx = 0; sx < 4; ++sx) Qf[sx] = *(const bf16x8*)(qp + 32 * sx);
        }
        unsigned long long selmask = 0ull, tmask, om = 0ull;
        if (BR == 0) {
            selmask = p.SEL[m * 2 + g];
            om = p.SEL[(MP + s * 8 + (lane & 7)) * 2 + g];
        }
        bt[tid] = btv;
        if (BR == 0) { if (tid < 16) pgs[tid] = pgv; __syncthreads(); }
        if (BR == 0) {
            om |= __shfl_xor(om, 1, 64); om |= __shfl_xor(om, 2, 64); om |= __shfl_xor(om, 4, 64);
            tmask = om;
        } else tmask = 0x1ffull;
        asm volatile("" : "+v"(Qf[0]), "+v"(Qf[1]), "+v"(Qf[2]), "+v"(Qf[3]), "+v"(b31), "+v"(selmask) :: "memory");
        auto rowptr = [&](int j, int jj) -> const float* {
            const int r = 64 * j + srow + 16 * jj;
            if (BR == 0) {
                if (r < 2048) {
                    const int page = pgs[j >> 1];
                    return p.cache_slc + (((size_t)page * 128 + (r & 127)) * 4 + g) * 128;
                }
                if (r < 2056) return p.out + O_SLC_S + ((size_t)s * 8 + (r - 2048)) * 512 + g * 128;
                return nullptr;
            } else {
                if (r < 512) return p.cache_win + (((size_t)s * 512 + r) * 4 + g) * 128;
                if (r < 520) return p.out + O_WIN_S + ((size_t)s * 512 + 504 + (r - 512)) * 512 + g * 128;
                return nullptr;
            }
        };
        f32x4 O[4];
#pragma unroll
        for (int c = 0; c < 4; ++c) O[c] = (f32x4){0.f, 0.f, 0.f, 0.f};
        float mrun = -INFINITY, lrun = 0.f;
        f32x4 kx[2][4], vx[2][4];
        int jt[2];
        unsigned rowok[2];
#define GLD_NT(dst, ptr) asm volatile("global_load_dwordx4 %0, %1, off nt" : "=v"(dst) : "v"(ptr) : "memory")
#define LOAD_ROWS(j, par) do { rowok[par] = 0u; _Pragma("unroll") for (int jj_ = 0; jj_ < 4; ++jj_) { const float* rp_ = rowptr(j, jj_); \
            if (rp_) rowok[par] |= 1u << jj_; else rp_ = p.cache_win; \
            GLD_NT(kx[par][jj_], rp_ + spc * 4); GLD_NT(vx[par][jj_], rp_ + 256 + spc * 4); } } while (0)
#pragma unroll
        for (int par = 0; par < 2; ++par) {
            jt[par] = __builtin_amdgcn_readfirstlane(tmask ? (int)__builtin_ctzll(tmask) : -1);
            tmask &= tmask - 1;
            rowok[par] = 0u;
            if (jt[par] >= 0) LOAD_ROWS(jt[par], par);
            else {
#pragma unroll
                for (int jj_ = 0; jj_ < 4; ++jj_) { kx[par][jj_] = (f32x4){0.f, 0.f, 0.f, 0.f}; vx[par][jj_] = (f32x4){0.f, 0.f, 0.f, 0.f}; }
            }
        }
        __syncthreads();
        bool more = true;
        while (more) {
#pragma unroll
          for (int par = 0; par < 2; ++par) {
            const int j = jt[par];
            if (j < 0) { more = false; break; }
            unsigned char* Kb = smem + par * 32768;
            unsigned char* Vb = Kb + 16384;
            if (jt[par ^ 1] >= 0) asm volatile("s_waitcnt vmcnt(8)" ::: "memory"); else asm volatile("s_waitcnt vmcnt(0)" ::: "memory");
            asm volatile("" : "+v"(kx[par][0]), "+v"(kx[par][1]), "+v"(kx[par][2]), "+v"(kx[par][3]), "+v"(vx[par][0]), "+v"(vx[par][1]), "+v"(vx[par][2]), "+v"(vx[par][3]) :: "memory");
            {
                const unsigned kof = ((((unsigned)spc >> 1) ^ ksw) << 4) + 8u * ((unsigned)spc & 1u);
                const unsigned vof = ((((unsigned)spc >> 1) ^ vsw) << 4) + 8u * ((unsigned)spc & 1u);
#pragma unroll
                for (int jj_ = 0; jj_ < 4; ++jj_) {
                    const bool ok = (rowok[par] >> jj_) & 1u;
                    const uint2 kw = ok ? make_uint2(pk2(kx[par][jj_][0], kx[par][jj_][1]), pk2(kx[par][jj_][2], kx[par][jj_][3])) : make_uint2(0u, 0u);
                    const uint2 vw = ok ? make_uint2(pk2(vx[par][jj_][0], vx[par][jj_][1]), pk2(vx[par][jj_][2], vx[par][jj_][3])) : make_uint2(0u, 0u);
                    *(uint2*)(Kb + (srow + 16 * jj_) * 256 + kof) = kw;
                    *(uint2*)(Vb + (srow + 16 * jj_) * 256 + vof) = vw;
                }
            }
            __syncthreads();
            jt[par] = __builtin_amdgcn_readfirstlane(tmask ? (int)__builtin_ctzll(tmask) : -1);
            tmask &= tmask - 1;
            if (jt[par] >= 0) LOAD_ROWS(jt[par], par);
            const int kbase = j * 64 + 32 * kh;
            f32x4 S[2];
#pragma unroll
            for (int nt = 0; nt < 2; ++nt) {
                const int r = 32 * kh + 16 * nt + fr;
                S[nt] = (f32x4){0.f, 0.f, 0.f, 0.f};
#pragma unroll
                for (int sx = 0; sx < 4; ++sx) {
                    const bf16x8 Kf = *(const bf16x8*)(Kb + r * 256 + (((unsigned)(4 * sx + fq) ^ (unsigned)(r & 15)) << 4));
                    S[nt] = __builtin_amdgcn_mfma_f32_16x16x32_bf16(Kf, Qf[sx], S[nt], 0, 0, 0);
                }
            }
            const int q0 = (BR == 0) ? 2048 : 512;
            const bool far = (q0 - (j * 64 + 63)) >= 113;
            const bool selok = (BR == 0) ? (((selmask >> j) & 1ull) != 0ull) : true;
            float tmax = -INFINITY;
#pragma unroll
            for (int nt = 0; nt < 2; ++nt)
#pragma unroll
                for (int i = 0; i < 4; ++i) {
                    const int dist = tq - (kbase + 16 * nt + 4 * fq + i);
                    bool valid = selok && dist >= 0;
                    if (BR == 1) valid = valid && dist <= 512;
                    const float bias = far ? b31 : bt[hl * 128 + (dist < 0 ? 0 : (dist > 127 ? 127 : dist))];
                    const float sv = valid ? S[nt][i] + bias : -INFINITY;
                    S[nt][i] = sv;
                    tmax = fmaxf(tmax, sv);
                }
            tmax = fmaxf(tmax, __shfl_xor(tmax, 16, 64));
            tmax = fmaxf(tmax, __shfl_xor(tmax, 32, 64));
            const float mnew = fmaxf(mrun, tmax);
            const bool dead = (mnew == -INFINITY);
            const float scale = (mrun == -INFINITY) ? 0.f : __expf(mrun - mnew);
            float psum = 0.f;
#pragma unroll
            for (int nt = 0; nt < 2; ++nt)
#pragma unroll
                for (int i = 0; i < 4; ++i) {
                    const float pv = dead ? 0.f : __expf(S[nt][i] - mnew);
                    S[nt][i] = pv;
                    psum += pv;
                }
            lrun = lrun * scale + psum;
            mrun = mnew;
#pragma unroll
            for (int c = 0; c < 4; ++c) { O[c][0] *= scale; O[c][1] *= scale; O[c][2] *= scale; O[c][3] *= scale; }
            bf16x8 Pf;
            {
                union { unsigned u[4]; bf16x8 v; } cv;
                cv.u[0] = pk2(S[0][0], S[0][1]); cv.u[1] = pk2(S[0][2], S[0][3]);
                cv.u[2] = pk2(S[1][0], S[1][1]); cv.u[3] = pk2(S[1][2], S[1][3]);
                Pf = cv.v;
            }
#pragma unroll
            for (int c = 0; c < 4; ++c) {
                const int r0 = 32 * kh + 4 * fq + (fr >> 2), r1 = r0 + 16;
                const unsigned ch = (unsigned)(2 * (4 * dh + c) + ((fr & 3) >> 1));
                const s16x4 a0 = __builtin_amdgcn_ds_read_tr16_b64_v4i16((__attribute__((address_space(3))) s16x4*)(Vb + r0 * 256 + ((ch ^ fvsw(r0)) << 4) + 8 * (fr & 1)));
                const s16x4 a1 = __builtin_amdgcn_ds_read_tr16_b64_v4i16((__attribute__((address_space(3))) s16x4*)(Vb + r1 * 256 + ((ch ^ fvsw(r1)) << 4) + 8 * (fr & 1)));
                const bf16x8 Vf = {a0[0], a0[1], a0[2], a0[3], a1[0], a1[1], a1[2], a1[3]};
                O[c] = __builtin_amdgcn_mfma_f32_16x16x32_bf16(Vf, Pf, O[c], 0, 0, 0);
            }
          }
        }
#undef LOAD_ROWS
#undef GLD_NT
        float l = lrun + __shfl_xor(lrun, 16, 64);
        l += __shfl_xor(l, 32, 64);
#pragma unroll
        for (int c = 0; c < 4; ++c) *(f32x4*)(mrg + ((wid * 4 + c) * 64 + lane) * 4) = O[c];
        mrg[8192 + (wid * 64 + lane) * 2] = mrun;
        mrg[8192 + (wid * 64 + lane) * 2 + 1] = l;
        __syncthreads();
        if (kh == 0) {
            const int pw = wid + 2;
            const float m1 = mrg[8192 + (pw * 64 + lane) * 2], l1 = mrg[8192 + (pw * 64 + lane) * 2 + 1];
            const float mm = fmaxf(mrun, m1);
            float w0 = 0.f, w1 = 0.f;
            if (mm != -INFINITY) {
                w0 = (mrun == -INFINITY) ? 0.f : __expf(mrun - mm);
                w1 = (m1 == -INFINITY) ? 0.f : __expf(m1 - mm);
            }
            const float lt = l * w0 + l1 * w1;
            const float inv = lt > 0.f ? 1.0f / lt : 0.f;
            bf16_t* Og = (BR == 0) ? p.OS : p.OW;
            bf16_t* op = Og + (size_t)m * 1024 + (g * 4 + hl) * 128 + dh * 64 + 4 * fq;
#pragma unroll
            for (int c = 0; c < 4; ++c) {
                const f32x4 o1 = *(const f32x4*)(mrg + ((pw * 4 + c) * 64 + lane) * 4);
                *(uint2*)(op + 16 * c) = make_uint2(pk2((O[c][0] * w0 + o1[0] * w1) * inv, (O[c][1] * w0 + o1[1] * w1) * inv),
                                                    pk2((O[c][2] * w0 + o1[2] * w1) * inv, (O[c][3] * w0 + o1[3] * w1) * inv));
            }
        }
    }
}


__device__ __forceinline__ void ph_hgrn(const Params& p, int bid, int nb, float* lds, unsigned* qctr = nullptr) {
    const int tid = threadIdx.x, v = tid & 127, kq = tid >> 7;
    float* sq = lds;
    float* sf = lds + 2048;
    float* si = lds + 4096;
    float* so = lds + 6144;
    for (int j = q_next(qctr, -1, bid, nb, (unsigned char*)lds); j < 1024;) {
        const int h = j & 7;
        const size_t mbase = (size_t)MP + (size_t)(j >> 3) * 8;
        const float* s0 = p.state + (size_t)j * 16384;
        float* sout = p.out + O_ST_S + (size_t)j * 16384;
        float S[32];
#pragma unroll
        for (int k = 0; k < 32; ++k) S[k] = s0[(size_t)(kq * 32 + k) * 128 + v];
        const float l0 = p.lb_logits[h * 128 + v], l1 = p.lb_logits[1024 + h * 128 + v];
        const float* rowa = p.PF + (mbase + (tid >> 7)) * NPF + h * 128 + v;
        const float* rowb = rowa + (size_t)4 * NPF;
        const float qa = rowa[C_QB], fa = rowa[C_FB], ia = rowa[C_IB], qb = rowb[C_QB], fb = rowb[C_FB], ib = rowb[C_IB];
        const int jnext = q_next(qctr, j, bid, nb, (unsigned char*)lds);
        {
            const float lb = 1.0f / (1.0f + expf(l1 - l0));
            sq[tid] = qa; sf[tid] = lb + (1.0f - lb) * sigmoidf_(fa); si[tid] = ia;
            sq[tid + NT] = qb; sf[tid + NT] = lb + (1.0f - lb) * sigmoidf_(fb); si[tid + NT] = ib;
        }
        __syncthreads();
#pragma unroll
        for (int tt = 0; tt < 8; ++tt) {
            const float iv = si[tt * 128 + v];
            float o = 0.f;
#pragma unroll
            for (int k = 0; k < 32; ++k) {
                const float f = sf[tt * 128 + kq * 32 + k];
                const float q = sq[tt * 128 + kq * 32 + k];
                S[k] = f * S[k] + (1.0f - f) * iv;
                o += q * S[k];
            }
            so[(tt * 4 + kq) * 128 + v] = o;
        }
        __syncthreads();
#pragma unroll
        for (int r = 0; r < 2; ++r) {
            const int e = tid + r * NT, tt = e >> 7;
            const float* sp = so + tt * 512 + v;
            p.OH[(mbase + tt) * 1024 + h * 128 + v] = (sp[0] + sp[128]) + (sp[256] + sp[384]);
        }
#pragma unroll
        for (int k = 0; k < 32; ++k) sout[(size_t)(kq * 32 + k) * 128 + v] = S[k];
        j = jnext;
    }
}

template <int CTRL> __device__ __forceinline__ float dpp_f(float x) {
    return __int_as_float(__builtin_amdgcn_update_dpp(0, __float_as_int(x), CTRL, 0xf, 0xf, false));
}
__device__ __forceinline__ float row_prefix16(float x) {
    x += dpp_f<0x111>(x); x += dpp_f<0x112>(x); x += dpp_f<0x114>(x); x += dpp_f<0x118>(x);
    return x;
}
__device__ __forceinline__ float row_suffix16(float x) {
    x += dpp_f<0x101>(x); x += dpp_f<0x102>(x); x += dpp_f<0x104>(x); x += dpp_f<0x108>(x);
    return x;
}
__device__ __forceinline__ float fsig(float x) { return __builtin_amdgcn_rcpf(1.0f + __expf(-x)); }
__device__ __forceinline__ float flog2(float x) { return __builtin_amdgcn_logf(x); }
__device__ __forceinline__ float fexp2(float x) { return __builtin_amdgcn_exp2f(x); }
__device__ __forceinline__ float row_last16(float x) {
    return __int_as_float(__builtin_amdgcn_ds_swizzle(__float_as_int(x), 0x1F0));
}

struct ChainCtx {
    size_t mbase; int h, st, kg, sk4, wid, fr, fq; float4 lb4;
};

__device__ __forceinline__ void chain_step(const Params& p, unsigned char* smem, const ChainCtx& c, const int step,
                                           float4& rq, float4& rfraw, float4& ri, pg8::f32x4 (&Sacc)[8]) {
    typedef pg8::bf16x8 bf16x8;
    typedef pg8::f32x4 f32x4;
    typedef short s16x4 __attribute__((ext_vector_type(4)));
    constexpr int BUF = 17408;
    unsigned char* B = smem + (step & 1) * BUF;
    unsigned char* QD = B;
    unsigned char* KH = B + 4096;
    bf16_t* KET = (bf16_t*)(B + 8192);
    bf16_t* VT = (bf16_t*)(B + 12288);
    float* DEND = (float*)(B + 16384);
    const int st = c.st, kg = c.kg, sk4 = c.sk4, wid = c.wid, fr = c.fr, fq = c.fq;
    {
        const float fx = c.lb4.x + (1.0f - c.lb4.x) * fsig(rfraw.x), fy = c.lb4.y + (1.0f - c.lb4.y) * fsig(rfraw.y);
        const float fz = c.lb4.z + (1.0f - c.lb4.z) * fsig(rfraw.z), fw = c.lb4.w + (1.0f - c.lb4.w) * fsig(rfraw.w);
        const float lx = flog2(fx), ly = flog2(fy), lz = flog2(fz), lw = flog2(fw);
        const float bsx = row_prefix16(lx), bsy = row_prefix16(ly), bsz = row_prefix16(lz), bsw = row_prefix16(lw);
        const float ex = row_last16(bsx) - bsx, ey = row_last16(bsy) - bsy, ez = row_last16(bsz) - bsz, ew = row_last16(bsw) - bsw;
        const float kx = 1.0f - fx, ky = 1.0f - fy, kz = 1.0f - fz, kw = 1.0f - fw;
        const unsigned v01 = pk2(ri.x, ri.y), v23 = pk2(ri.z, ri.w);
        VT[(sk4 + 0) * 16 + st] = (bf16_t)(v01 & 0xffffu); VT[(sk4 + 1) * 16 + st] = (bf16_t)(v01 >> 16);
        VT[(sk4 + 2) * 16 + st] = (bf16_t)(v23 & 0xffffu); VT[(sk4 + 3) * 16 + st] = (bf16_t)(v23 >> 16);
        const float dx = fexp2(bsx), dy = fexp2(bsy), dz = fexp2(bsz), dw = fexp2(bsw);
        const unsigned qd0 = pk2(rq.x * dx, rq.y * dy), qd1 = pk2(rq.z * dz, rq.w * dw);
        const unsigned kh0 = pk2(kx * fexp2(fminf(-bsx, 115.4f)), ky * fexp2(fminf(-bsy, 115.4f)));
        const unsigned kh1 = pk2(kz * fexp2(fminf(-bsz, 115.4f)), kw * fexp2(fminf(-bsw, 115.4f)));
        const unsigned ke0 = pk2(kx * fexp2(ex), ky * fexp2(ey));
        const unsigned ke1 = pk2(kz * fexp2(ez), kw * fexp2(ew));
        const unsigned off = (unsigned)st * 256u + ((((unsigned)kg >> 1) ^ (unsigned)st) << 4) + 8u * ((unsigned)kg & 1u);
        *(uint2*)(QD + off) = make_uint2(qd0, qd1);
        *(uint2*)(KH + off) = make_uint2(kh0, kh1);
        KET[(sk4 + 0) * 16 + st] = (bf16_t)(ke0 & 0xffffu); KET[(sk4 + 1) * 16 + st] = (bf16_t)(ke0 >> 16);
        KET[(sk4 + 2) * 16 + st] = (bf16_t)(ke1 & 0xffffu); KET[(sk4 + 3) * 16 + st] = (bf16_t)(ke1 >> 16);
        if (st == 15) *(float4*)(DEND + sk4) = make_float4(dx, dy, dz, dw);
    }
    __syncthreads();
    if (step + 2 < 128) {
        const float* row = p.PF + (c.mbase + (size_t)(step + 2) * 16 + st) * NPF + c.h * 128 + sk4;
        rq = *(const float4*)(row + C_QB); rfraw = *(const float4*)(row + C_FB); ri = *(const float4*)(row + C_IB);
    }
    const s16x4 vv = *(const s16x4*)(VT + (16 * wid + fr) * 16 + 4 * fq);
    s16x4 Kef[8];
    f32x4 d4[8];
#pragma unroll
    for (int kt = 0; kt < 8; ++kt) {
        Kef[kt] = *(const s16x4*)(KET + (16 * kt + fr) * 16 + 4 * fq);
        d4[kt] = *(const f32x4*)(DEND + 16 * kt + 4 * fq);
    }
    f32x4 oacc = (f32x4){0.f, 0.f, 0.f, 0.f};
#pragma unroll
    for (int ks = 0; ks < 4; ++ks) {
        const unsigned c0 = (unsigned)(4 * ks + (fq >> 1)), c1 = c0 + 2u;
        const s16x4 qa = *(const s16x4*)(QD + fr * 256 + ((c0 ^ (unsigned)fr) << 4) + 8 * (fq & 1));
        const s16x4 qb = *(const s16x4*)(QD + fr * 256 + ((c1 ^ (unsigned)fr) << 4) + 8 * (fq & 1));
        const bf16x8 Qp = {qa[0], qa[1], qa[2], qa[3], qb[0], qb[1], qb[2], qb[3]};
        union { unsigned u[4]; bf16x8 v; } sv;
        sv.u[0] = pk2(Sacc[2 * ks][0], Sacc[2 * ks][1]); sv.u[1] = pk2(Sacc[2 * ks][2], Sacc[2 * ks][3]);
        sv.u[2] = pk2(Sacc[2 * ks + 1][0], Sacc[2 * ks + 1][1]); sv.u[3] = pk2(Sacc[2 * ks + 1][2], Sacc[2 * ks + 1][3]);
        oacc = __builtin_amdgcn_mfma_f32_16x16x32_bf16(Qp, sv.v, oacc, 0, 0, 0);
    }
    f32x4 A = (f32x4){0.f, 0.f, 0.f, 0.f};
#pragma unroll
    for (int ks = 0; ks < 4; ++ks) {
        const unsigned o16 = (unsigned)fr * 256u + ((((unsigned)(4 * ks + fq)) ^ (unsigned)fr) << 4);
        const bf16x8 Khf = *(const bf16x8*)(KH + o16);
        const bf16x8 Qdf = *(const bf16x8*)(QD + o16);
        A = __builtin_amdgcn_mfma_f32_16x16x32_bf16(Khf, Qdf, A, 0, 0, 0);
    }
    {
        union { unsigned u[2]; s16x4 v; } av;
        av.u[0] = pk2((4 * fq + 0 <= fr) ? A[0] : 0.f, (4 * fq + 1 <= fr) ? A[1] : 0.f);
        av.u[1] = pk2((4 * fq + 2 <= fr) ? A[2] : 0.f, (4 * fq + 3 <= fr) ? A[3] : 0.f);
        oacc = __builtin_amdgcn_mfma_f32_16x16x16bf16_1k(av.v, vv, oacc, 0, 0, 0);
    }
    {
        float* op = p.OH + (c.mbase + (size_t)step * 16 + 4 * fq) * 1024 + c.h * 128 + 16 * wid + fr;
        op[0] = oacc[0]; op[1024] = oacc[1]; op[2048] = oacc[2]; op[3072] = oacc[3];
    }
#pragma unroll
    for (int kt = 0; kt < 8; ++kt) {
        Sacc[kt] = Sacc[kt] * d4[kt];
        Sacc[kt] = __builtin_amdgcn_mfma_f32_16x16x16bf16_1k(Kef[kt], vv, Sacc[kt], 0, 0, 0);
    }
}

__device__ __forceinline__ void ph_hgrn_chain(const Params& p, int item, unsigned char* smem) {
    typedef pg8::f32x4 f32x4;
    const int tid = threadIdx.x, lane = tid & 63;
    ChainCtx c;
    c.wid = tid >> 6; c.fr = lane & 15; c.fq = lane >> 4;
    const int n = item >> 3;
    c.h = item & 7;
    c.mbase = (size_t)n * 2048;
    c.st = tid & 15; c.kg = tid >> 4; c.sk4 = c.kg * 4;
    {
        const float4 l0 = *(const float4*)&p.lb_logits[c.h * 128 + c.sk4], l1 = *(const float4*)&p.lb_logits[1024 + c.h * 128 + c.sk4];
        c.lb4 = make_float4(1.0f / (1.0f + expf(l1.x - l0.x)), 1.0f / (1.0f + expf(l1.y - l0.y)), 1.0f / (1.0f + expf(l1.z - l0.z)), 1.0f / (1.0f + expf(l1.w - l0.w)));
    }
    f32x4 Sacc[8];
#pragma unroll
    for (int kt = 0; kt < 8; ++kt) Sacc[kt] = (f32x4){0.f, 0.f, 0.f, 0.f};
    float4 q0, f0, i0, q1, f1, i1;
    {
        const float* row = p.PF + (c.mbase + c.st) * NPF + c.h * 128 + c.sk4;
        q0 = *(const float4*)(row + C_QB); f0 = *(const float4*)(row + C_FB); i0 = *(const float4*)(row + C_IB);
        row += (size_t)16 * NPF;
        q1 = *(const float4*)(row + C_QB); f1 = *(const float4*)(row + C_FB); i1 = *(const float4*)(row + C_IB);
    }
    __syncthreads();
    for (int s2 = 0; s2 < 128; s2 += 2) {
        chain_step(p, smem, c, s2, q0, f0, i0, Sacc);
        chain_step(p, smem, c, s2 + 1, q1, f1, i1, Sacc);
    }
    float* so = p.out + O_ST_P + (size_t)item * 16384;
#pragma unroll
    for (int kt = 0; kt < 8; ++kt)
#pragma unroll
        for (int i = 0; i < 4; ++i) so[(size_t)(16 * kt + 4 * c.fq + i) * 128 + 16 * c.wid + c.fr] = Sacc[kt][i];
    __syncthreads();
}

__device__ __forceinline__ void ph_combine(const Params& p, int bid, int nb, int m_begin, int m_end) {
    const int lane = threadIdx.x & 63, wave = threadIdx.x >> 6;
    const int gw = bid * 8 + wave, ngw = nb * 8;
    const int c0 = lane * 16, hd = lane >> 3;
    float4 gov[4];
#pragma unroll
    for (int j = 0; j < 4; ++j) gov[j] = *(const float4*)&p.g_o[(c0 & 127) + 4 * j];
    for (int m = m_begin + gw; m < m_end; m += ngw) {
        const bf16_t* row = p.PH + (size_t)m * LDH;
        float4 oc[4], os[4], ow[4], oh[4], za[4], zb[4];
#pragma unroll
        for (int j = 0; j < 4; ++j) {
            const uint2 c2 = *(const uint2*)&p.OC[(size_t)m * 1024 + c0 + 4 * j], s2 = *(const uint2*)&p.OS[(size_t)m * 1024 + c0 + 4 * j];
            const uint2 w2 = *(const uint2*)&p.OW[(size_t)m * 1024 + c0 + 4 * j];
            oc[j] = make_float4(__uint_as_float(c2.x << 16), __uint_as_float(c2.x & 0xffff0000u), __uint_as_float(c2.y << 16), __uint_as_float(c2.y & 0xffff0000u));
            os[j] = make_float4(__uint_as_float(s2.x << 16), __uint_as_float(s2.x & 0xffff0000u), __uint_as_float(s2.y << 16), __uint_as_float(s2.y & 0xffff0000u));
            ow[j] = make_float4(__uint_as_float(w2.x << 16), __uint_as_float(w2.x & 0xffff0000u), __uint_as_float(w2.y << 16), __uint_as_float(w2.y & 0xffff0000u));
            oh[j] = *(const float4*)&p.OH[(size_t)m * 1024 + c0 + 4 * j];
            za[j] = bf4(*(const uint2*)&row[C_ZA + c0 + 4 * j]);
            zb[j] = bf4(*(const uint2*)&row[C_ZB + c0 + 4 * j]);
        }
        const float gc = p.GATE[(size_t)m * 24 + hd], gs = p.GATE[(size_t)m * 24 + 8 + hd], gw_ = p.GATE[(size_t)m * 24 + 16 + hd];
        float ss = 0.f;
#pragma unroll
        for (int j = 0; j < 4; ++j) ss += oh[j].x * oh[j].x + oh[j].y * oh[j].y + oh[j].z * oh[j].z + oh[j].w * oh[j].w;
        ss += __shfl_xor(ss, 1, 64); ss += __shfl_xor(ss, 2, 64); ss += __shfl_xor(ss, 4, 64);
        const float rr = rsqrtf(ss * (1.0f / 128) + EPS);
        uint2 a[4], bq[4];
#pragma unroll
        for (int j = 0; j < 4; ++j) {
            const float4 go = gov[j];
            a[j].x = pk2((gc * oc[j].x + gs * os[j].x + gw_ * ow[j].x) * siluf_(za[j].x), (gc * oc[j].y + gs * os[j].y + gw_ * ow[j].y) * siluf_(za[j].y));
            a[j].y = pk2((gc * oc[j].z + gs * os[j].z + gw_ * ow[j].z) * siluf_(za[j].z), (gc * oc[j].w + gs * os[j].w + gw_ * ow[j].w) * siluf_(za[j].w));
            bq[j].x = pk2(oh[j].x * rr * go.x * siluf_(zb[j].x), oh[j].y * rr * go.y * siluf_(zb[j].y));
            bq[j].y = pk2(oh[j].z * rr * go.z * siluf_(zb[j].z), oh[j].w * rr * go.w * siluf_(zb[j].w));
        }
        uint4* oa = (uint4*)&p.MIXb[(size_t)m * 2048 + c0];
        uint4* ob = (uint4*)&p.MIXb[(size_t)m * 2048 + 1024 + c0];
        oa[0] = make_uint4(a[0].x, a[0].y, a[1].x, a[1].y); oa[1] = make_uint4(a[2].x, a[2].y, a[3].x, a[3].y);
        ob[0] = make_uint4(bq[0].x, bq[0].y, bq[1].x, bq[1].y); ob[1] = make_uint4(bq[2].x, bq[2].y, bq[3].x, bq[3].y);
    }
}

__global__ void __launch_bounds__(NT, 2) k_mega(Params p) {
    extern __shared__ __attribute__((aligned(16))) unsigned char smem[];
    float* lds = (float*)smem;
    volatile LAS unsigned* misc = (volatile LAS unsigned*)(smem + LDS_STAGE);
    if (threadIdx.x == 0) { misc[0] = 0u; misc[1] = 0u; }
    __syncthreads();
    XcdBarrier bar = xcd_barrier_post(p.bar, misc);
    const int bid = blockIdx.x, nb = gridDim.x;
#define PH0 { ph_prologue(p, bid, nb, lds); xcd_barrier(bar); }
#define PH1 { if (bid < nb - 32 || nb <= 64) { const int gg = (nb > 64) ? nb - 32 : nb; \
                pg8::Gemm g{p.Hb, p.Wt_in, M, LDP, D}; pg8::StaticOrder S; S.init(M, LDP, gg, bid); pg8::EpiMix E{p.PF, p.PH, LDH}; \
                pg8::gemm_phase<pg8::EpiMix, pg8::StaticOrder>((PG8_LAS unsigned char*)smem, g, S, E); \
                if (threadIdx.x == 0) (void)__hip_atomic_fetch_add(&p.ctr[64], 1u, __ATOMIC_RELAXED, __HIP_MEMORY_SCOPE_AGENT); } \
              else { ph_cmp_mfma(p, 512, true, smem, P1_MAXU); } \
              xcd_barrier(bar); }
#define PH2 { ph_post(p, bid, nb); xcd_barrier(bar); }
#define PH3 { if (bid < 32 && nb > 64) { ph_hgrn_chain(p, bid, smem); } \
              else if (nb <= 64) { for (int it = bid; it < 32; it += nb) ph_hgrn_chain(p, it, smem); } \
                \
              ph_cmp_mfma(p, NSEQ * 4, false, smem); __syncthreads(); \
              ph_attn_prompt<1>(p, bid, nb, smem, p.ctr + 1); __syncthreads(); \
              ph_attn_sample<1>(p, bid, nb, smem, p.ctr + 2); __syncthreads(); \
              ph_hgrn(p, bid, nb, lds, p.ctr + 3); \
              xcd_barrier(bar); }
#define PH5 { ph_cmp_attn_mfma(p, bid, nb, smem); xcd_barrier(bar); }
#define PH6 {   \
              if (bid & 1) { ph_attn_prompt<0>(p, bid, nb, smem); __syncthreads(); ph_attn_sample<0>(p, bid, nb, smem); } \
              else { ph_attn_sample<0>(p, bid, nb, smem); __syncthreads(); ph_attn_prompt<0>(p, bid, nb, smem); } \
              xcd_barrier(bar); }
#define PH7A { ph_combine(p, bid, nb, MP, M); xcd_barrier(bar); }
#define PH7B { if (bid < 32 && nb > 64) {   \
                 pg8::Gemm g{p.MIXb + (size_t)MP * 2048, p.Wt_out, MS, D, 2048}; pg8::StaticOrder S; S.init(MS, D, 32, bid); \
                 pg8::EpiResF32S E{p.out + O_YS, p.x_sample}; \
                 pg8::gemm_phase<pg8::EpiResF32S, pg8::StaticOrder>((PG8_LAS unsigned char*)smem, g, S, E); } \
               else { const int rb = (nb > 64) ? bid - 32 : bid, rnb = (nb > 64) ? nb - 32 : nb; \
                 ph_combine(p, rb, rnb, 0, MP); } \
               __syncthreads(); ph_wincopy(p, bid, nb, smem, p.ctr + 4);   \
               xcd_barrier(bar); }
#define PH8 { if (nb > 64) { pg8::Gemm g{p.MIXb, p.Wt_out, MP, D, 2048}; pg8::StaticOrder S; S.init(MP, D, nb, bid); pg8::EpiResF32 E{p.out, p.x_prompt, p.x_sample}; \
                pg8::gemm_phase<pg8::EpiResF32, pg8::StaticOrder>((PG8_LAS unsigned char*)smem, g, S, E); } \
              else { pg8::Gemm g{p.MIXb, p.Wt_out, M, D, 2048}; pg8::StaticOrder S; S.init(M, D, nb, bid); pg8::EpiResF32 E{p.out, p.x_prompt, p.x_sample}; \
                pg8::gemm_phase<pg8::EpiResF32, pg8::StaticOrder>((PG8_LAS unsigned char*)smem, g, S, E); } }
    PH0
#if (PROBE_MASK >> 0) & 1
    PH0
#endif
    PH1
#if (PROBE_MASK >> 1) & 1
    PH1
#endif
    PH2
#if (PROBE_MASK >> 2) & 1
    PH2
#endif
    PH3
#if (PROBE_MASK >> 3) & 1
    PH3
#endif
    PH5
#if (PROBE_MASK >> 5) & 1
    PH5
#endif
    PH6
#if (PROBE_MASK >> 6) & 1
    PH6
#endif
    PH7A
    PH7B
#if (PROBE_MASK >> 8) & 1
    PH8
    xcd_barrier(bar);
#endif
    PH8
}

}

extern "C" void kernel_launch(void* const* d_in, const int* in_sizes, int n_in, void* d_out,
                              int out_size, void* d_ws, size_t ws_size, hipStream_t stream) {
    (void)in_sizes; (void)n_in; (void)out_size; (void)ws_size;
    Params p{};
    p.x_prompt = (const float*)d_in[0];
    p.x_sample = (const float*)d_in[1];
    p.cache_cmp = (const float*)d_in[2];
    p.cache_slc = (const float*)d_in[3];
    p.cache_win = (const float*)d_in[4];
    p.state = (const float*)d_in[5];
    p.page_table = (const int*)d_in[6];
    p.g_norm = (const float*)d_in[7];
    p.w_in = (const float*)d_in[8];
    p.w_out = (const float*)d_in[9];
    p.g_q = (const float*)d_in[10];
    p.g_k_slc = (const float*)d_in[11];
    p.g_k_win = (const float*)d_in[12];
    p.g_k_cmp = (const float*)d_in[13];
    p.w_cmp_k = (const float*)d_in[14];
    p.w_cmp_v = (const float*)d_in[15];
    p.pe_k = (const float*)d_in[16];
    p.pe_v = (const float*)d_in[17];
    p.rel_bias = (const float*)d_in[18];
    p.lb_logits = (const float*)d_in[19];
    p.g_o = (const float*)d_in[20];
    p.out = (float*)d_out;
    float* ws = (float*)d_ws;
    size_t off = 0;
    auto take = [&](size_t nfloats) { float* r = ws + off; off += (nfloats + 63) & ~(size_t)63; return r; };
    p.bar = (unsigned*)take(XCD_BAR_WORDS + 128);
    p.ctr = p.bar + XCD_BAR_WORDS;
    p.Hb = (bf16_t*)take((size_t)M * D / 2);
    p.Wt_in = (bf16_t*)take((size_t)LDP * D / 2);
    p.Wt_out = (bf16_t*)take((size_t)D * 2048 / 2);
    p.MIXb = (bf16_t*)take((size_t)M * 2048 / 2);
    p.Wc_t = (bf16_t*)take((size_t)2 * 256 * 2048 / 2);
    p.PEB = take(64 * 128);
    p.Qb = (bf16_t*)take((size_t)M * 1024 / 2);
    p.KVb = (bf16_t*)take((size_t)2 * 2 * 4 * 2 * 2048 * 128 / 2);
    p.PF = take((size_t)M * NPF);
    p.PH = (bf16_t*)take((size_t)M * LDH / 2);
    p.KCb = (bf16_t*)take((size_t)NSEQ * 2 * 128 * 128 / 2);
    p.VCb = (bf16_t*)take((size_t)NSEQ * 2 * 128 * 128 / 2);
    p.OC = (bf16_t*)take((size_t)M * 1024 / 2);
    p.OS = (bf16_t*)take((size_t)M * 1024 / 2);
    p.OW = (bf16_t*)take((size_t)M * 1024 / 2);
    p.OH = take((size_t)M * 1024);
    p.GATE = take((size_t)M * 24);
    p.SEL = (unsigned long long*)take((size_t)M * 2 * 2);

    static int grid = 0;
    if (!grid) {
        int dev = 0, cus = 0;
        (void)hipGetDevice(&dev);
        (void)hipDeviceGetAttribute(&cus, hipDeviceAttributeMultiprocessorCount, dev);
        (void)hipFuncSetAttribute((const void*)k_mega, hipFuncAttributeMaxDynamicSharedMemorySize, LDS_BYTES);
        grid = cus > 0 ? cus : 256;
    }
    (void)hipMemsetAsync(p.bar, 0, (XCD_BAR_WORDS + 128) * sizeof(unsigned), stream);
    hipLaunchKernelGGL(k_mega, dim3(grid), dim3(NT), LDS_BYTES, stream, p);
}
```
